# Optimizing an MI355X kernel written in HIP

```python
import math
import jax, jax.numpy as jnp
from jax import lax
import numpy as np

D_MODEL = 1024
BATCH = 8
SEQ = 2048
DEPTH = 2

EPS = 1e-6
D_FF = 2816
Q_BLOCK = 128
NUM_BUCKETS = 32
MAX_DISTANCE = 1024
ROPE_THETA = 10000.0
NEG_BIG = -1e30

DIFF_HEADS = 4
DIFF_QK_DIM = 32
DIFF_V_DIM = 64
DIL_HEADS = 6
DIL_HEAD_DIM = 64
DIL_PATTERNS = ((128, 1), (512, 4), (2048, 16))
MLA_HEADS = 6
MLA_Q_RANK = 256
MLA_KV_RANK = 128
MLA_NOPE_DIM = 64
MLA_ROPE_DIM = 32
MLA_V_DIM = 64

DIFF_WIDTH = DIFF_HEADS * DIFF_V_DIM
DIL_WIDTH = DIL_HEADS * DIL_HEAD_DIM
MLA_WIDTH = MLA_HEADS * MLA_V_DIM
MIX_WIDTH = DIFF_WIDTH + DIL_WIDTH + MLA_WIDTH
BIAS_HEADS = DIFF_HEADS + DIL_HEADS
IN_SIZES = (DIFF_HEADS * 2 * DIFF_QK_DIM, DIFF_HEADS * 2 * DIFF_QK_DIM, DIFF_WIDTH,
            DIL_WIDTH, DIL_WIDTH, DIL_WIDTH,
            MLA_Q_RANK, MLA_KV_RANK + MLA_ROPE_DIM)
IN_WIDTH = sum(IN_SIZES)

kernel_name = 'hybrid_parallel_diff_dilated_mla_encoder'


def rms_norm(x, g):
    xf = x.astype(jnp.float32)
    y = xf * lax.rsqrt(jnp.mean(xf * xf, axis=-1, keepdims=True) + EPS)
    return (y * g.astype(jnp.float32)).astype(x.dtype)


def swiglu(x, wg, wu, wd):
    return (jax.nn.silu(x @ wg) * (x @ wu)) @ wd


def t5_bucket(rel):
    half = NUM_BUCKETS // 2
    max_exact = half // 2
    n = jnp.abs(rel)
    nf = jnp.maximum(n, 1).astype(jnp.float32)
    large = max_exact + (jnp.log(nf / max_exact) / math.log(MAX_DISTANCE / max_exact)
                         * (half - max_exact)).astype(jnp.int32)
    large = jnp.minimum(large, half - 1)
    return jnp.where(rel > 0, half, 0) + jnp.where(n < max_exact, n, large)


def rope(x, pos):
    half = x.shape[-1] // 2
    inv = ROPE_THETA ** (-jnp.arange(half, dtype=jnp.float32) / half)
    ang = pos.astype(jnp.float32)[:, None] * inv[None, :]
    cos, sin = jnp.cos(ang), jnp.sin(ang)
    x1, x2 = x[..., :half], x[..., half:]
    return jnp.concatenate([x1 * cos - x2 * sin, x1 * sin + x2 * cos], axis=-1).astype(x.dtype)


def diff_attention(q, k, v, lam, lambda_init, subln_g, bias_table):
    B, H, S, _, dk = q.shape
    dv = v.shape[-1]
    nblk = S // Q_BLOCK
    qb = q.reshape(B, H, nblk, Q_BLOCK, 2, dk).transpose(2, 0, 1, 3, 4, 5)
    kpos = jnp.arange(S)
    scale = dk ** -0.5
    table = bias_table.astype(jnp.float32)

    def block(args):
        qi, start = args
        rel = kpos[None, :] - (start + jnp.arange(Q_BLOCK))[:, None]
        bias = jnp.moveaxis(table[t5_bucket(rel)], -1, 0)
        logits = jnp.einsum('bhqcd,bhkcd->cbhqk', qi, k).astype(jnp.float32) * scale + bias
        p = jax.nn.softmax(logits, axis=-1)
        a = p[0] - lam * p[1]
        return jnp.einsum('bhqk,bhkd->bhqd', a.astype(v.dtype), v)

    starts = jnp.arange(nblk, dtype=jnp.int32) * Q_BLOCK
    out = lax.map(block, (qb, starts))
    out = out.transpose(1, 2, 0, 3, 4).reshape(B, H, S, dv)
    return rms_norm(out, subln_g) * (1.0 - lambda_init)


def dilated_branch(q, k, v, window, dil, bias_table):
    B, H, S, d = q.shape
    R = window // (2 * dil)
    L = S // dil
    nb = -(-L // R)
    Lp = nb * R

    def to_sub(t):
        return t.reshape(B, H, L, dil, d).transpose(0, 1, 3, 2, 4)

    pad_q = ((0, 0), (0, 0), (0, 0), (0, Lp - L), (0, 0))
    pad_kv = ((0, 0), (0, 0), (0, 0), (R, Lp - L + R), (0, 0))
    qb = jnp.pad(to_sub(q), pad_q).reshape(B, H, dil, nb, R, d)

    def bands(t):
        tb = jnp.pad(to_sub(t), pad_kv).reshape(B, H, dil, nb + 2, R, d)
        return jnp.concatenate([tb[:, :, :, :-2], tb[:, :, :, 1:-1], tb[:, :, :, 2:]], axis=4)

    kb, vb = bands(k), bands(v)
    qi = jnp.arange(nb)[:, None] * R + jnp.arange(R)[None, :]
    kj = jnp.arange(nb)[:, None] * R - R + jnp.arange(3 * R)[None, :]
    rel = kj[:, None, :] - qi[:, :, None]
    valid = (jnp.abs(rel) <= R) & (kj[:, None, :] >= 0) & (kj[:, None, :] < L)
    bias = jnp.moveaxis(bias_table.astype(jnp.float32)[t5_bucket(rel * dil)], -1, 0)
    logits = jnp.einsum('bhrnqd,bhrnkd->bhrnqk', qb, kb).astype(jnp.float32) * (d ** -0.5)
    logits = jnp.where(valid, logits + bias[None, :, None], NEG_BIG)
    m = jnp.max(logits, axis=-1, keepdims=True)
    e = jnp.exp(logits - m)
    s = jnp.sum(e, axis=-1, keepdims=True)
    out = jnp.einsum('bhrnqk,bhrnkd->bhrnqd', (e / s).astype(v.dtype), vb)
    lse = (m + jnp.log(s))[..., 0]
    out = out.reshape(B, H, dil, Lp, d)[:, :, :, :L].transpose(0, 1, 3, 2, 4).reshape(B, H, S, d)
    lse = lse.reshape(B, H, dil, Lp)[:, :, :, :L].transpose(0, 1, 3, 2).reshape(B, H, S)
    return out, lse


def dilated_attention(q, k, v, bias_table):
    outs, lses = [], []
    for window, dil in DIL_PATTERNS:
        o, l = dilated_branch(q, k, v, window, dil, bias_table)
        outs.append(o)
        lses.append(l)
    w = jax.nn.softmax(jnp.stack(lses, axis=0), axis=0)
    return jnp.sum(w[..., None] * jnp.stack(outs, axis=0).astype(jnp.float32), axis=0).astype(q.dtype)


def dense_attention(q, k, v):
    B, H, S, dq = q.shape
    nblk = S // Q_BLOCK
    qb = q.reshape(B, H, nblk, Q_BLOCK, dq).transpose(2, 0, 1, 3, 4)
    scale = dq ** -0.5

    def block(qi):
        logits = jnp.einsum('bhqd,bhkd->bhqk', qi, k).astype(jnp.float32) * scale
        p = jax.nn.softmax(logits, axis=-1)
        return jnp.einsum('bhqk,bhkd->bhqd', p.astype(v.dtype), v)

    out = lax.map(block, qb)
    return out.transpose(1, 2, 0, 3, 4).reshape(B, H, S, v.shape[-1])


def mla_mixer(q_down, kv_down, q_norm_g, q_up, kv_norm_g, kv_up, qn_g, kn_g):
    B, S, _ = q_down.shape
    qk_dim = MLA_NOPE_DIM + MLA_ROPE_DIM
    q = (rms_norm(q_down, q_norm_g) @ q_up).reshape(B, S, MLA_HEADS, qk_dim)
    c_kv = rms_norm(kv_down[..., :MLA_KV_RANK], kv_norm_g)
    k_rope = kv_down[..., MLA_KV_RANK:]
    kv = (c_kv @ kv_up).reshape(B, S, MLA_HEADS, MLA_NOPE_DIM + MLA_V_DIM)
    k = jnp.concatenate([kv[..., :MLA_NOPE_DIM],
                         jnp.broadcast_to(k_rope[:, :, None, :], (B, S, MLA_HEADS, MLA_ROPE_DIM))], axis=-1)
    v = kv[..., MLA_NOPE_DIM:].transpose(0, 2, 1, 3)
    q = rms_norm(q, qn_g).transpose(0, 2, 1, 3)
    k = rms_norm(k, kn_g).transpose(0, 2, 1, 3)
    pos = jnp.arange(S)
    q = jnp.concatenate([q[..., :MLA_NOPE_DIM], rope(q[..., MLA_NOPE_DIM:], pos)], axis=-1)
    k = jnp.concatenate([k[..., :MLA_NOPE_DIM], rope(k[..., MLA_NOPE_DIM:], pos)], axis=-1)
    out = dense_attention(q, k, v)
    return out.transpose(0, 2, 1, 3).reshape(B, S, MLA_WIDTH)


def setup_inputs(seed: int = 0) -> dict:
    key = jax.random.key(seed)
    keys = iter(jax.random.split(key, 32))
    L = DEPTH

    def w(shape, fan_in):
        return jax.random.normal(next(keys), shape, jnp.float32) * fan_in ** -0.5

    def g(shape):
        return 1.0 + 0.05 * jax.random.normal(next(keys), shape, jnp.float32)

    return {
        'x': jax.random.normal(next(keys), (BATCH, SEQ, D_MODEL), jnp.float32),
        'rel_bias': 0.5 * jax.random.normal(next(keys), (NUM_BUCKETS, BIAS_HEADS), jnp.float32),
        'ffn1_norm': g((L, D_MODEL)),
        'ffn1_wg': w((L, D_MODEL, D_FF), D_MODEL),
        'ffn1_wu': w((L, D_MODEL, D_FF), D_MODEL),
        'ffn1_wd': w((L, D_FF, D_MODEL), D_FF),
        'mix_norm': g((L, D_MODEL)),
        'w_in': w((L, D_MODEL, IN_WIDTH), D_MODEL),
        'diff_q_norm': g((L, DIFF_QK_DIM)),
        'diff_k_norm': g((L, DIFF_QK_DIM)),
        'diff_lambda': 0.1 * jax.random.normal(next(keys), (L, 4, DIFF_QK_DIM), jnp.float32),
        'diff_subln': g((L, DIFF_V_DIM)),
        'dil_q_norm': g((L, DIL_HEAD_DIM)),
        'dil_k_norm': g((L, DIL_HEAD_DIM)),
        'mla_q_norm': g((L, MLA_Q_RANK)),
        'mla_q_up': w((L, MLA_Q_RANK, MLA_HEADS * (MLA_NOPE_DIM + MLA_ROPE_DIM)), MLA_Q_RANK),
        'mla_kv_norm': g((L, MLA_KV_RANK)),
        'mla_kv_up': w((L, MLA_KV_RANK, MLA_HEADS * (MLA_NOPE_DIM + MLA_V_DIM)), MLA_KV_RANK),
        'mla_qn': g((L, MLA_NOPE_DIM + MLA_ROPE_DIM)),
        'mla_kn': g((L, MLA_NOPE_DIM + MLA_ROPE_DIM)),
        'w_o': w((L, MIX_WIDTH, D_MODEL), MIX_WIDTH),
        'ffn2_norm': g((L, D_MODEL)),
        'ffn2_wg': w((L, D_MODEL, D_FF), D_MODEL),
        'ffn2_wu': w((L, D_MODEL, D_FF), D_MODEL),
        'ffn2_wd': w((L, D_FF, D_MODEL), D_FF),
    }


def reference(x, rel_bias, ffn1_norm, ffn1_wg, ffn1_wu, ffn1_wd, mix_norm, w_in,
              diff_q_norm, diff_k_norm, diff_lambda, diff_subln, dil_q_norm, dil_k_norm,
              mla_q_norm, mla_q_up, mla_kv_norm, mla_kv_up, mla_qn, mla_kn, w_o,
              ffn2_norm, ffn2_wg, ffn2_wu, ffn2_wd):
    B, S, _ = x.shape
    split_points = [int(p) for p in np.cumsum(IN_SIZES)[:-1]]
    diff_bias = rel_bias[:, :DIFF_HEADS]
    dil_bias = rel_bias[:, DIFF_HEADS:]
    for l in range(DEPTH):
        lambda_init = 0.8 - 0.6 * math.exp(-0.3 * (l + 1))
        x = x + 0.5 * swiglu(rms_norm(x, ffn1_norm[l]), ffn1_wg[l], ffn1_wu[l], ffn1_wd[l])
        h = rms_norm(x, mix_norm[l])
        dq, dk, dv, lq, lk, lv, mq, mkv = jnp.split(h @ w_in[l], split_points, axis=-1)
        dq = rms_norm(dq.reshape(B, S, DIFF_HEADS, 2, DIFF_QK_DIM), diff_q_norm[l]).transpose(0, 2, 1, 3, 4)
        dk = rms_norm(dk.reshape(B, S, DIFF_HEADS, 2, DIFF_QK_DIM), diff_k_norm[l]).transpose(0, 2, 1, 3, 4)
        dv = dv.reshape(B, S, DIFF_HEADS, DIFF_V_DIM).transpose(0, 2, 1, 3)
        lp = diff_lambda[l].astype(jnp.float32)
        lam = jnp.exp(jnp.sum(lp[0] * lp[1])) - jnp.exp(jnp.sum(lp[2] * lp[3])) + lambda_init
        out_a = diff_attention(dq, dk, dv, lam, lambda_init, diff_subln[l], diff_bias)
        out_a = out_a.transpose(0, 2, 1, 3).reshape(B, S, DIFF_WIDTH)
        lq = rms_norm(lq.reshape(B, S, DIL_HEADS, DIL_HEAD_DIM), dil_q_norm[l]).transpose(0, 2, 1, 3)
        lk = rms_norm(lk.reshape(B, S, DIL_HEADS, DIL_HEAD_DIM), dil_k_norm[l]).transpose(0, 2, 1, 3)
        lv = lv.reshape(B, S, DIL_HEADS, DIL_HEAD_DIM).transpose(0, 2, 1, 3)
        out_b = dilated_attention(lq, lk, lv, dil_bias).transpose(0, 2, 1, 3).reshape(B, S, DIL_WIDTH)
        out_c = mla_mixer(mq, mkv, mla_q_norm[l], mla_q_up[l], mla_kv_norm[l], mla_kv_up[l], mla_qn[l], mla_kn[l])
        mix = jnp.concatenate([out_a, out_b, out_c], axis=-1)
        x = x + mix @ w_o[l]
        x = x + 0.5 * swiglu(rms_norm(x, ffn2_norm[l]), ffn2_wg[l], ffn2_wu[l], ffn2_wd[l])
    return x
```

```cpp
#include <hip/hip_runtime.h>
#include <cstdio>
#include <cstdint>

#ifndef MK_ONE_LAUNCH
#define MK_ONE_LAUNCH 0
#endif

constexpr int DM = 1024, BATCH = 8, SEQ = 2048, DEPTH = 2, MTOK = BATCH * SEQ, DFF = 2816;
constexpr int IN_W = 2336, NIN = 2560;
constexpr float EPS = 1e-6f;
constexpr float LOG2E = 1.4426950408889634f;

namespace pg8 {
#define PG8_LAS __attribute__((address_space(3)))
typedef unsigned short bf16_t;
typedef short bf16x8 __attribute__((ext_vector_type(8)));
typedef float f32x4 __attribute__((ext_vector_type(4)));
typedef unsigned u32x4 __attribute__((ext_vector_type(4)));
typedef unsigned u32x2 __attribute__((ext_vector_type(2)));
constexpr int BM = 256, BK = 64, HALF = 128, HTB = HALF * BK * 2  , STAGE_BYTES = 8 * HTB, NXCD = 8, WGM = 8;

__host__ __device__ __forceinline__ int lds_byte(int r, int c) { const int st = (r >> 4) * 2 + (c >> 5), rr = r & 15, cc = c & 31, ob = rr * 64 + cc * 2; return st * 1024 + (ob ^ (((ob >> 9) & 1) << 5)); }
__host__ __device__ __forceinline__ void stage_rc(int b, int& R, int& C) { const int st = b / 1024, sb = b % 1024, swz = sb ^ (((sb >> 9) & 1) << 5); R = (st >> 1) * 16 + swz / 64; C = (st & 1) * 32 + (swz % 64) / 2; }
__host__ __device__ __forceinline__ int perm32(int rho) { const int n = rho >> 4, i = rho & 15; return 8 * (i >> 2) + 4 * n + (i & 3); }

struct Unit { int pm, pn; };
struct Gemm { const bf16_t* A; const bf16_t* Bt; int M, N, K, lda, ldb; };

struct StaticOrder {
    int nM, nN, nwg, G, c;
    __host__ __device__ void init(int M, int N, int G_, int c_) { nM = M / BM; nN = N / BM; nwg = nM * nN; G = G_; c = c_; }
    __host__ __device__ bool next(int i, Unit& u) const {
        const long L = (long)i * G + c; if (L >= nwg) return false;
        int wgid = (int)L; { const int q = nwg / NXCD, r = nwg % NXCD, xcd = wgid % NXCD, off = wgid / NXCD; wgid = (xcd < r ? xcd * (q + 1) : r * (q + 1) + (xcd - r) * q) + off; }
        const int nig = WGM * nN, gid = wgid / nig, fm = gid * WGM, gsz = (nM - fm) < WGM ? (nM - fm) : WGM;
        u.pm = fm + ((wgid % nig) % gsz); u.pn = (wgid % nig) / gsz; return true;
    }
    __device__ __forceinline__ void a_ready(const Unit&) const {}
    __device__ __forceinline__ void done(const Unit&) const {}
};

__device__ __forceinline__ unsigned cvt_pk_bf16(float lo, float hi) { unsigned r; asm volatile("v_cvt_pk_bf16_f32 %0, %1, %2" : "=v"(r) : "v"(lo), "v"(hi)); return r; }

__device__ __forceinline__ float rowscale16(const float* P, int row) {
    const f32x4* p = (const f32x4*)(P + (size_t)row * 16);
    const f32x4 a = p[0], b = p[1], c = p[2], d = p[3];
    const float s = ((a[0] + a[1]) + (a[2] + a[3])) + ((b[0] + b[1]) + (b[2] + b[3])) + ((c[0] + c[1]) + (c[2] + c[3])) + ((d[0] + d[1]) + (d[2] + d[3]));
    return __builtin_amdgcn_rsqf(s * (1.0f / 1024.0f) + EPS);
}
__device__ __forceinline__ u32x4 pack8(const float* v) { u32x4 w; w.x = cvt_pk_bf16(v[0], v[1]); w.y = cvt_pk_bf16(v[2], v[3]); w.z = cvt_pk_bf16(v[4], v[5]); w.w = cvt_pk_bf16(v[6], v[7]); return w; }
__device__ __forceinline__ float quad_sum(float s) { s += __shfl_xor(s, 16); s += __shfl_xor(s, 32); return s; }
#define EPI_OPAQUE() do { u.pm = __builtin_amdgcn_readfirstlane(u.pm); u.pn = __builtin_amdgcn_readfirstlane(u.pn); wr = __builtin_amdgcn_readfirstlane(wr); wc = __builtin_amdgcn_readfirstlane(wc); \
    asm volatile("" : "+s"(u.pm), "+s"(u.pn), "+s"(wr), "+s"(wc), "+v"(fr), "+v"(fq)); } while (0)
#define XS_BAR() do { asm volatile("s_waitcnt lgkmcnt(0)" ::: "memory"); __builtin_amdgcn_s_barrier(); asm volatile("" ::: "memory"); } while (0)

struct EpiSwiGLU {
    static constexpr bool PERM = true, AFTER_DRAIN = false;
    bf16_t* H; const float* P;
    __device__ __forceinline__ void operator()(const f32x4 (&acc)[2][2][4][2], const Unit& u_, int wr, int wc, int fr, int fq, PG8_LAS float* xs) const {
        Unit u = u_; EPI_OPAQUE();
#pragma unroll
        for (int ai = 0; ai < 2; ++ai)
#pragma unroll
            for (int m = 0; m < 4; ++m) {
                asm volatile("" ::: "memory");
                const int row = u.pm * BM + ai * HALF + wr * 64 + m * 16 + fr;
                const float r = rowscale16(P, row);
                float h[8];
#pragma unroll
                for (int n = 0; n < 2; ++n)
#pragma unroll
                    for (int j = 0; j < 4; ++j) {
                        const float g = acc[ai][0][m][n][j] * r, up = acc[ai][1][m][n][j] * r;
                        h[n * 4 + j] = g * __builtin_amdgcn_rcpf(1.0f + __builtin_amdgcn_exp2f(-g * LOG2E)) * up;
                    }
                *(u32x4*)(H + (size_t)row * DFF + u.pn * 128 + wc * 32 + fq * 8) = pack8(h);
            }
    }
};

struct EpiResid {
    static constexpr bool PERM = true, AFTER_DRAIN = false;
    float* X; bf16_t* XB; float* Pout; float alpha;
    __device__ __forceinline__ void operator()(const f32x4 (&acc)[2][2][4][2], const Unit& u_, int wr, int wc, int fr, int fq, PG8_LAS float* xs) const {
        Unit u = u_; EPI_OPAQUE();
#pragma unroll
        for (int ai = 0; ai < 2; ++ai)
#pragma unroll
            for (int m = 0; m < 4; ++m) {
                asm volatile("" ::: "memory");
                const int row = u.pm * BM + ai * HALF + wr * 64 + m * 16 + fr;
                float ss = 0.f;
#pragma unroll
                for (int bj = 0; bj < 2; ++bj) {
                    const size_t off = (size_t)row * DM + u.pn * BM + bj * HALF + wc * 32 + fq * 8;
                    const f32x4 o0 = *(const f32x4*)(X + off), o1 = *(const f32x4*)(X + off + 4);
                    const f32x4 v0 = o0 + acc[ai][bj][m][0] * alpha, v1 = o1 + acc[ai][bj][m][1] * alpha;
                    *(f32x4*)(X + off) = v0; *(f32x4*)(X + off + 4) = v1;
                    if (XB) { const float t[8] = {v0[0], v0[1], v0[2], v0[3], v1[0], v1[1], v1[2], v1[3]}; *(u32x4*)(XB + off) = pack8(t); }
                    ss += (v0[0] * v0[0] + v0[1] * v0[1]) + (v0[2] * v0[2] + v0[3] * v0[3]) + (v1[0] * v1[0] + v1[1] * v1[1]) + (v1[2] * v1[2] + v1[3] * v1[3]);
                }
                if (Pout) { ss = quad_sum(ss); if (fq == 0) Pout[(size_t)row * 16 + u.pn * 4 + wc] = ss; }
            }
    }
};

struct EpiInProj {
    static constexpr bool PERM = true, AFTER_DRAIN = false;
    const float* P;
    bf16_t *Qd, *Kd, *Vd, *Ql, *Kl, *Vl, *AQ; float *kr, *krss;
    const float *g_dq, *g_dk, *g_lq, *g_lk;
    float cdiff, cdil;
    __device__ __forceinline__ void operator()(const f32x4 (&acc)[2][2][4][2], const Unit& u_, int wr, int wc, int fr, int fq, PG8_LAS float* xs) const {
        Unit u = u_; EPI_OPAQUE();
        const int t = u.pn;
        if (t == 7 || t == 8) {
#pragma unroll
            for (int ai = 0; ai < 2; ++ai)
#pragma unroll
                for (int m = 0; m < 4; ++m) {
                    const int rl = ai * HALF + wr * 64 + m * 16 + fr;
                    float ss = 0.f;
#pragma unroll
                    for (int bj = 0; bj < 2; ++bj)
#pragma unroll
                        for (int n = 0; n < 2; ++n) { const f32x4 a = acc[ai][bj][m][n]; ss += (a[0] * a[0] + a[1] * a[1]) + (a[2] * a[2] + a[3] * a[3]); }
                    ss = quad_sum(ss);
                    if (fq == 0) xs[rl * 4 + wc] = ss;
                }
            XS_BAR();
        }
#pragma unroll
        for (int ai = 0; ai < 2; ++ai)
#pragma unroll
            for (int m = 0; m < 4; ++m) {
                asm volatile("" ::: "memory");
                const int rl = ai * HALF + wr * 64 + m * 16 + fr, row = u.pm * BM + rl, b = row >> 11, s = row & (SEQ - 1);
                const float r = rowscale16(P, row);
                float v[2][8];
#pragma unroll
                for (int bj = 0; bj < 2; ++bj)
#pragma unroll
                    for (int n = 0; n < 2; ++n)
#pragma unroll
                        for (int j = 0; j < 4; ++j) v[bj][n * 4 + j] = acc[ai][bj][m][n][j] * r;
                if (t <= 1) {
                    const float* g = t == 0 ? g_dq : g_dk; bf16_t* dst = t == 0 ? Qd : Kd; const float post = t == 0 ? cdiff : 1.0f;
#pragma unroll
                    for (int bj = 0; bj < 2; ++bj) {
                        float ss = 0.f;
#pragma unroll
                        for (int i = 0; i < 8; ++i) ss += v[bj][i] * v[bj][i];
                        ss = quad_sum(ss);
                        const float rn = __builtin_amdgcn_rsqf(ss * (1.0f / 32.0f) + EPS) * post;
                        float o[8];
#pragma unroll
                        for (int i = 0; i < 8; ++i) o[i] = v[bj][i] * rn * g[fq * 8 + i];
                        *(u32x4*)(dst + ((size_t)(((b * 4 + wc) * 2 + bj) * SEQ + s)) * 32 + fq * 8) = pack8(o);
                    }
                } else if (t == 2) {
#pragma unroll
                    for (int bj = 0; bj < 2; ++bj) *(u32x4*)(Vd + ((size_t)((b * 4 + wc) * SEQ + s)) * 64 + bj * 32 + fq * 8) = pack8(v[bj]);
                } else if (t <= 5) {
                    const bool isq = (t == 3) || (t == 4 && wc < 2);
                    const int head = (t == 3) ? wc : (t == 4 ? (wc < 2 ? 4 + wc : wc - 2) : wc + 2);
                    const float* g = isq ? g_lq : g_lk; bf16_t* dst = isq ? Ql : Kl; const float post = isq ? cdil : 1.0f;
                    float ss = 0.f;
#pragma unroll
                    for (int bj = 0; bj < 2; ++bj)
#pragma unroll
                        for (int i = 0; i < 8; ++i) ss += v[bj][i] * v[bj][i];
                    ss = quad_sum(ss);
                    const float rn = __builtin_amdgcn_rsqf(ss * (1.0f / 64.0f) + EPS) * post;
#pragma unroll
                    for (int bj = 0; bj < 2; ++bj) {
                        float o[8];
#pragma unroll
                        for (int i = 0; i < 8; ++i) o[i] = v[bj][i] * rn * g[bj * 32 + fq * 8 + i];
                        *(u32x4*)(dst + ((size_t)((b * 6 + head) * SEQ + s)) * 64 + bj * 32 + fq * 8) = pack8(o);
                    }
                } else if (t == 6 || (t == 7 && wc < 2)) {
                    const int head = t == 6 ? wc : 4 + wc;
#pragma unroll
                    for (int bj = 0; bj < 2; ++bj) *(u32x4*)(Vl + ((size_t)((b * 6 + head) * SEQ + s)) * 64 + bj * 32 + fq * 8) = pack8(v[bj]);
                } else if (t == 7) {
                    const float ss = (xs[rl * 4 + 2] + xs[rl * 4 + 3]) * r * r;
                    const float rn = __builtin_amdgcn_rsqf(ss * (1.0f / 128.0f) + EPS);
#pragma unroll
                    for (int bj = 0; bj < 2; ++bj) {
                        float o[8];
#pragma unroll
                        for (int i = 0; i < 8; ++i) o[i] = v[bj][i] * rn;
                        *(u32x4*)(AQ + (size_t)row * 384 + 256 + (wc - 2) * 64 + bj * 32 + fq * 8) = pack8(o);
                    }
                } else if (t == 8) {
                    const float ss = ((xs[rl * 4 + 0] + xs[rl * 4 + 1]) + (xs[rl * 4 + 2] + xs[rl * 4 + 3])) * r * r;
                    const float rn = __builtin_amdgcn_rsqf(ss * (1.0f / 256.0f) + EPS);
#pragma unroll
                    for (int bj = 0; bj < 2; ++bj) {
                        float o[8];
#pragma unroll
                        for (int i = 0; i < 8; ++i) o[i] = v[bj][i] * rn;
                        *(u32x4*)(AQ + (size_t)row * 384 + bj * 128 + wc * 32 + fq * 8) = pack8(o);
                    }
                } else {
                    if (wc == 0) {
                        float ss = 0.f;
#pragma unroll
                        for (int bj = 0; bj < 2; ++bj)
#pragma unroll
                            for (int i = 0; i < 8; ++i) ss += v[bj][i] * v[bj][i];
                        ss = quad_sum(ss);
                        if (fq < 2) {
#pragma unroll
                            for (int bj = 0; bj < 2; ++bj) {
                                *(f32x4*)(kr + (size_t)row * 32 + bj * 16 + fq * 8) = (f32x4){v[bj][0], v[bj][1], v[bj][2], v[bj][3]};
                                *(f32x4*)(kr + (size_t)row * 32 + bj * 16 + fq * 8 + 4) = (f32x4){v[bj][4], v[bj][5], v[bj][6], v[bj][7]};
                            }
                        }
                        if (fq == 0) krss[row] = ss;
                    }
                }
            }
    }
};

struct EpiMlaQ {
    static constexpr bool PERM = true, AFTER_DRAIN = false;
    bf16_t* Qc; const float* qn; const float* cs; const float* sn; float cmla;
    __device__ __forceinline__ void operator()(const f32x4 (&acc)[2][2][4][2], const Unit& u_, int wr, int wc, int fr, int fq, PG8_LAS float* xs) const {
        Unit u = u_; EPI_OPAQUE();
#pragma unroll
        for (int ai = 0; ai < 2; ++ai)
#pragma unroll
            for (int m = 0; m < 4; ++m) {
                const int rl = ai * HALF + wr * 64 + m * 16 + fr;
                float ss = 0.f;
#pragma unroll
                for (int bj = 0; bj < 2; ++bj)
#pragma unroll
                    for (int n = 0; n < 2; ++n) { const f32x4 a = acc[ai][bj][m][n]; ss += (a[0] * a[0] + a[1] * a[1]) + (a[2] * a[2] + a[3] * a[3]); }
                ss = quad_sum(ss);
                if (fq == 0) xs[rl * 4 + wc] = ss;
            }
        XS_BAR();
        const int hs = wc >> 1, head = u.pn * 2 + hs; const bool rope = wc & 1;
#pragma unroll
        for (int ai = 0; ai < 2; ++ai)
#pragma unroll
            for (int m = 0; m < 4; ++m) {
                asm volatile("" ::: "memory");
                const int rl = ai * HALF + wr * 64 + m * 16 + fr, row = u.pm * BM + rl, b = row >> 11, s = row & (SEQ - 1);
                const float ss = xs[rl * 4 + hs * 2] + xs[rl * 4 + hs * 2 + 1];
                const float rn = __builtin_amdgcn_rsqf(ss * (1.0f / 96.0f) + EPS) * cmla;
                bf16_t* dst = Qc + ((size_t)((b * 6 + head) * SEQ + s)) * 96;
                if (!rope) {
#pragma unroll
                    for (int bj = 0; bj < 2; ++bj) {
                        float o[8];
#pragma unroll
                        for (int n = 0; n < 2; ++n)
#pragma unroll
                            for (int j = 0; j < 4; ++j) o[n * 4 + j] = acc[ai][bj][m][n][j] * rn * qn[bj * 32 + fq * 8 + n * 4 + j];
                        *(u32x4*)(dst + bj * 32 + fq * 8) = pack8(o);
                    }
                } else if (fq < 2) {
                    float o1[8], o2[8];
#pragma unroll
                    for (int n = 0; n < 2; ++n)
#pragma unroll
                        for (int j = 0; j < 4; ++j) {
                            const int i = fq * 8 + n * 4 + j;
                            const float x1 = acc[ai][0][m][n][j] * rn * qn[64 + i], x2 = acc[ai][1][m][n][j] * rn * qn[80 + i];
                            const float c = cs[s * 16 + i], sv = sn[s * 16 + i];
                            o1[n * 4 + j] = x1 * c - x2 * sv; o2[n * 4 + j] = x1 * sv + x2 * c;
                        }
                    *(u32x4*)(dst + 64 + fq * 8) = pack8(o1);
                    *(u32x4*)(dst + 80 + fq * 8) = pack8(o2);
                }
            }
    }
};

struct EpiMlaKV {
    static constexpr bool PERM = true, AFTER_DRAIN = false;
    bf16_t *Kc, *Vc; const float *kn, *kr, *krss, *cs, *sn;
    __device__ __forceinline__ void operator()(const f32x4 (&acc)[2][2][4][2], const Unit& u_, int wr, int wc, int fr, int fq, PG8_LAS float* xs) const {
        Unit u = u_; EPI_OPAQUE();
        const int hs = wc >> 1, head = u.pn * 2 + hs; const bool isv = wc & 1;
#pragma unroll
        for (int ai = 0; ai < 2; ++ai)
#pragma unroll
            for (int m = 0; m < 4; ++m) {
                asm volatile("" ::: "memory");
                const int rl = ai * HALF + wr * 64 + m * 16 + fr, row = u.pm * BM + rl, b = row >> 11, s = row & (SEQ - 1);
                if (isv) {
#pragma unroll
                    for (int bj = 0; bj < 2; ++bj) {
                        float o[8];
#pragma unroll
                        for (int n = 0; n < 2; ++n)
#pragma unroll
                            for (int j = 0; j < 4; ++j) o[n * 4 + j] = acc[ai][bj][m][n][j];
                        *(u32x4*)(Vc + ((size_t)((b * 6 + head) * SEQ + s)) * 64 + bj * 32 + fq * 8) = pack8(o);
                    }
                } else {
                    float ss = 0.f;
#pragma unroll
                    for (int bj = 0; bj < 2; ++bj)
#pragma unroll
                        for (int n = 0; n < 2; ++n) { const f32x4 a = acc[ai][bj][m][n]; ss += (a[0] * a[0] + a[1] * a[1]) + (a[2] * a[2] + a[3] * a[3]); }
                    ss = quad_sum(ss) + krss[row];
                    const float rn = __builtin_amdgcn_rsqf(ss * (1.0f / 96.0f) + EPS);
                    bf16_t* dst = Kc + ((size_t)((b * 6 + head) * SEQ + s)) * 96;
#pragma unroll
                    for (int bj = 0; bj < 2; ++bj) {
                        float o[8];
#pragma unroll
                        for (int n = 0; n < 2; ++n)
#pragma unroll
                            for (int j = 0; j < 4; ++j) o[n * 4 + j] = acc[ai][bj][m][n][j] * rn * kn[bj * 32 + fq * 8 + n * 4 + j];
                        *(u32x4*)(dst + bj * 32 + fq * 8) = pack8(o);
                    }
                    const f32x4 k1 = *(const f32x4*)(kr + (size_t)row * 32 + fq * 4), k2 = *(const f32x4*)(kr + (size_t)row * 32 + 16 + fq * 4);
                    float o1[4], o2[4];
#pragma unroll
                    for (int j = 0; j < 4; ++j) {
                        const int i = fq * 4 + j;
                        const float x1 = k1[j] * rn * kn[64 + i], x2 = k2[j] * rn * kn[80 + i];
                        const float c = cs[s * 16 + i], sv = sn[s * 16 + i];
                        o1[j] = x1 * c - x2 * sv; o2[j] = x1 * sv + x2 * c;
                    }
                    *(u32x2*)(dst + 64 + fq * 4) = (u32x2){cvt_pk_bf16(o1[0], o1[1]), cvt_pk_bf16(o1[2], o1[3])};
                    *(u32x2*)(dst + 80 + fq * 4) = (u32x2){cvt_pk_bf16(o2[0], o2[1]), cvt_pk_bf16(o2[2], o2[3])};
                }
            }
    }
};
template <class Epi, class Sched, bool ALIGN_EPI = false, bool SP2 = false>
__device__ __forceinline__ void gemm_phase(const int tid, PG8_LAS unsigned char* lds, PG8_LAS float* xs, const Gemm g, const Sched& S, const Epi& E) {
    const int wid = __builtin_amdgcn_readfirstlane(tid >> 6), lane = tid & 63, wr = wid >> 2, wc = wid & 3, fr = lane & 15, fq = lane >> 4;
    const int K = g.K, nt = K / BK;
    unsigned voffA[2], voffB[2];
#pragma unroll
    for (int i = 0; i < 2; ++i) { int R, C; stage_rc(tid * 16 + i * 8192, R, C); const int Rb = Epi::PERM ? ((R & ~31) + perm32(R & 31)) : R;
        voffA[i] = (unsigned)(R * g.lda + C) * 2u; voffB[i] = (unsigned)(Rb * g.ldb + C) * 2u; }
    const size_t kstep = (size_t)(BK * 2);
    const size_t hstepA = (size_t)HALF * g.lda * 2, hstepB = (size_t)HALF * g.ldb * 2;
    const size_t tstepA = 2 * hstepA, tstepB = 2 * hstepB;
    const unsigned ldsw = (unsigned)wid * 1024u;
    const int aoff = lds_byte(wr * 64 + fr, fq * 8), boff = lds_byte(wc * 32 + fr, fq * 8);
#define PG8_SA(b, h) (((b) * 2 + (h)) * HTB)
#define PG8_SB(b, h) ((4 + (b) * 2 + (h)) * HTB)
#define PG8_STAGE(bufoff, gbase, voff) do { _Pragma("unroll") for (int _i = 0; _i < 2; ++_i) \
        __builtin_amdgcn_global_load_lds((const unsigned*)((const char*)(gbase) + (voff)[_i]), (PG8_LAS unsigned*)(lds + (bufoff) + ldsw + _i * 8192), 16, 0, 0); } while (0)
#define PG8_LDA(dst, b, h) do { _Pragma("unroll") for (int m = 0; m < 4; ++m) _Pragma("unroll") for (int k = 0; k < 2; ++k) dst[m][k] = *(const PG8_LAS bf16x8*)(lds + PG8_SA(b, h) + aoff + m * 2048 + k * 1024); } while (0)
#define PG8_LDB(dst, b, h) do { _Pragma("unroll") for (int n = 0; n < 2; ++n) _Pragma("unroll") for (int k = 0; k < 2; ++k) dst[n][k] = *(const PG8_LAS bf16x8*)(lds + PG8_SB(b, h) + boff + n * 2048 + k * 1024); } while (0)
#define PG8_MMA(ai, bj, At, Bt) do { __builtin_amdgcn_s_setprio(1); _Pragma("unroll") for (int m = 0; m < 4; ++m) _Pragma("unroll") for (int n = 0; n < 2; ++n) _Pragma("unroll") for (int k = 0; k < 2; ++k) \
        acc[ai][bj][m][n] = __builtin_amdgcn_mfma_f32_16x16x32_bf16(Bt[n][k], At[m][k], acc[ai][bj][m][n], 0, 0, 0); __builtin_amdgcn_s_setprio(0); } while (0)
#define PG8_WAIT_V(n) asm volatile("s_waitcnt vmcnt(" #n ")" ::: "memory")
#define PG8_WAIT_L(n) asm volatile("s_waitcnt lgkmcnt(" #n ")" ::: "memory")
#define PG8_BAR __builtin_amdgcn_s_barrier()
#define PG8_SCHED __builtin_amdgcn_sched_barrier(0)
    Unit cur, nxt; int ui = 0;
    if (!S.next(0, cur)) return;
    f32x4 acc[2][2][4][2];
#pragma unroll
    for (int a = 0; a < 2; ++a)
#pragma unroll
        for (int b = 0; b < 2; ++b)
#pragma unroll
            for (int m = 0; m < 4; ++m)
#pragma unroll
                for (int n = 0; n < 2; ++n) acc[a][b][m][n] = (f32x4){0.f, 0.f, 0.f, 0.f};
    bf16x8 At[4][2], B0[2][2], B1[2][2];
    const char* cA = (const char*)g.A + (size_t)cur.pm * tstepA; const char* cB = (const char*)g.Bt + (size_t)cur.pn * tstepB;
    S.a_ready(cur);
    if constexpr (SP2) {
        PG8_STAGE(PG8_SB(0, 0), cB, voffB); PG8_STAGE(PG8_SB(0, 1), cB + hstepB, voffB); PG8_STAGE(PG8_SA(0, 0), cA, voffA); PG8_STAGE(PG8_SA(0, 1), cA + hstepA, voffA);
        if (wr == 1) PG8_BAR;
        PG8_WAIT_V(2); PG8_BAR;
        PG8_STAGE(PG8_SB(1, 0), cB + kstep, voffB); PG8_STAGE(PG8_SA(1, 0), cA + kstep, voffA); PG8_STAGE(PG8_SB(1, 1), cB + hstepB + kstep, voffB);
        PG8_WAIT_V(6); PG8_BAR;
    } else {
        PG8_STAGE(PG8_SB(0, 0), cB, voffB); PG8_STAGE(PG8_SA(0, 0), cA, voffA); PG8_STAGE(PG8_SB(0, 1), cB + hstepB, voffB); PG8_STAGE(PG8_SA(0, 1), cA + hstepA, voffA);
        if (wr == 1) PG8_BAR;
        PG8_WAIT_V(4); PG8_BAR;
        PG8_STAGE(PG8_SB(1, 0), cB + kstep, voffB); PG8_STAGE(PG8_SA(1, 0), cA + kstep, voffA); PG8_STAGE(PG8_SB(1, 1), cB + hstepB + kstep, voffB);
        PG8_WAIT_V(6); PG8_BAR;
    }
    for (;;) {
        const bool has_next = S.next(ui + 1, nxt);
        const char* nA = has_next ? (const char*)g.A + (size_t)nxt.pm * tstepA : cA; const char* nB = has_next ? (const char*)g.Bt + (size_t)nxt.pn * tstepB : cB;
        for (int t = 0; t < nt; t += 2) {
            const bool last = (t == nt - 2);
            const char* a1 = cA + (size_t)(t + 1) * kstep;
            const char* a2 = last ? nA : cA + (size_t)(t + 2) * kstep; const char* b2 = last ? nB : cB + (size_t)(t + 2) * kstep;
            const char* a3 = a2 + kstep; const char* b3 = b2 + kstep;
            if (last && has_next) S.a_ready(nxt);
            if constexpr (SP2) {
            PG8_LDB(B0, 0, 0); PG8_LDB(B1, 0, 1); PG8_SCHED; PG8_LDA(At, 0, 0); PG8_STAGE(PG8_SA(1, 1), a1 + hstepA, voffA);
            PG8_WAIT_V(8); PG8_WAIT_L(0); PG8_BAR; PG8_MMA(0, 0, At, B0); PG8_MMA(0, 1, At, B1); PG8_BAR; PG8_SCHED;
            PG8_LDA(At, 0, 1); PG8_STAGE(PG8_SB(0, 0), b2, voffB); PG8_STAGE(PG8_SB(0, 1), b2 + hstepB, voffB); PG8_STAGE(PG8_SA(0, 0), a2, voffA);
            PG8_WAIT_V(8); PG8_WAIT_L(0); PG8_BAR; PG8_MMA(1, 0, At, B0); PG8_MMA(1, 1, At, B1); PG8_BAR; PG8_SCHED;
            PG8_LDB(B0, 1, 0); PG8_LDB(B1, 1, 1); PG8_SCHED; PG8_LDA(At, 1, 0); PG8_STAGE(PG8_SA(0, 1), a2 + hstepA, voffA);
            PG8_WAIT_V(8); PG8_WAIT_L(0); PG8_BAR; PG8_MMA(0, 0, At, B0); PG8_MMA(0, 1, At, B1); PG8_BAR; PG8_SCHED;
            PG8_LDA(At, 1, 1); PG8_STAGE(PG8_SB(1, 0), b3, voffB); PG8_STAGE(PG8_SB(1, 1), b3 + hstepB, voffB); PG8_STAGE(PG8_SA(1, 0), a3, voffA);
            PG8_WAIT_V(8); PG8_WAIT_L(0); PG8_BAR; PG8_MMA(1, 0, At, B0); PG8_MMA(1, 1, At, B1); PG8_BAR; PG8_SCHED;
            } else {
            PG8_LDB(B0, 0, 0); PG8_SCHED; PG8_LDA(At, 0, 0); PG8_STAGE(PG8_SA(1, 1), a1 + hstepA, voffA);
            PG8_WAIT_L(8); PG8_BAR; PG8_WAIT_L(0); PG8_MMA(0, 0, At, B0); PG8_BAR; PG8_SCHED;
            PG8_LDB(B1, 0, 1); PG8_STAGE(PG8_SB(0, 0), b2, voffB);
            PG8_BAR; PG8_WAIT_L(0); PG8_MMA(0, 1, At, B1); PG8_BAR;
            PG8_LDA(At, 0, 1); PG8_STAGE(PG8_SA(0, 0), a2, voffA);
            PG8_BAR; PG8_WAIT_L(0); PG8_MMA(1, 0, At, B0); PG8_BAR; PG8_SCHED;
            PG8_STAGE(PG8_SB(0, 1), b2 + hstepB, voffB);
            PG8_WAIT_V(6); PG8_BAR; PG8_MMA(1, 1, At, B1); PG8_BAR;
            PG8_LDB(B0, 1, 0); PG8_SCHED; PG8_LDA(At, 1, 0); PG8_STAGE(PG8_SA(0, 1), a2 + hstepA, voffA);
            PG8_WAIT_L(8); PG8_BAR; PG8_WAIT_L(0); PG8_MMA(0, 0, At, B0); PG8_BAR; PG8_SCHED;
            PG8_LDB(B1, 1, 1); PG8_STAGE(PG8_SB(1, 0), b3, voffB);
            PG8_BAR; PG8_WAIT_L(0); PG8_MMA(0, 1, At, B1); PG8_BAR;
            PG8_LDA(At, 1, 1); PG8_STAGE(PG8_SA(1, 0), a3, voffA);
            PG8_BAR; PG8_WAIT_L(0); PG8_MMA(1, 0, At, B0); PG8_BAR; PG8_SCHED;
            PG8_STAGE(PG8_SB(1, 1), b3 + hstepB, voffB);
            PG8_WAIT_V(6); PG8_BAR; PG8_MMA(1, 1, At, B1); PG8_BAR;
            }
        }
        if constexpr (ALIGN_EPI) { if (wr == 0) PG8_BAR; }
        if constexpr (!Epi::AFTER_DRAIN) { E(acc, cur, wr, wc, fr, fq, xs); S.done(cur); }
        if (!has_next) break;
#pragma unroll
        for (int a = 0; a < 2; ++a)
#pragma unroll
            for (int b = 0; b < 2; ++b)
#pragma unroll
                for (int m = 0; m < 4; ++m)
#pragma unroll
                    for (int n = 0; n < 2; ++n) acc[a][b][m][n] = (f32x4){0.f, 0.f, 0.f, 0.f};
        cur = nxt; cA = nA; cB = nB; ++ui;
        if constexpr (ALIGN_EPI) { if (wr == 1) PG8_BAR; }
    }
    PG8_WAIT_V(0);
    if constexpr (!ALIGN_EPI) { if (wr == 0) PG8_BAR; }
    PG8_BAR;
    if constexpr (Epi::AFTER_DRAIN) { E(acc, cur, wr, wc, fr, fq, xs); S.done(cur); }
#undef PG8_SA
#undef PG8_SB
#undef PG8_STAGE
#undef PG8_LDA
#undef PG8_LDB
#undef PG8_MMA
#undef PG8_WAIT_V
#undef PG8_WAIT_L
#undef PG8_BAR
#undef PG8_SCHED
}
}

constexpr size_t MiB = 1u << 20;
constexpr size_t WS_CTL = 0, CTL_ZERO_BYTES = 1 * MiB;
constexpr size_t WS_TAB = 1 * MiB;
constexpr size_t WS_P = 2 * MiB;
constexpr size_t WS_KR = 5 * MiB;
constexpr size_t WS_KRSS = 7 * MiB;
constexpr size_t WS_W = 8 * MiB;
constexpr size_t W_GU1 = WS_W, W_GU2 = W_GU1 + 11 * MiB, W_D1 = W_GU2 + 11 * MiB, W_D2 = W_D1 + 5632 * 1024, W_IN = W_D2 + 5632 * 1024, W_O = W_IN + 5 * MiB, W_QU = W_O + 2 * MiB, W_KVU = W_QU + 768 * 256 * 2, W_END = W_KVU + 768 * 256 * 2;
static_assert(W_END <= 50 * MiB, "weights");
constexpr size_t WS_XB = 50 * MiB;
constexpr size_t WS_R = 82 * MiB;
constexpr size_t WS_H = WS_R;
constexpr size_t WS_QD = WS_R, WS_KD = WS_QD + 8 * MiB, WS_VD = WS_KD + 8 * MiB, WS_QL = WS_VD + 8 * MiB, WS_KL = WS_QL + 12 * MiB, WS_VL = WS_KL + 12 * MiB;
constexpr size_t WS_QC = WS_VL + 12 * MiB, WS_KC = WS_QC + 18 * MiB, WS_VC = WS_KC + 18 * MiB, WS_AQ = WS_VC + 12 * MiB, WS_MIX = WS_AQ + 12 * MiB, WS_END = WS_MIX + 32 * MiB;
static_assert(WS_END <= 256 * MiB && WS_H + (size_t)MTOK * DFF * 2 <= WS_MIX, "d_ws map");
constexpr int TAB_COS = 0, TAB_SIN = 32768;
constexpr int TAB_BD = 65536;
constexpr int TAB_BL = TAB_BD + 2 * 4 * 4096;
constexpr int TAB_SC = TAB_BL + 2 * 6 * 4096;
static_assert((TAB_SC + 64) * 4 <= (int)MiB, "tables");
constexpr int CW_BAR = 4096;

constexpr int RING_BYTES = 131072, XS_OFF = RING_BYTES, XS_BYTES = 4096, MISC_OFF = XS_OFF + XS_BYTES, LDS_BYTES = 147456;

#define GAS __attribute__((address_space(1)))
#define LAS __attribute__((address_space(3)))
typedef unsigned short bf16;
typedef unsigned v4u __attribute__((ext_vector_type(4)));
typedef float f32x4 __attribute__((ext_vector_type(4)));
typedef GAS unsigned gu32;
#define RLX_AGENT __ATOMIC_RELAXED, __HIP_MEMORY_SCOPE_AGENT
#define LDS_WAIT() asm volatile("s_waitcnt lgkmcnt(0)" ::: "memory")
__device__ __forceinline__ unsigned f2bf(float f) { unsigned u = __builtin_bit_cast(unsigned, f); return (u + 0x7fffu + ((u >> 16) & 1u)) >> 16; }
__device__ __forceinline__ unsigned pk2(float lo, float hi) { return f2bf(lo) | (f2bf(hi) << 16); }
__device__ __forceinline__ float bflo(unsigned w) { return __builtin_bit_cast(float, w << 16); }
__device__ __forceinline__ float bfhi(unsigned w) { return __builtin_bit_cast(float, w & 0xffff0000u); }
__device__ __forceinline__ void unpack8(v4u w, float* o) { o[0] = bflo(w.x); o[1] = bfhi(w.x); o[2] = bflo(w.y); o[3] = bfhi(w.y); o[4] = bflo(w.z); o[5] = bfhi(w.z); o[6] = bflo(w.w); o[7] = bfhi(w.w); }

#define XB_TMO      128
#define XB_XCNT(j)  (256  + 64 * (j))
#define XB_XSUB(j)  (1280 + 64 * (j))
#define XB_XGEN(j)  (2304 + 64 * (j))
#define XB_TOP      3328
#define XB_TOPGEN   3392
#define XCD_BAR_WORDS 3456
#define XB_SPIN_CAP (1u << 22)

__device__ __forceinline__ unsigned xb_ld(unsigned* p)              { return __hip_atomic_load(p, __ATOMIC_RELAXED, __HIP_MEMORY_SCOPE_AGENT); }
__device__ __forceinline__ unsigned xb_add(unsigned* p, unsigned v) { return __hip_atomic_fetch_add(p, v, __ATOMIC_RELAXED, __HIP_MEMORY_SCOPE_AGENT); }
__device__ __forceinline__ unsigned xb_xcc_id() { return (unsigned)__builtin_amdgcn_s_getreg((3 << 11) | 20) & 0xFu; }
#define XB_SPIN(cond, bar) do { unsigned _sp = 0; while (cond) { __builtin_amdgcn_s_sleep(1); \
    if ((++_sp & 255u) == 0u) { if (xb_ld(&(bar)[XB_TMO])) break; if (_sp > XB_SPIN_CAP) { atomicAdd(&(bar)[XB_TMO], 1u); break; } } } } while (0)

struct XcdBarrier { unsigned* bar; unsigned x; volatile LAS unsigned* st; };

__device__ __forceinline__ XcdBarrier xcd_barrier_post(unsigned* bar, volatile LAS unsigned* st) {
    XcdBarrier b; b.bar = bar; b.x = xb_xcc_id(); b.st = st;
    if (threadIdx.x == 0) (void)xb_add(&bar[XB_XCNT(b.x)], 1u);
    return b;
}
__device__ __forceinline__ void xcd_barrier_complete(unsigned* bar, unsigned x, unsigned& nloc, unsigned& nx) {
    const unsigned G = gridDim.x * gridDim.y * gridDim.z;
    unsigned sum, cnt, mine, sp = 0u;
    for (;;) {
        sum = 0u; cnt = 0u; mine = 0u;
#pragma unroll
        for (unsigned j = 0; j < 16; ++j) { const unsigned c = xb_ld(&bar[XB_XCNT(j)]); sum += c; cnt += (c > 0u) ? 1u : 0u; mine = (j == x) ? c : mine; }
        if (sum == G) break;
        __builtin_amdgcn_s_sleep(1);
        if ((++sp & 255u) == 0u) { if (xb_ld(&bar[XB_TMO])) break; if (sp > XB_SPIN_CAP) { atomicAdd(&bar[XB_TMO], 1u); break; } }
    }
    nloc = mine > 0u ? mine : 1u; nx = cnt > 0u ? cnt : 1u;
}
__device__ __forceinline__ void xcd_barrier(const XcdBarrier& b) {
    asm volatile("s_waitcnt vmcnt(0)" ::: "memory");
    __syncthreads();
    if (threadIdx.x == 0) {
        unsigned* bar = b.bar;
        __builtin_amdgcn_s_waitcnt(0);
        unsigned nloc = b.st[0], nx = b.st[1];
        if (nloc == 0u) { xcd_barrier_complete(bar, b.x, nloc, nx); b.st[0] = nloc; b.st[1] = nx; }
        const unsigned old = xb_add(&bar[XB_XSUB(b.x)], 1u);
        const unsigned gen = old / nloc;
        if (old + 1u == (gen + 1u) * nloc) {
            __builtin_amdgcn_fence(__ATOMIC_RELEASE, "agent");
            asm volatile("s_waitcnt vmcnt(0)" ::: "memory");
            const unsigned og = xb_add(&bar[XB_TOP], 1u);
            const unsigned tg = og / nx;
            if (og + 1u == (tg + 1u) * nx) xb_add(&bar[XB_TOPGEN], 1u);
            else XB_SPIN(xb_ld(&bar[XB_TOPGEN]) == tg, bar);
            __builtin_amdgcn_fence(__ATOMIC_ACQUIRE, "agent");
            xb_add(&bar[XB_XGEN(b.x)], 1u);
            asm volatile("s_waitcnt vmcnt(0)" ::: "memory");
        } else {
            XB_SPIN(xb_ld(&bar[XB_XGEN(b.x)]) == gen, bar);
            __builtin_amdgcn_fence(__ATOMIC_ACQUIRE, "agent");
            asm volatile("s_waitcnt vmcnt(0)" ::: "memory");
        }
    }
    __syncthreads();
}

struct Args { const float* in[25]; float* out; unsigned char* ws; int layer, pad; };
enum { I_X = 0, I_RELB, I_F1N, I_F1G, I_F1U, I_F1D, I_MIXN, I_WIN, I_DQN, I_DKN, I_DLAM, I_DSUB, I_LQN, I_LKN, I_MQN, I_MQU, I_MKVN, I_MKVU, I_MQNG, I_MKNG, I_WO, I_F2N, I_F2G, I_F2U, I_F2D };

__device__ __forceinline__ float wave_sum(float v) {
#pragma unroll
    for (int o = 1; o < 64; o <<= 1) v += __shfl_xor(v, o);
    return v;
}
__device__ __forceinline__ float wave_max(float v) {
#pragma unroll
    for (int o = 1; o < 64; o <<= 1) v = fmaxf(v, __shfl_xor(v, o));
    return v;
}

__device__ __forceinline__ void tr_item(const float* W, int Nsrc, int ks0, const float* gain, int sc, int nvalid, bf16* dst, int ldb, LAS float* scr, int lane) {
#pragma unroll 8
    for (int i = 0; i < 32; ++i) {
        const int kk = 2 * i + (lane >> 5), c = lane & 31;
        float v = 0.f;
        if (W != nullptr && c < nvalid) { v = W[(size_t)(ks0 + kk) * Nsrc + sc + c]; if (gain) v *= gain[ks0 + kk]; }
        scr[kk * 33 + c] = v;
    }
    LDS_WAIT(); asm volatile("" ::: "memory");
    const int c = lane & 7;
#pragma unroll
    for (int j = 0; j < 4; ++j) { const int n = (lane >> 3) + 8 * j; const LAS float* s = scr + (8 * c) * 33 + n;
        v4u o; o.x = pk2(s[0 * 33], s[1 * 33]); o.y = pk2(s[2 * 33], s[3 * 33]); o.z = pk2(s[4 * 33], s[5 * 33]); o.w = pk2(s[6 * 33], s[7 * 33]);
        *(GAS v4u*)(dst + (size_t)n * ldb + 8 * c) = o; }
    LDS_WAIT(); asm volatile("" ::: "memory");
}

__device__ __forceinline__ void win_map(int g, int& sc, int& nvalid) {
    const int pn = g >> 3, gi = g & 7, bj = gi >> 2, wc = gi & 3; nvalid = 32;
    switch (pn) {
        case 0: sc = 0 + wc * 64 + bj * 32; break;
        case 1: sc = 256 + wc * 64 + bj * 32; break;
        case 2: sc = 512 + wc * 64 + bj * 32; break;
        case 3: sc = 768 + wc * 64 + bj * 32; break;
        case 4: sc = (wc < 2) ? 768 + (4 + wc) * 64 + bj * 32 : 1152 + (wc - 2) * 64 + bj * 32; break;
        case 5: sc = 1152 + (wc + 2) * 64 + bj * 32; break;
        case 6: sc = 1536 + wc * 64 + bj * 32; break;
        case 7: sc = (wc < 2) ? 1536 + (4 + wc) * 64 + bj * 32 : 2176 + (wc - 2) * 64 + bj * 32; break;
        case 8: sc = 1920 + bj * 128 + wc * 32; break;
        default: sc = 2176 + 128 + bj * 16; nvalid = (wc == 0) ? 16 : 0; break;
    }
}

__device__ __forceinline__ void convert_weights(const Args& a, unsigned char* ws, int l, LAS float* scr, int gw, int NGW, int lane) {
    constexpr int I_GU = (5632 / 32) * 16, I_D = 32 * 44, I_IN = 80 * 16, I_O = 32 * 16, I_QU = 24 * 4, I_KVU = 24 * 4;
    constexpr int NITEMS = 2 * I_GU + 2 * I_D + I_IN + I_O + I_QU + I_KVU;
    for (int it = gw; it < NITEMS; it += NGW) {
        int r = it;
        if (r < 2 * I_GU) {
            const int f = r / I_GU; r -= f * I_GU; const int g = r >> 4, kb = r & 15;
            const int pn = g >> 3, gi = g & 7, bj = gi >> 2, wc = gi & 3;
            const float* W = a.in[f == 0 ? (bj == 0 ? I_F1G : I_F1U) : (bj == 0 ? I_F2G : I_F2U)] + (size_t)l * DM * DFF;
            const float* gain = a.in[f == 0 ? I_F1N : I_F2N] + l * DM;
            bf16* dst = (bf16*)(ws + (f == 0 ? W_GU1 : W_GU2)) + (size_t)(32 * g) * DM + 64 * kb;
            tr_item(W, DFF, 64 * kb, gain, pn * 128 + wc * 32, 32, dst, DM, scr, lane); continue;
        }
        r -= 2 * I_GU;
        if (r < 2 * I_D) {
            const int f = r / I_D; r -= f * I_D; const int g = r / 44, kb = r % 44;
            const float* W = a.in[f == 0 ? I_F1D : I_F2D] + (size_t)l * DFF * DM;
            bf16* dst = (bf16*)(ws + (f == 0 ? W_D1 : W_D2)) + (size_t)(32 * g) * DFF + 64 * kb;
            tr_item(W, DM, 64 * kb, nullptr, 32 * g, 32, dst, DFF, scr, lane); continue;
        }
        r -= 2 * I_D;
        if (r < I_IN) {
            const int g = r >> 4, kb = r & 15; int sc, nv; win_map(g, sc, nv);
            const float* W = a.in[I_WIN] + (size_t)l * DM * IN_W;
            bf16* dst = (bf16*)(ws + W_IN) + (size_t)(32 * g) * DM + 64 * kb;
            tr_item(W, IN_W, 64 * kb, a.in[I_MIXN] + l * DM, sc, nv, dst, DM, scr, lane); continue;
        }
        r -= I_IN;
        if (r < I_O) {
            const int g = r >> 4, kb = r & 15;
            bf16* dst = (bf16*)(ws + W_O) + (size_t)(32 * g) * DM + 64 * kb;
            tr_item(a.in[I_WO] + (size_t)l * DM * DM, DM, 64 * kb, nullptr, 32 * g, 32, dst, DM, scr, lane); continue;
        }
        r -= I_O;
        if (r < I_QU) {
            const int g = r >> 2, kb = r & 3; const int pn = g >> 3, gi = g & 7, bj = gi >> 2, wc = gi & 3, head = pn * 2 + (wc >> 1);
            const int sc = (wc & 1) ? head * 96 + 64 + 16 * bj : head * 96 + 32 * bj, nv = (wc & 1) ? 16 : 32;
            bf16* dst = (bf16*)(ws + W_QU) + (size_t)(32 * g) * 256 + 64 * kb;
            tr_item(a.in[I_MQU] + (size_t)l * 256 * 576, 576, 64 * kb, a.in[I_MQN] + l * 256, sc, nv, dst, 256, scr, lane); continue;
        }
        r -= I_QU;
        {
            const int g = r >> 2, kb = r & 3; const int pn = g >> 3, gi = g & 7, bj = gi >> 2, wc = gi & 3, head = pn * 2 + (wc >> 1);
            const int sc = head * 128 + ((wc & 1) ? 64 : 0) + 32 * bj;
            bf16* dst = (bf16*)(ws + W_KVU) + (size_t)(32 * g) * 256 + 64 * kb;
            if (kb < 2) tr_item(nullptr, 768, 0, nullptr, 0, 0, dst, 256, scr, lane);
            else tr_item(a.in[I_MKVU] + (size_t)l * 128 * 768, 768, 64 * (kb - 2), a.in[I_MKVN] + l * 128, sc, 32, dst, 256, scr, lane);
        }
    }
}

__device__ __forceinline__ int t5_bucket(int rel) {
    const int n = rel < 0 ? -rel : rel;
    const float nf = (float)(n > 1 ? n : 1);
    int large = 8 + (int)(logf(nf / 8.0f) / 4.852030263919617f * 8.0f);
    large = large < 15 ? large : 15;
    return (rel > 0 ? 16 : 0) + (n < 8 ? n : large);
}

__device__ __forceinline__ void prologue_misc(const Args& a, unsigned char* ws, int gw, int NGW, int lane, int gtid, int NGT) {
    float* tab = (float*)(ws + WS_TAB);
    for (int i = gtid; i < SEQ * 16; i += NGT) { const int s = i >> 4, j = i & 15; const double inv = pow(10000.0, -(double)j / 16.0), ang = (double)s * inv; tab[TAB_COS + i] = (float)cos(ang); tab[TAB_SIN + i] = (float)sin(ang); }
    for (int l = 0; l < DEPTH; ++l) {
        const float* relb = a.in[I_RELB];
        float mbd = 0.f, mbl = 0.f;
        for (int i = lane; i < 320; i += 64) { const float v = fabsf(relb[i]); if ((i % 10) < 4) mbd = fmaxf(mbd, v); else mbl = fmaxf(mbl, v); }
        mbd = wave_max(mbd); mbl = wave_max(mbl);
        float gq = (lane < 32) ? fabsf(a.in[I_DQN][l * 32 + lane]) : 0.f, gk = (lane < 32) ? fabsf(a.in[I_DKN][l * 32 + lane]) : 0.f;
        gq = wave_max(gq); gk = wave_max(gk);
        const float B2d = (5.656854249f * gq * gk + mbd) * LOG2E;
        float lq = fabsf(a.in[I_LQN][l * 64 + lane]), lk = fabsf(a.in[I_LKN][l * 64 + lane]);
        lq = wave_max(lq); lk = wave_max(lk);
        const float B2l = (8.0f * lq * lk + mbl) * LOG2E;
        float mq = fmaxf(fabsf(a.in[I_MQNG][l * 96 + lane]), lane < 32 ? fabsf(a.in[I_MQNG][l * 96 + 64 + lane]) : 0.f);
        float mk = fmaxf(fabsf(a.in[I_MKNG][l * 96 + lane]), lane < 32 ? fabsf(a.in[I_MKNG][l * 96 + 64 + lane]) : 0.f);
        mq = wave_max(mq); mk = wave_max(mk);
        const float B2c = 9.797958971f * mq * mk * LOG2E;
        for (int i = gtid; i < 10 * 4096; i += NGT) {
            const int h = i >> 12, idx = i & 4095, rel = idx - 2048; const int bk = t5_bucket(rel);
            if (h < 4) tab[TAB_BD + (l * 4 + h) * 4096 + idx] = relb[bk * 10 + h] * LOG2E - B2d;
            else tab[TAB_BL + (l * 6 + (h - 4)) * 4096 + idx] = relb[bk * 10 + h] * LOG2E - B2l;
        }
        if (gw == 0) {
            const float* lp = a.in[I_DLAM] + l * 128;
            float s1 = (lane < 32) ? lp[lane] * lp[32 + lane] : 0.f, s2 = (lane < 32) ? lp[64 + lane] * lp[96 + lane] : 0.f;
            s1 = wave_sum(s1); s2 = wave_sum(s2);
            const float linit = 0.8f - 0.6f * expf(-0.3f * (float)(l + 1));
            if (lane == 0) { tab[TAB_SC + l * 8 + 0] = expf(s1) - expf(s2) + linit; tab[TAB_SC + l * 8 + 1] = 1.0f - linit; tab[TAB_SC + l * 8 + 2] = -B2c; }
        }
    }
    float* P0 = (float*)(ws + WS_P);
    for (int m = gw; m < MTOK; m += NGW) {
        const GAS f32x4* xr = (const GAS f32x4*)(a.in[I_X] + (size_t)m * DM) + lane;
        GAS f32x4* orow = (GAS f32x4*)(a.out + (size_t)m * DM) + lane;
        GAS unsigned long long* o8 = (GAS unsigned long long*)((bf16*)(ws + WS_XB) + (size_t)m * DM) + lane;
        float s = 0.f;
#pragma unroll
        for (int j = 0; j < 4; ++j) { const f32x4 v = xr[64 * j]; orow[64 * j] = v; s += (v.x * v.x + v.y * v.y) + (v.z * v.z + v.w * v.w);
            o8[64 * j] = (unsigned long long)pk2(v.x, v.y) | ((unsigned long long)pk2(v.z, v.w) << 32); }
        s = wave_sum(s);
        if (lane < 16) P0[(size_t)m * 16 + lane] = lane == 0 ? s : 0.f;
    }
}


__device__ __forceinline__ void diff_unit_v1(const unsigned char* ws, const float* sub, const int tid, int l, int u, LAS float* lds) {
    const int c = tid >> 8, ql = tid & 255, bh = u >> 3, b = bh >> 2, h = bh & 3, qi = (u & 7) * 256 + ql;
    const bf16* Qd = (const bf16*)(ws + WS_QD); const bf16* Kd = (const bf16*)(ws + WS_KD); const bf16* Vd = (const bf16*)(ws + WS_VD);
    const float* tab = (const float*)(ws + WS_TAB) + TAB_BD + (l * 4 + h) * 4096;
    float q[32], o[64]; float lsum = 0.f;
    { const v4u* qp = (const v4u*)(Qd + ((size_t)(((b * 4 + h) * 2 + c) * SEQ + qi)) * 32);
#pragma unroll
      for (int i = 0; i < 4; ++i) unpack8(qp[i], q + 8 * i); }
#pragma unroll
    for (int d = 0; d < 64; ++d) o[d] = 0.f;
    LAS float* Ks = lds;
    LAS float* Vs = lds + 4096;
    for (int kc = 0; kc < SEQ / 64; ++kc) {
        __syncthreads();
        { const int e = tid * 8, cc = e >> 11, key = (e & 2047) >> 5, d = e & 31;
          const v4u w = *(const v4u*)(Kd + ((size_t)(((b * 4 + h) * 2 + cc) * SEQ + kc * 64 + key)) * 32 + d);
          float t[8]; unpack8(w, t);
#pragma unroll
          for (int i = 0; i < 8; ++i) Ks[e + i] = t[i];
          const int vkey = e >> 6, vd = e & 63;
          const v4u w2 = *(const v4u*)(Vd + ((size_t)((b * 4 + h) * SEQ + kc * 64 + vkey)) * 64 + vd);
          unpack8(w2, t);
#pragma unroll
          for (int i = 0; i < 8; ++i) Vs[e + i] = t[i]; }
        __syncthreads();
        for (int j = 0; j < 64; ++j) {
            const int k = kc * 64 + j;
            float s = tab[k - qi + 2048];
            const LAS f32x4* kp = (const LAS f32x4*)(Ks + (c * 64 + j) * 32);
#pragma unroll
            for (int i = 0; i < 8; ++i) { const f32x4 kv = kp[i]; s += q[4 * i] * kv.x + q[4 * i + 1] * kv.y + q[4 * i + 2] * kv.z + q[4 * i + 3] * kv.w; }
            const float p = __builtin_amdgcn_exp2f(s);
            lsum += p;
            const LAS f32x4* vp = (const LAS f32x4*)(Vs + j * 64);
#pragma unroll
            for (int i = 0; i < 16; ++i) { const f32x4 vv = vp[i]; o[4 * i] += p * vv.x; o[4 * i + 1] += p * vv.y; o[4 * i + 2] += p * vv.z; o[4 * i + 3] += p * vv.w; }
        }
    }
    __syncthreads();
    const float inv = 1.0f / lsum;
    LAS float* Xs = lds + 8192;
    if (c == 1) {
#pragma unroll
        for (int d = 0; d < 64; ++d) Xs[ql * 68 + d] = o[d] * inv;
    }
    __syncthreads();
    if (c == 0) {
        const float* sc = (const float*)(ws + WS_TAB) + TAB_SC + l * 8; const float lam = sc[0], post = sc[1];
        float ss = 0.f;
#pragma unroll
        for (int d = 0; d < 64; ++d) { o[d] = o[d] * inv - lam * Xs[ql * 68 + d]; ss += o[d] * o[d]; }
        const float rn = __builtin_amdgcn_rsqf(ss * (1.0f / 64.0f) + EPS) * post;
        bf16* dst = (bf16*)(ws + WS_MIX) + ((size_t)(b * SEQ + qi)) * DM + h * 64;
#pragma unroll
        for (int i = 0; i < 8; ++i) { v4u w; w.x = pk2(o[8 * i] * rn * sub[8 * i], o[8 * i + 1] * rn * sub[8 * i + 1]); w.y = pk2(o[8 * i + 2] * rn * sub[8 * i + 2], o[8 * i + 3] * rn * sub[8 * i + 3]);
            w.z = pk2(o[8 * i + 4] * rn * sub[8 * i + 4], o[8 * i + 5] * rn * sub[8 * i + 5]); w.w = pk2(o[8 * i + 6] * rn * sub[8 * i + 6], o[8 * i + 7] * rn * sub[8 * i + 7]); *(v4u*)(dst + 8 * i) = w; }
    }
    __syncthreads();
}

__device__ __forceinline__ void mla_unit_v1(const unsigned char* ws, const int tid, int l, int u, LAS float* lds) {
    const int bh = u >> 2, b = bh / 6, h = bh % 6, qi = (u & 3) * 512 + tid;
    const bf16* Qc = (const bf16*)(ws + WS_QC); const bf16* Kc = (const bf16*)(ws + WS_KC); const bf16* Vc = (const bf16*)(ws + WS_VC);
    const float nb2 = ((const float*)(ws + WS_TAB))[TAB_SC + l * 8 + 2];
    float q[96], o[64]; float lsum = 0.f;
    { const v4u* qp = (const v4u*)(Qc + ((size_t)((b * 6 + h) * SEQ + qi)) * 96);
#pragma unroll
      for (int i = 0; i < 12; ++i) unpack8(qp[i], q + 8 * i); }
#pragma unroll
    for (int d = 0; d < 64; ++d) o[d] = 0.f;
    LAS float* Ks = lds;
    LAS float* Vs = lds + 3072;
    for (int kc = 0; kc < SEQ / 32; ++kc) {
        __syncthreads();
        if (tid < 384) { const int e = tid * 8; const v4u w = *(const v4u*)(Kc + ((size_t)((b * 6 + h) * SEQ + kc * 32)) * 96 + e); float t[8]; unpack8(w, t);
#pragma unroll
            for (int i = 0; i < 8; ++i) Ks[e + i] = t[i]; }
        if (tid < 256) { const int e = tid * 8; const v4u w = *(const v4u*)(Vc + ((size_t)((b * 6 + h) * SEQ + kc * 32)) * 64 + e); float t[8]; unpack8(w, t);
#pragma unroll
            for (int i = 0; i < 8; ++i) Vs[e + i] = t[i]; }
        __syncthreads();
        for (int j = 0; j < 32; ++j) {
            float s = nb2;
            const LAS f32x4* kp = (const LAS f32x4*)(Ks + j * 96);
#pragma unroll
            for (int i = 0; i < 24; ++i) { const f32x4 kv = kp[i]; s += q[4 * i] * kv.x + q[4 * i + 1] * kv.y + q[4 * i + 2] * kv.z + q[4 * i + 3] * kv.w; }
            const float p = __builtin_amdgcn_exp2f(s);
            lsum += p;
            const LAS f32x4* vp = (const LAS f32x4*)(Vs + j * 64);
#pragma unroll
            for (int i = 0; i < 16; ++i) { const f32x4 vv = vp[i]; o[4 * i] += p * vv.x; o[4 * i + 1] += p * vv.y; o[4 * i + 2] += p * vv.z; o[4 * i + 3] += p * vv.w; }
        }
    }
    const float inv = 1.0f / lsum;
    bf16* dst = (bf16*)(ws + WS_MIX) + ((size_t)(b * SEQ + qi)) * DM + 640 + h * 64;
#pragma unroll
    for (int i = 0; i < 8; ++i) { v4u w; w.x = pk2(o[8 * i] * inv, o[8 * i + 1] * inv); w.y = pk2(o[8 * i + 2] * inv, o[8 * i + 3] * inv); w.z = pk2(o[8 * i + 4] * inv, o[8 * i + 5] * inv); w.w = pk2(o[8 * i + 6] * inv, o[8 * i + 7] * inv); *(v4u*)(dst + 8 * i) = w; }
    __syncthreads();
}

__device__ __forceinline__ void dil_unit_v1(const unsigned char* ws, const int tid, int l, int u) {
    const int bh = u >> 2, b = bh / 6, h = bh % 6, qi = (u & 3) * 512 + tid;
    const bf16* Ql = (const bf16*)(ws + WS_QL); const bf16* Kl = (const bf16*)(ws + WS_KL) + (size_t)((b * 6 + h) * SEQ) * 64; const bf16* Vl = (const bf16*)(ws + WS_VL) + (size_t)((b * 6 + h) * SEQ) * 64;
    const float* tab = (const float*)(ws + WS_TAB) + TAB_BL + (l * 6 + h) * 4096;
    float q[64], o[64]; float lsum = 0.f;
    { const v4u* qp = (const v4u*)(Ql + ((size_t)((b * 6 + h) * SEQ + qi)) * 64);
#pragma unroll
      for (int i = 0; i < 8; ++i) unpack8(qp[i], q + 8 * i); }
#pragma unroll
    for (int d = 0; d < 64; ++d) o[d] = 0.f;
    for (int br = 0; br < 3; ++br) {
        const int dil = br == 0 ? 1 : (br == 1 ? 4 : 16);
        for (int j = -64; j <= 64; ++j) {
            const int k = qi + dil * j; const bool valid = (k >= 0) && (k < SEQ); const int kk = valid ? k : qi;
            float s = tab[kk - qi + 2048];
            const v4u* kp = (const v4u*)(Kl + (size_t)kk * 64);
#pragma unroll
            for (int i = 0; i < 8; ++i) { float t[8]; unpack8(kp[i], t);
#pragma unroll
                for (int e = 0; e < 8; ++e) s += q[8 * i + e] * t[e]; }
            const float p = valid ? __builtin_amdgcn_exp2f(s) : 0.f;
            lsum += p;
            const v4u* vp = (const v4u*)(Vl + (size_t)kk * 64);
#pragma unroll
            for (int i = 0; i < 8; ++i) { float t[8]; unpack8(vp[i], t);
#pragma unroll
                for (int e = 0; e < 8; ++e) o[8 * i + e] += p * t[e]; }
        }
    }
    const float inv = 1.0f / lsum;
    bf16* dst = (bf16*)(ws + WS_MIX) + ((size_t)(b * SEQ + qi)) * DM + 256 + h * 64;
#pragma unroll
    for (int i = 0; i < 8; ++i) { v4u w; w.x = pk2(o[8 * i] * inv, o[8 * i + 1] * inv); w.y = pk2(o[8 * i + 2] * inv, o[8 * i + 3] * inv); w.z = pk2(o[8 * i + 4] * inv, o[8 * i + 5] * inv); w.w = pk2(o[8 * i + 6] * inv, o[8 * i + 7] * inv); *(v4u*)(dst + 8 * i) = w; }
}

#ifndef MK_PH
#define MK_PH 255
#endif
#ifndef MK_SP2
#define MK_SP2 false
#endif
constexpr int NPHASE = 18;
template <int MODE>
__global__ void __launch_bounds__(512, 2) enc_fwd(Args args) {
    extern __shared__ __attribute__((aligned(16))) unsigned char lds[];
    LAS unsigned char* L = (LAS unsigned char*)lds;
    volatile LAS unsigned* MISC = (volatile LAS unsigned*)(L + MISC_OFF);
    LAS float* xs = (LAS float*)(L + XS_OFF);
    const int G = gridDim.x, bx = blockIdx.x;
    const int vcu = (G % 8 == 0) ? (bx % 8) * (G / 8) + bx / 8 : bx;
    for (int u = threadIdx.x; u < (LDS_BYTES - MISC_OFF) / 4; u += 512) ((LAS unsigned*)(L + MISC_OFF))[u] = 0u;
    __syncthreads();
    XcdBarrier bar; bar.bar = (unsigned*)(args.ws + WS_CTL) + CW_BAR; bar.x = 0; bar.st = nullptr;
    if (MODE < 0) bar = xcd_barrier_post((unsigned*)(args.ws + WS_CTL) + CW_BAR, MISC + 8);
    const int NGW = G * 8, NGT = G * 512;
#define IN(k) (MODE < 0 || MODE == (k))
#define SEAM(k) do { if (MODE < 0) xcd_barrier(bar); } while (0)
#define PHASE_ENV() int tidp = threadIdx.x; asm volatile("" : "+v"(tidp)); unsigned char* ws; { const unsigned long long w_ = (unsigned long long)args.ws; unsigned wl_ = __builtin_amdgcn_readfirstlane((unsigned)w_), wh_ = __builtin_amdgcn_readfirstlane((unsigned)(w_ >> 32)); \
          asm volatile("" : "+s"(wl_), "+s"(wh_)); ws = (unsigned char*)(((unsigned long long)wh_ << 32) | wl_); } \
        const int lane = tidp & 63, wave = __builtin_amdgcn_readfirstlane(tidp >> 6), gw = vcu * 8 + wave, gtid = bx * 512 + tidp; (void)lane; (void)gw; (void)gtid; \
        bf16* XB = (bf16*)(ws + WS_XB); bf16* HB = (bf16*)(ws + WS_H); float* P0 = (float*)(ws + WS_P); float* P1 = P0 + (size_t)MTOK * 16; float* P2 = P1 + (size_t)MTOK * 16; \
        const float* tab = (const float*)(ws + WS_TAB); (void)XB; (void)HB; (void)P0; (void)P1; (void)P2; (void)tab;

    if (IN(0) && (MK_PH & 1)) { PHASE_ENV();
        prologue_misc(args, ws, gw, NGW, lane, gtid, NGT);
        convert_weights(args, ws, 0, (LAS float*)(L + wave * 16384), gw, NGW, lane);
    }
    SEAM(0);
    for (int l = (MODE < 0 ? 0 : args.layer); l < (MODE < 0 ? DEPTH : args.layer + 1); ++l) {
        constexpr int p0 = 1;
        if (IN(p0 + 0) && (MK_PH & 4)) { PHASE_ENV();
            pg8::Gemm g{XB, (const bf16*)(ws + W_GU1), MTOK, 2 * DFF, DM, DM, DM}; pg8::StaticOrder S; S.init(MTOK, 2 * DFF, G, bx);
            pg8::EpiSwiGLU E{HB, P0};
            pg8::gemm_phase<pg8::EpiSwiGLU, pg8::StaticOrder, true, MK_SP2>(tidp, L, xs, g, S, E);
        }
        SEAM(p0 + 0);
        if (IN(p0 + 1) && (MK_PH & 8)) { PHASE_ENV();
            pg8::Gemm g{HB, (const bf16*)(ws + W_D1), MTOK, DM, DFF, DFF, DFF}; pg8::StaticOrder S; S.init(MTOK, DM, G, bx);
            pg8::EpiResid E{args.out, XB, P1, 0.5f};
            pg8::gemm_phase<pg8::EpiResid, pg8::StaticOrder, true, MK_SP2>(tidp, L, xs, g, S, E);
        }
        SEAM(p0 + 1);
        if (IN(p0 + 2) && (MK_PH & 16)) { PHASE_ENV();
            pg8::Gemm g{XB, (const bf16*)(ws + W_IN), MTOK, NIN, DM, DM, DM}; pg8::StaticOrder S; S.init(MTOK, NIN, G, bx);
            pg8::EpiInProj E{P1, (bf16*)(ws + WS_QD), (bf16*)(ws + WS_KD), (bf16*)(ws + WS_VD), (bf16*)(ws + WS_QL), (bf16*)(ws + WS_KL), (bf16*)(ws + WS_VL), (bf16*)(ws + WS_AQ),
                             (float*)(ws + WS_KR), (float*)(ws + WS_KRSS), args.in[I_DQN] + l * 32, args.in[I_DKN] + l * 32, args.in[I_LQN] + l * 64, args.in[I_LKN] + l * 64,
                             0.17677669529663687f * LOG2E, 0.125f * LOG2E};
            pg8::gemm_phase<pg8::EpiInProj, pg8::StaticOrder, true, MK_SP2>(tidp, L, xs, g, S, E);
        }
        SEAM(p0 + 2);
        if (IN(p0 + 3) && (MK_PH & 32)) { PHASE_ENV();
            { pg8::Gemm g{(const bf16*)(ws + WS_AQ), (const bf16*)(ws + W_QU), MTOK, 768, 256, 384, 256}; pg8::StaticOrder S; S.init(MTOK, 768, G, bx);
              pg8::EpiMlaQ E{(bf16*)(ws + WS_QC), args.in[I_MQNG] + l * 96, tab + TAB_COS, tab + TAB_SIN, 0.10206207261596575f * LOG2E};
              pg8::gemm_phase<pg8::EpiMlaQ, pg8::StaticOrder, true, MK_SP2>(tidp, L, xs, g, S, E); }
        }
        if (IN(p0 + 3) && (MK_PH & 32)) { PHASE_ENV();
            { pg8::Gemm g{(const bf16*)(ws + WS_AQ) + 128, (const bf16*)(ws + W_KVU), MTOK, 768, 256, 384, 256}; pg8::StaticOrder S; S.init(MTOK, 768, G, (bx + 128) % G);
              pg8::EpiMlaKV E{(bf16*)(ws + WS_KC), (bf16*)(ws + WS_VC), args.in[I_MKNG] + l * 96, (const float*)(ws + WS_KR), (const float*)(ws + WS_KRSS), tab + TAB_COS, tab + TAB_SIN};
              pg8::gemm_phase<pg8::EpiMlaKV, pg8::StaticOrder, true, MK_SP2>(tidp, L, xs, g, S, E); }
        }
        SEAM(p0 + 3);
        if (IN(p0 + 4) && (MK_PH & 64)) { PHASE_ENV();
            for (int u = bx; u < 640; u += G) {
                if (u < 192) mla_unit_v1(ws, tidp, l, u, (LAS float*)L);
                else if (u < 448) diff_unit_v1(ws, args.in[I_DSUB] + l * 64, tidp, l, u - 192, (LAS float*)L);
                else dil_unit_v1(ws, tidp, l, u - 448);
            }
        }
        SEAM(p0 + 4);
        if (IN(p0 + 5) && (MK_PH & 128)) { PHASE_ENV();
            pg8::Gemm g{(const bf16*)(ws + WS_MIX), (const bf16*)(ws + W_O), MTOK, DM, DM, DM, DM}; pg8::StaticOrder S; S.init(MTOK, DM, G, bx);
            pg8::EpiResid E{args.out, XB, P2, 1.0f};
            pg8::gemm_phase<pg8::EpiResid, pg8::StaticOrder, true, MK_SP2>(tidp, L, xs, g, S, E);
        }
        SEAM(p0 + 5);
        if (IN(p0 + 6) && (MK_PH & 4)) { PHASE_ENV();
            pg8::Gemm g{XB, (const bf16*)(ws + W_GU2), MTOK, 2 * DFF, DM, DM, DM}; pg8::StaticOrder S; S.init(MTOK, 2 * DFF, G, bx);
            pg8::EpiSwiGLU E{HB, P2};
            pg8::gemm_phase<pg8::EpiSwiGLU, pg8::StaticOrder, true, MK_SP2>(tidp, L, xs, g, S, E);
        }
        SEAM(p0 + 6);
        if (IN(p0 + 7) && (MK_PH & 8)) { PHASE_ENV();
            pg8::Gemm g{HB, (const bf16*)(ws + W_D2), MTOK, DM, DFF, DFF, DFF}; pg8::StaticOrder S; S.init(MTOK, DM, G, bx);
            pg8::EpiResid E{args.out, l == DEPTH - 1 ? nullptr : XB, l == DEPTH - 1 ? nullptr : P0, 0.5f};
            pg8::gemm_phase<pg8::EpiResid, pg8::StaticOrder, true, MK_SP2>(tidp, L, xs, g, S, E);
        }
        if (l + 1 < DEPTH) {
            SEAM(p0 + 7);
            if (IN(p0 + 8) && (MK_PH & 2)) { PHASE_ENV(); convert_weights(args, ws, l + 1, (LAS float*)(L + wave * 16384), gw, NGW, lane); }
            SEAM(p0 + 8);
        }
    }
#undef IN
#undef SEAM
#undef PHASE_ENV
}

extern "C" void kernel_launch(void* const* d_in, const int* in_sizes, int n_in, void* d_out, int out_size, void* d_ws, size_t ws_size, hipStream_t stream) {
    static int grid = 0;
    if (grid == 0) {
        if (n_in != 25 || out_size != MTOK * DM || ws_size < WS_END) { fprintf(stderr, "kernel_launch: unexpected shapes (n_in %d out %d ws %zu)\n", n_in, out_size, ws_size); grid = -1; return; }
        int dev = 0, cus = 0, per_cu = 0;
        if (hipGetDevice(&dev) != hipSuccess || hipDeviceGetAttribute(&cus, hipDeviceAttributeMultiprocessorCount, dev) != hipSuccess) { grid = -1; return; }
#if MK_ONE_LAUNCH
        if (hipFuncSetAttribute((const void*)enc_fwd<-1>, hipFuncAttributeMaxDynamicSharedMemorySize, LDS_BYTES) != hipSuccess) { fprintf(stderr, "kernel_launch: hipFuncSetAttribute failed\n"); grid = -1; return; }
        if (hipOccupancyMaxActiveBlocksPerMultiprocessor(&per_cu, (const void*)enc_fwd<-1>, 512, LDS_BYTES) != hipSuccess || per_cu < 1) { fprintf(stderr, "kernel_launch: occupancy query says %d\n", per_cu); grid = -1; return; }
#else
#define SETATTR(K) if (hipFuncSetAttribute((const void*)enc_fwd<K>, hipFuncAttributeMaxDynamicSharedMemorySize, LDS_BYTES) != hipSuccess) { fprintf(stderr, "kernel_launch: hipFuncSetAttribute failed\n"); grid = -1; return; }
        SETATTR(0) SETATTR(1) SETATTR(2) SETATTR(3) SETATTR(4) SETATTR(5) SETATTR(6) SETATTR(7) SETATTR(8) SETATTR(9)
        per_cu = 1;
#endif
        (void)hipGetLastError();
        grid = cus;
    }
    if (grid < 0) return;
    (void)hipMemsetAsync((char*)d_ws + WS_CTL, 0, CTL_ZERO_BYTES, stream);
    Args a{};
    for (int i = 0; i < 25; ++i) a.in[i] = (const float*)d_in[i];
    a.out = (float*)d_out; a.ws = (unsigned char*)d_ws;
#if MK_ONE_LAUNCH
    a.layer = 0;
    hipLaunchKernelGGL(enc_fwd<-1>, dim3(grid), dim3(512), LDS_BYTES, stream, a);
#else
#define LAUNCH_PH(K, LAYER) do { a.layer = (LAYER); hipLaunchKernelGGL(enc_fwd<K>, dim3(grid), dim3(512), LDS_BYTES, stream, a); } while (0)
    LAUNCH_PH(0, 0);
    for (int l = 0; l < DEPTH; ++l) {
        LAUNCH_PH(1, l); LAUNCH_PH(2, l); LAUNCH_PH(3, l); LAUNCH_PH(4, l); LAUNCH_PH(5, l); LAUNCH_PH(6, l); LAUNCH_PH(7, l); LAUNCH_PH(8, l);
        if (l + 1 < DEPTH) LAUNCH_PH(9, l);
    }
#endif
}
```

```cpp
#include <hip/hip_runtime.h>
#include <cstdio>
#include <cstdint>

#ifndef MK_SC1_STORES
#define MK_SC1_STORES 0
#endif
#ifndef MK_ONE_LAUNCH
#define MK_ONE_LAUNCH 1
#endif

constexpr int DM = 1024, BATCH = 8, SEQ = 2048, DEPTH = 2, MTOK = BATCH * SEQ, DFF = 2816;
constexpr int IN_W = 2336, NIN = 2560;
constexpr float EPS = 1e-6f;
constexpr float LOG2E = 1.4426950408889634f;

__device__ __forceinline__ float sum_x32(float v) { const unsigned u = __builtin_bit_cast(unsigned, v); auto r = __builtin_amdgcn_permlane32_swap(u, u, false, false); return __builtin_bit_cast(float, (unsigned)r[0]) + __builtin_bit_cast(float, (unsigned)r[1]); }
__device__ __forceinline__ float max_x32(float v) { const unsigned u = __builtin_bit_cast(unsigned, v); auto r = __builtin_amdgcn_permlane32_swap(u, u, false, false); return fmaxf(__builtin_bit_cast(float, (unsigned)r[0]), __builtin_bit_cast(float, (unsigned)r[1])); }
template <int M> __device__ __forceinline__ float swz(float v) { return __builtin_bit_cast(float, __builtin_amdgcn_ds_swizzle(__builtin_bit_cast(int, v), 0x1F | (M << 10))); }

namespace pg8 {
#define PG8_LAS __attribute__((address_space(3)))
typedef unsigned short bf16_t;
typedef short bf16x8 __attribute__((ext_vector_type(8)));
typedef float f32x4 __attribute__((ext_vector_type(4)));
typedef unsigned u32x4 __attribute__((ext_vector_type(4)));
typedef unsigned u32x2 __attribute__((ext_vector_type(2)));
constexpr int BM = 256, BK = 64, HALF = 128, HTB = HALF * BK * 2  , STAGE_BYTES = 8 * HTB, NXCD = 8, WGM = 8;

__host__ __device__ __forceinline__ int lds_byte(int r, int c) { const int st = (r >> 4) * 2 + (c >> 5), rr = r & 15, cc = c & 31, ob = rr * 64 + cc * 2; return st * 1024 + (ob ^ (((ob >> 9) & 1) << 5)); }
__host__ __device__ __forceinline__ void stage_rc(int b, int& R, int& C) { const int st = b / 1024, sb = b % 1024, swz = sb ^ (((sb >> 9) & 1) << 5); R = (st >> 1) * 16 + swz / 64; C = (st & 1) * 32 + (swz % 64) / 2; }
__host__ __device__ __forceinline__ int perm32(int rho) { const int n = rho >> 4, i = rho & 15; return 8 * (i >> 2) + 4 * n + (i & 3); }

struct Unit { int pm, pn; };
struct Gemm { const bf16_t* A; const bf16_t* Bt; int M, N, K, lda, ldb; };

struct StaticOrder {
    int nM, nN, nwg, G, c;
    __host__ __device__ void init(int M, int N, int G_, int c_) { nM = M / BM; nN = N / BM; nwg = nM * nN; G = G_; c = c_; }
    __host__ __device__ bool next(int i, Unit& u) const {
        const long L = (long)i * G + c; if (L >= nwg) return false;
        int wgid = (int)L; { const int q = nwg / NXCD, r = nwg % NXCD, xcd = wgid % NXCD, off = wgid / NXCD; wgid = (xcd < r ? xcd * (q + 1) : r * (q + 1) + (xcd - r) * q) + off; }
        const int nig = WGM * nN, gid = wgid / nig, fm = gid * WGM, gsz = (nM - fm) < WGM ? (nM - fm) : WGM;
        u.pm = fm + ((wgid % nig) % gsz); u.pn = (wgid % nig) / gsz; return true;
    }
    __device__ __forceinline__ void a_ready(const Unit&) const {}
    __device__ __forceinline__ void done(const Unit&) const {}
};

__device__ __forceinline__ unsigned cvt_pk_bf16(float lo, float hi) { unsigned r; asm volatile("v_cvt_pk_bf16_f32 %0, %1, %2" : "=v"(r) : "v"(lo), "v"(hi)); return r; }

__device__ __forceinline__ float rowscale16(const float* P, int row) {
    const f32x4* p = (const f32x4*)(P + (size_t)row * 16);
    const f32x4 a = p[0], b = p[1], c = p[2], d = p[3];
    const float s = ((a[0] + a[1]) + (a[2] + a[3])) + ((b[0] + b[1]) + (b[2] + b[3])) + ((c[0] + c[1]) + (c[2] + c[3])) + ((d[0] + d[1]) + (d[2] + d[3]));
    return __builtin_amdgcn_rsqf(s * (1.0f / 1024.0f) + EPS);
}
__device__ __forceinline__ void rowscale_all(const float* P, int row0, int fq, float (&r)[8]) {
    f32x4 t[8];
#pragma unroll
    for (int i = 0; i < 8; ++i) t[i] = *(const f32x4*)(P + (size_t)(row0 + (i >> 2) * HALF + (i & 3) * 16) * 16 + fq * 4);
#pragma unroll
    for (int i = 0; i < 8; ++i) { float s = (t[i][0] + t[i][1]) + (t[i][2] + t[i][3]); s += swz<16>(s); s = sum_x32(s); r[i] = __builtin_amdgcn_rsqf(s * (1.0f / 1024.0f) + EPS); }
}
__device__ __forceinline__ u32x4 pack8(const float* v) { u32x4 w; w.x = cvt_pk_bf16(v[0], v[1]); w.y = cvt_pk_bf16(v[2], v[3]); w.z = cvt_pk_bf16(v[4], v[5]); w.w = cvt_pk_bf16(v[6], v[7]); return w; }
__device__ __forceinline__ float quad_sum(float s) { s += swz<16>(s); return sum_x32(s); }
#define EPI_OPAQUE() do { u.pm = __builtin_amdgcn_readfirstlane(u.pm); u.pn = __builtin_amdgcn_readfirstlane(u.pn); wr = __builtin_amdgcn_readfirstlane(wr); wc = __builtin_amdgcn_readfirstlane(wc); \
    asm volatile("" : "+s"(u.pm), "+s"(u.pn), "+s"(wr), "+s"(wc), "+v"(fr), "+v"(fq)); } while (0)
#if MK_SC1_STORES
__device__ __forceinline__ void st16(void* p, u32x4 v) { asm volatile("global_store_dwordx4 %0, %1, off sc1\n\ts_nop 1" :: "v"(p), "v"(v) : "memory"); }
__device__ __forceinline__ void st16f(void* p, f32x4 v) { asm volatile("global_store_dwordx4 %0, %1, off sc1\n\ts_nop 1" :: "v"(p), "v"(v) : "memory"); }
#else
__device__ __forceinline__ void st16(void* p, u32x4 v) { *(u32x4*)p = v; }
__device__ __forceinline__ void st16f(void* p, f32x4 v) { *(f32x4*)p = v; }
#endif
#define XS_BAR() do { asm volatile("s_waitcnt lgkmcnt(0)" ::: "memory"); __builtin_amdgcn_s_barrier(); asm volatile("" ::: "memory"); } while (0)

struct EpiSwiGLU {
    static constexpr bool PERM = true, AFTER_DRAIN = false, DUP_OK = true;
    bf16_t* H; const float* P;
    __device__ __forceinline__ void operator()(const f32x4 (&acc)[2][2][4][2], const Unit& u_, int wr, int wc, int fr, int fq, PG8_LAS float* xs) const {
        Unit u = u_; EPI_OPAQUE();
        float rs[8]; rowscale_all(P, u.pm * BM + wr * 64 + fr, fq, rs);
#pragma unroll
        for (int ai = 0; ai < 2; ++ai)
#pragma unroll
            for (int m = 0; m < 4; ++m) {
                const int row = u.pm * BM + ai * HALF + wr * 64 + m * 16 + fr;
                const float r = rs[ai * 4 + m];
                float h[8];
#pragma unroll
                for (int n = 0; n < 2; ++n)
#pragma unroll
                    for (int j = 0; j < 4; ++j) {
                        const float g = acc[ai][0][m][n][j] * r, up = acc[ai][1][m][n][j] * r;
                        h[n * 4 + j] = g * __builtin_amdgcn_rcpf(1.0f + __builtin_amdgcn_exp2f(-g * LOG2E)) * up;
                    }
                st16(H + (size_t)row * DFF + u.pn * 128 + wc * 32 + fq * 8, pack8(h));
            }
    }
};

struct EpiResid {
    static constexpr bool PERM = true, AFTER_DRAIN = false, DUP_OK = false;
    const float* Xin; float* X; bf16_t* XB; float* Pout; float alpha;
    __device__ __forceinline__ void operator()(const f32x4 (&acc)[2][2][4][2], const Unit& u_, int wr, int wc, int fr, int fq, PG8_LAS float* xs) const {
        Unit u = u_; EPI_OPAQUE();
        const size_t off0 = (size_t)(u.pm * BM + wr * 64 + fr) * DM + u.pn * BM + wc * 32 + fq * 8;
        f32x4 cur[4], nxt[4];
#pragma unroll
        for (int bj = 0; bj < 2; ++bj) { cur[2 * bj] = *(const f32x4*)(Xin + off0 + bj * HALF); cur[2 * bj + 1] = *(const f32x4*)(Xin + off0 + bj * HALF + 4); }
#pragma unroll
        for (int i = 0; i < 8; ++i) {
            const int ai = i >> 2, m = i & 3;
            const size_t off = off0 + (size_t)(ai * HALF + m * 16) * DM;
            if (i < 7) { const size_t offn = off0 + (size_t)(((i + 1) >> 2) * HALF + ((i + 1) & 3) * 16) * DM;
#pragma unroll
                for (int bj = 0; bj < 2; ++bj) { nxt[2 * bj] = *(const f32x4*)(Xin + offn + bj * HALF); nxt[2 * bj + 1] = *(const f32x4*)(Xin + offn + bj * HALF + 4); } }
            float ss = 0.f;
#pragma unroll
            for (int bj = 0; bj < 2; ++bj) {
                const f32x4 v0 = cur[2 * bj] + acc[ai][bj][m][0] * alpha, v1 = cur[2 * bj + 1] + acc[ai][bj][m][1] * alpha;
                st16f(X + off + bj * HALF, v0); st16f(X + off + bj * HALF + 4, v1);
                if (XB) { const float t[8] = {v0[0], v0[1], v0[2], v0[3], v1[0], v1[1], v1[2], v1[3]}; st16(XB + off + bj * HALF, pack8(t)); }
                ss += (v0[0] * v0[0] + v0[1] * v0[1]) + (v0[2] * v0[2] + v0[3] * v0[3]) + (v1[0] * v1[0] + v1[1] * v1[1]) + (v1[2] * v1[2] + v1[3] * v1[3]);
            }
            if (Pout) { ss = quad_sum(ss); if (fq == 0) Pout[(size_t)(u.pm * BM + ai * HALF + wr * 64 + m * 16 + fr) * 16 + u.pn * 4 + wc] = ss; }
#pragma unroll
            for (int j = 0; j < 4; ++j) cur[j] = nxt[j];
            asm volatile("" ::: "memory");
        }
    }
};

struct EpiInProj {
    static constexpr bool PERM = true, AFTER_DRAIN = false, DUP_OK = false;
    const float* P;
    bf16_t *Qd, *Kd, *Vd, *Ql, *Kl, *Vl, *AQ; float *kr, *krss;
    const float *g_dq, *g_dk, *g_lq, *g_lk;
    float cdiff, cdil;
    __device__ __forceinline__ void operator()(const f32x4 (&acc)[2][2][4][2], const Unit& u_, int wr, int wc, int fr, int fq, PG8_LAS float* xs) const {
        Unit u = u_; EPI_OPAQUE();
        const int t = u.pn;
        if (t == 7 || t == 8) {
#pragma unroll
            for (int ai = 0; ai < 2; ++ai)
#pragma unroll
                for (int m = 0; m < 4; ++m) {
                    const int rl = ai * HALF + wr * 64 + m * 16 + fr;
                    float ss = 0.f;
#pragma unroll
                    for (int bj = 0; bj < 2; ++bj)
#pragma unroll
                        for (int n = 0; n < 2; ++n) { const f32x4 a = acc[ai][bj][m][n]; ss += (a[0] * a[0] + a[1] * a[1]) + (a[2] * a[2] + a[3] * a[3]); }
                    ss = quad_sum(ss);
                    if (fq == 0) xs[rl * 4 + wc] = ss;
                }
            XS_BAR();
        }
        float rs[8]; rowscale_all(P, u.pm * BM + wr * 64 + fr, fq, rs);
        float gg[2][8];
        {
            const bool dil_ = (t >= 3 && t <= 5), isq_ = (t == 0) || (t == 3) || (t == 4 && wc < 2);
            const float *p_dq = g_dq, *p_dk = g_dk, *p_lq = g_lq, *p_lk = g_lk; asm volatile("" : "+s"(p_dq), "+s"(p_dk), "+s"(p_lq), "+s"(p_lk));
            const float* gp = dil_ ? (isq_ ? p_lq : p_lk) : (t == 1 ? p_dk : p_dq);
            const int gstep = dil_ ? 32 : 0;
#pragma unroll
            for (int bj = 0; bj < 2; ++bj)
#pragma unroll
                for (int i = 0; i < 8; ++i) gg[bj][i] = gp[bj * gstep + fq * 8 + i];
        }
#pragma unroll
        for (int ai = 0; ai < 2; ++ai)
#pragma unroll
            for (int m = 0; m < 4; ++m) {
                asm volatile("" ::: "memory");
                const int rl = ai * HALF + wr * 64 + m * 16 + fr, row = u.pm * BM + rl, b = row >> 11, s = row & (SEQ - 1);
                const float r = rs[ai * 4 + m];
                float v[2][8];
#pragma unroll
                for (int bj = 0; bj < 2; ++bj)
#pragma unroll
                    for (int n = 0; n < 2; ++n)
#pragma unroll
                        for (int j = 0; j < 4; ++j) v[bj][n * 4 + j] = acc[ai][bj][m][n][j] * r;
                if (t <= 1) {
                    bf16_t* dst = t == 0 ? Qd : Kd; const float post = t == 0 ? cdiff : 1.0f;
#pragma unroll
                    for (int bj = 0; bj < 2; ++bj) {
                        float ss = 0.f;
#pragma unroll
                        for (int i = 0; i < 8; ++i) ss += v[bj][i] * v[bj][i];
                        ss = quad_sum(ss);
                        const float rn = __builtin_amdgcn_rsqf(ss * (1.0f / 32.0f) + EPS) * post;
                        float o[8];
#pragma unroll
                        for (int i = 0; i < 8; ++i) o[i] = v[bj][i] * rn * gg[bj][i];
                        *(u32x4*)(dst + ((size_t)(((b * 4 + wc) * 2 + bj) * SEQ + s)) * 32 + fq * 8) = pack8(o);
                    }
                } else if (t == 2) {
#pragma unroll
                    for (int bj = 0; bj < 2; ++bj) *(u32x4*)(Vd + ((size_t)((b * 4 + wc) * SEQ + s)) * 64 + bj * 32 + fq * 8) = pack8(v[bj]);
                } else if (t <= 5) {
                    const bool isq = (t == 3) || (t == 4 && wc < 2);
                    const int head = (t == 3) ? wc : (t == 4 ? (wc < 2 ? 4 + wc : wc - 2) : wc + 2);
                    bf16_t* dst = isq ? Ql : Kl; const float post = isq ? cdil : 1.0f;
                    float ss = 0.f;
#pragma unroll
                    for (int bj = 0; bj < 2; ++bj)
#pragma unroll
                        for (int i = 0; i < 8; ++i) ss += v[bj][i] * v[bj][i];
                    ss = quad_sum(ss);
                    const float rn = __builtin_amdgcn_rsqf(ss * (1.0f / 64.0f) + EPS) * post;
#pragma unroll
                    for (int bj = 0; bj < 2; ++bj) {
                        float o[8];
#pragma unroll
                        for (int i = 0; i < 8; ++i) o[i] = v[bj][i] * rn * gg[bj][i];
                        *(u32x4*)(dst + ((size_t)((b * 6 + head) * SEQ + s)) * 64 + bj * 32 + fq * 8) = pack8(o);
                    }
                } else if (t == 6 || (t == 7 && wc < 2)) {
                    const int head = t == 6 ? wc : 4 + wc;
#pragma unroll
                    for (int bj = 0; bj < 2; ++bj) *(u32x4*)(Vl + ((size_t)((b * 6 + head) * SEQ + s)) * 64 + bj * 32 + fq * 8) = pack8(v[bj]);
                } else if (t == 7) {
                    const float ss = (xs[rl * 4 + 2] + xs[rl * 4 + 3]) * r * r;
                    const float rn = __builtin_amdgcn_rsqf(ss * (1.0f / 128.0f) + EPS);
#pragma unroll
                    for (int bj = 0; bj < 2; ++bj) {
                        float o[8];
#pragma unroll
                        for (int i = 0; i < 8; ++i) o[i] = v[bj][i] * rn;
                        *(u32x4*)(AQ + (size_t)row * 384 + 256 + (wc - 2) * 64 + bj * 32 + fq * 8) = pack8(o);
                    }
                } else if (t == 8) {
                    const float ss = ((xs[rl * 4 + 0] + xs[rl * 4 + 1]) + (xs[rl * 4 + 2] + xs[rl * 4 + 3])) * r * r;
                    const float rn = __builtin_amdgcn_rsqf(ss * (1.0f / 256.0f) + EPS);
#pragma unroll
                    for (int bj = 0; bj < 2; ++bj) {
                        float o[8];
#pragma unroll
                        for (int i = 0; i < 8; ++i) o[i] = v[bj][i] * rn;
                        *(u32x4*)(AQ + (size_t)row * 384 + bj * 128 + wc * 32 + fq * 8) = pack8(o);
                    }
                } else {
                    if (wc == 0) {
                        float ss = 0.f;
#pragma unroll
                        for (int bj = 0; bj < 2; ++bj)
#pragma unroll
                            for (int i = 0; i < 8; ++i) ss += v[bj][i] * v[bj][i];
                        ss = quad_sum(ss);
                        if (fq < 2) {
#pragma unroll
                            for (int bj = 0; bj < 2; ++bj) {
                                *(f32x4*)(kr + (size_t)row * 32 + bj * 16 + fq * 8) = (f32x4){v[bj][0], v[bj][1], v[bj][2], v[bj][3]};
                                *(f32x4*)(kr + (size_t)row * 32 + bj * 16 + fq * 8 + 4) = (f32x4){v[bj][4], v[bj][5], v[bj][6], v[bj][7]};
                            }
                        }
                        if (fq == 0) krss[row] = ss;
                    }
                }
            }
    }
};

struct EpiMlaQ {
    static constexpr bool PERM = true, AFTER_DRAIN = false, DUP_OK = false;
    bf16_t* Qc; const float* qn; const float* cs; const float* sn; float cmla;
    __device__ __forceinline__ void operator()(const f32x4 (&acc)[2][2][4][2], const Unit& u_, int wr, int wc, int fr, int fq, PG8_LAS float* xs) const {
        Unit u = u_; EPI_OPAQUE();
#pragma unroll
        for (int ai = 0; ai < 2; ++ai)
#pragma unroll
            for (int m = 0; m < 4; ++m) {
                const int rl = ai * HALF + wr * 64 + m * 16 + fr;
                float ss = 0.f;
#pragma unroll
                for (int bj = 0; bj < 2; ++bj)
#pragma unroll
                    for (int n = 0; n < 2; ++n) { const f32x4 a = acc[ai][bj][m][n]; ss += (a[0] * a[0] + a[1] * a[1]) + (a[2] * a[2] + a[3] * a[3]); }
                ss = quad_sum(ss);
                if (fq == 0) xs[rl * 4 + wc] = ss;
            }
        XS_BAR();
        const int hs = wc >> 1, head = u.pn * 2 + hs; const bool rope = wc & 1;
        float gq[16];
#pragma unroll
        for (int i = 0; i < 16; ++i) gq[i] = qn[(rope ? 64 + (i >> 3) * 16 : (i >> 3) * 32) + fq * 8 + (i & 7)];
        float cc[8], sv[8], ccn[8], svn[8];
        if (rope && fq < 2) { const int s0 = (u.pm * BM + wr * 64 + fr) & (SEQ - 1);
#pragma unroll
            for (int i = 0; i < 8; ++i) { cc[i] = cs[s0 * 16 + fq * 8 + i]; sv[i] = sn[s0 * 16 + fq * 8 + i]; } }
#pragma unroll
        for (int ig = 0; ig < 8; ++ig) {
            const int ai = ig >> 2, m = ig & 3;
            const int rl = ai * HALF + wr * 64 + m * 16 + fr, row = u.pm * BM + rl, b = row >> 11, s = row & (SEQ - 1);
            if (rope && fq < 2 && ig < 7) { const int sn_ = (u.pm * BM + ((ig + 1) >> 2) * HALF + wr * 64 + ((ig + 1) & 3) * 16 + fr) & (SEQ - 1);
#pragma unroll
                for (int i = 0; i < 8; ++i) { ccn[i] = cs[sn_ * 16 + fq * 8 + i]; svn[i] = sn[sn_ * 16 + fq * 8 + i]; } }
            const float ss = xs[rl * 4 + hs * 2] + xs[rl * 4 + hs * 2 + 1];
            const float rn = __builtin_amdgcn_rsqf(ss * (1.0f / 96.0f) + EPS) * cmla;
            bf16_t* dst = Qc + ((size_t)((b * 6 + head) * SEQ + s)) * 96;
            if (!rope) {
#pragma unroll
                for (int bj = 0; bj < 2; ++bj) {
                    float o[8];
#pragma unroll
                    for (int n = 0; n < 2; ++n)
#pragma unroll
                        for (int j = 0; j < 4; ++j) o[n * 4 + j] = acc[ai][bj][m][n][j] * rn * gq[bj * 8 + n * 4 + j];
                    *(u32x4*)(dst + bj * 32 + fq * 8) = pack8(o);
                }
            } else if (fq < 2) {
                float o1[8], o2[8];
#pragma unroll
                for (int n = 0; n < 2; ++n)
#pragma unroll
                    for (int j = 0; j < 4; ++j) {
                        const int i = n * 4 + j;
                        const float x1 = acc[ai][0][m][n][j] * rn * gq[i], x2 = acc[ai][1][m][n][j] * rn * gq[8 + i];
                        o1[i] = x1 * cc[i] - x2 * sv[i]; o2[i] = x1 * sv[i] + x2 * cc[i];
                    }
                *(u32x4*)(dst + 64 + fq * 8) = pack8(o1);
                *(u32x4*)(dst + 80 + fq * 8) = pack8(o2);
#pragma unroll
                for (int i = 0; i < 8; ++i) { cc[i] = ccn[i]; sv[i] = svn[i]; }
            }
            asm volatile("" ::: "memory");
        }
    }
};

struct EpiMlaKV {
    static constexpr bool PERM = true, AFTER_DRAIN = false, DUP_OK = false;
    bf16_t *Kc, *Vc; const float *kn, *kr, *krss, *cs, *sn;
    __device__ __forceinline__ void operator()(const f32x4 (&acc)[2][2][4][2], const Unit& u_, int wr, int wc, int fr, int fq, PG8_LAS float* xs) const {
        Unit u = u_; EPI_OPAQUE();
        const int hs = wc >> 1, head = u.pn * 2 + hs;
        if (wc & 1) {
#pragma unroll
            for (int ai = 0; ai < 2; ++ai)
#pragma unroll
                for (int m = 0; m < 4; ++m) {
                    asm volatile("" ::: "memory");
                    const int rl = ai * HALF + wr * 64 + m * 16 + fr, row = u.pm * BM + rl, b = row >> 11, s = row & (SEQ - 1);
#pragma unroll
                    for (int bj = 0; bj < 2; ++bj) {
                        float o[8];
#pragma unroll
                        for (int n = 0; n < 2; ++n)
#pragma unroll
                            for (int j = 0; j < 4; ++j) o[n * 4 + j] = acc[ai][bj][m][n][j];
                        *(u32x4*)(Vc + ((size_t)((b * 6 + head) * SEQ + s)) * 64 + bj * 32 + fq * 8) = pack8(o);
                    }
                }
        } else {
            float gk[16], gr1[4], gr2[4];
#pragma unroll
            for (int i = 0; i < 16; ++i) gk[i] = kn[(i >> 3) * 32 + fq * 8 + (i & 7)];
#pragma unroll
            for (int j = 0; j < 4; ++j) { gr1[j] = kn[64 + fq * 4 + j]; gr2[j] = kn[80 + fq * 4 + j]; }
            f32x4 k1, k2, k1n, k2n, c4, s4, c4n, s4n; float kss, kssn;
            { const int row = u.pm * BM + wr * 64 + fr, s0 = row & (SEQ - 1);
              k1 = *(const f32x4*)(kr + (size_t)row * 32 + fq * 4); k2 = *(const f32x4*)(kr + (size_t)row * 32 + 16 + fq * 4); kss = krss[row];
              c4 = *(const f32x4*)(cs + s0 * 16 + fq * 4); s4 = *(const f32x4*)(sn + s0 * 16 + fq * 4); }
#pragma unroll
            for (int ig = 0; ig < 8; ++ig) {
                const int ai = ig >> 2, m = ig & 3;
                const int rl = ai * HALF + wr * 64 + m * 16 + fr, row = u.pm * BM + rl, b = row >> 11, s = row & (SEQ - 1);
                if (ig < 7) { const int rown = u.pm * BM + ((ig + 1) >> 2) * HALF + wr * 64 + ((ig + 1) & 3) * 16 + fr, s1 = rown & (SEQ - 1);
                    k1n = *(const f32x4*)(kr + (size_t)rown * 32 + fq * 4); k2n = *(const f32x4*)(kr + (size_t)rown * 32 + 16 + fq * 4); kssn = krss[rown];
                    c4n = *(const f32x4*)(cs + s1 * 16 + fq * 4); s4n = *(const f32x4*)(sn + s1 * 16 + fq * 4); }
                float ss = 0.f;
#pragma unroll
                for (int bj = 0; bj < 2; ++bj)
#pragma unroll
                    for (int n = 0; n < 2; ++n) { const f32x4 a = acc[ai][bj][m][n]; ss += (a[0] * a[0] + a[1] * a[1]) + (a[2] * a[2] + a[3] * a[3]); }
                ss = quad_sum(ss) + kss;
                const float rn = __builtin_amdgcn_rsqf(ss * (1.0f / 96.0f) + EPS);
                bf16_t* dst = Kc + ((size_t)((b * 6 + head) * SEQ + s)) * 96;
#pragma unroll
                for (int bj = 0; bj < 2; ++bj) {
                    float o[8];
#pragma unroll
                    for (int n = 0; n < 2; ++n)
#pragma unroll
                        for (int j = 0; j < 4; ++j) o[n * 4 + j] = acc[ai][bj][m][n][j] * rn * gk[bj * 8 + n * 4 + j];
                    *(u32x4*)(dst + bj * 32 + fq * 8) = pack8(o);
                }
                float o1[4], o2[4];
#pragma unroll
                for (int j = 0; j < 4; ++j) {
                    const float x1 = k1[j] * rn * gr1[j], x2 = k2[j] * rn * gr2[j];
                    o1[j] = x1 * c4[j] - x2 * s4[j]; o2[j] = x1 * s4[j] + x2 * c4[j];
                }
                *(u32x2*)(dst + 64 + fq * 4) = (u32x2){cvt_pk_bf16(o1[0], o1[1]), cvt_pk_bf16(o1[2], o1[3])};
                *(u32x2*)(dst + 80 + fq * 4) = (u32x2){cvt_pk_bf16(o2[0], o2[1]), cvt_pk_bf16(o2[2], o2[3])};
                k1 = k1n; k2 = k2n; kss = kssn; c4 = c4n; s4 = s4n;
                asm volatile("" ::: "memory");
            }
        }
    }
};
template <class Epi, class Sched, bool ALIGN_EPI = false, bool SP2 = false>
__device__ __forceinline__ void gemm_phase(const int tid, PG8_LAS unsigned char* lds, PG8_LAS float* xs, const Gemm g, const Sched& S, const Epi& E) {
    const int wid = __builtin_amdgcn_readfirstlane(tid >> 6), lane = tid & 63, wr = wid >> 2, wc = wid & 3, fr = lane & 15, fq = lane >> 4;
    const int K = g.K, nt = K / BK;
    unsigned voffA[2], voffB[2];
#pragma unroll
    for (int i = 0; i < 2; ++i) { int R, C; stage_rc(tid * 16 + i * 8192, R, C); const int Rb = Epi::PERM ? ((R & ~31) + perm32(R & 31)) : R;
        voffA[i] = (unsigned)(R * g.lda + C) * 2u; voffB[i] = (unsigned)(Rb * g.ldb + C) * 2u; }
    const size_t kstep = (size_t)(BK * 2);
    const size_t hstepA = (size_t)HALF * g.lda * 2, hstepB = (size_t)HALF * g.ldb * 2;
    const size_t tstepA = 2 * hstepA, tstepB = 2 * hstepB;
    const unsigned ldsw = (unsigned)wid * 1024u;
    const int aoff = lds_byte(wr * 64 + fr, fq * 8), boff = lds_byte(wc * 32 + fr, fq * 8);
#define PG8_SA(b, h) (((b) * 2 + (h)) * HTB)
#define PG8_SB(b, h) ((4 + (b) * 2 + (h)) * HTB)
#define PG8_STAGE(bufoff, gbase, voff) do { _Pragma("unroll") for (int _i = 0; _i < 2; ++_i) \
        __builtin_amdgcn_global_load_lds((const unsigned*)((const char*)(gbase) + (voff)[_i]), (PG8_LAS unsigned*)(lds + (bufoff) + ldsw + _i * 8192), 16, 0, 0); } while (0)
#define PG8_LDA(dst, b, h) do { _Pragma("unroll") for (int m = 0; m < 4; ++m) _Pragma("unroll") for (int k = 0; k < 2; ++k) dst[m][k] = *(const PG8_LAS bf16x8*)(lds + PG8_SA(b, h) + aoff + m * 2048 + k * 1024); } while (0)
#define PG8_LDB(dst, b, h) do { _Pragma("unroll") for (int n = 0; n < 2; ++n) _Pragma("unroll") for (int k = 0; k < 2; ++k) dst[n][k] = *(const PG8_LAS bf16x8*)(lds + PG8_SB(b, h) + boff + n * 2048 + k * 1024); } while (0)
#define PG8_MMA(ai, bj, At, Bt) do { __builtin_amdgcn_s_setprio(1); _Pragma("unroll") for (int m = 0; m < 4; ++m) _Pragma("unroll") for (int n = 0; n < 2; ++n) _Pragma("unroll") for (int k = 0; k < 2; ++k) \
        acc[ai][bj][m][n] = __builtin_amdgcn_mfma_f32_16x16x32_bf16(Bt[n][k], At[m][k], acc[ai][bj][m][n], 0, 0, 0); __builtin_amdgcn_s_setprio(0); } while (0)
#define PG8_WAIT_V(n) asm volatile("s_waitcnt vmcnt(" #n ")" ::: "memory")
#define PG8_WAIT_L(n) asm volatile("s_waitcnt lgkmcnt(" #n ")" ::: "memory")
#define PG8_BAR __builtin_amdgcn_s_barrier()
#define PG8_SCHED __builtin_amdgcn_sched_barrier(0)
    Unit cur, nxt; int ui = 0;
    if (!S.next(0, cur)) return;
    f32x4 acc[2][2][4][2];
#pragma unroll
    for (int a = 0; a < 2; ++a)
#pragma unroll
        for (int b = 0; b < 2; ++b)
#pragma unroll
            for (int m = 0; m < 4; ++m)
#pragma unroll
                for (int n = 0; n < 2; ++n) acc[a][b][m][n] = (f32x4){0.f, 0.f, 0.f, 0.f};
    bf16x8 At[4][2], B0[2][2], B1[2][2];
    const char* cA = (const char*)g.A + (size_t)cur.pm * tstepA; const char* cB = (const char*)g.Bt + (size_t)cur.pn * tstepB;
    S.a_ready(cur);
    if constexpr (SP2) {
        PG8_STAGE(PG8_SB(0, 0), cB, voffB); PG8_STAGE(PG8_SB(0, 1), cB + hstepB, voffB); PG8_STAGE(PG8_SA(0, 0), cA, voffA); PG8_STAGE(PG8_SA(0, 1), cA + hstepA, voffA);
        if (wr == 1) PG8_BAR;
        PG8_WAIT_V(2); PG8_BAR;
        PG8_STAGE(PG8_SB(1, 0), cB + kstep, voffB); PG8_STAGE(PG8_SA(1, 0), cA + kstep, voffA); PG8_STAGE(PG8_SB(1, 1), cB + hstepB + kstep, voffB);
        PG8_WAIT_V(6); PG8_BAR;
    } else {
        PG8_STAGE(PG8_SB(0, 0), cB, voffB); PG8_STAGE(PG8_SA(0, 0), cA, voffA); PG8_STAGE(PG8_SB(0, 1), cB + hstepB, voffB); PG8_STAGE(PG8_SA(0, 1), cA + hstepA, voffA);
        if (wr == 1) PG8_BAR;
        PG8_WAIT_V(4); PG8_BAR;
        PG8_STAGE(PG8_SB(1, 0), cB + kstep, voffB); PG8_STAGE(PG8_SA(1, 0), cA + kstep, voffA); PG8_STAGE(PG8_SB(1, 1), cB + hstepB + kstep, voffB);
        PG8_WAIT_V(6); PG8_BAR;
    }
    for (;;) {
        const bool has_next = S.next(ui + 1, nxt);
        const char* nA = has_next ? (const char*)g.A + (size_t)nxt.pm * tstepA : cA; const char* nB = has_next ? (const char*)g.Bt + (size_t)nxt.pn * tstepB : cB;
        for (int t = 0; t < nt; t += 2) {
            const bool last = (t == nt - 2);
            const char* a1 = cA + (size_t)(t + 1) * kstep;
            const char* a2 = last ? nA : cA + (size_t)(t + 2) * kstep; const char* b2 = last ? nB : cB + (size_t)(t + 2) * kstep;
            const char* a3 = a2 + kstep; const char* b3 = b2 + kstep;
            if (last && has_next) S.a_ready(nxt);
            if constexpr (SP2) {
            PG8_LDB(B0, 0, 0); PG8_LDB(B1, 0, 1); PG8_SCHED; PG8_LDA(At, 0, 0); PG8_STAGE(PG8_SA(1, 1), a1 + hstepA, voffA);
            PG8_WAIT_V(8); PG8_WAIT_L(0); PG8_BAR; PG8_MMA(0, 0, At, B0); PG8_MMA(0, 1, At, B1); PG8_BAR; PG8_SCHED;
            PG8_LDA(At, 0, 1); PG8_STAGE(PG8_SB(0, 0), b2, voffB); PG8_STAGE(PG8_SB(0, 1), b2 + hstepB, voffB); PG8_STAGE(PG8_SA(0, 0), a2, voffA);
            PG8_WAIT_V(8); PG8_WAIT_L(0); PG8_BAR; PG8_MMA(1, 0, At, B0); PG8_MMA(1, 1, At, B1); PG8_BAR; PG8_SCHED;
            PG8_LDB(B0, 1, 0); PG8_LDB(B1, 1, 1); PG8_SCHED; PG8_LDA(At, 1, 0); PG8_STAGE(PG8_SA(0, 1), a2 + hstepA, voffA);
            PG8_WAIT_V(8); PG8_WAIT_L(0); PG8_BAR; PG8_MMA(0, 0, At, B0); PG8_MMA(0, 1, At, B1); PG8_BAR; PG8_SCHED;
            PG8_LDA(At, 1, 1); PG8_STAGE(PG8_SB(1, 0), b3, voffB); PG8_STAGE(PG8_SB(1, 1), b3 + hstepB, voffB); PG8_STAGE(PG8_SA(1, 0), a3, voffA);
            PG8_WAIT_V(8); PG8_WAIT_L(0); PG8_BAR; PG8_MMA(1, 0, At, B0); PG8_MMA(1, 1, At, B1); PG8_BAR; PG8_SCHED;
            } else {
            PG8_LDB(B0, 0, 0); PG8_SCHED; PG8_LDA(At, 0, 0); PG8_STAGE(PG8_SA(1, 1), a1 + hstepA, voffA);
            PG8_WAIT_L(8); PG8_BAR; PG8_WAIT_L(0); PG8_MMA(0, 0, At, B0); PG8_BAR; PG8_SCHED;
            PG8_LDB(B1, 0, 1); PG8_STAGE(PG8_SB(0, 0), b2, voffB);
            PG8_BAR; PG8_WAIT_L(0); PG8_MMA(0, 1, At, B1); PG8_BAR;
            PG8_LDA(At, 0, 1); PG8_STAGE(PG8_SA(0, 0), a2, voffA);
            PG8_BAR; PG8_WAIT_L(0); PG8_MMA(1, 0, At, B0); PG8_BAR; PG8_SCHED;
            PG8_STAGE(PG8_SB(0, 1), b2 + hstepB, voffB);
            PG8_WAIT_V(6); PG8_BAR; PG8_MMA(1, 1, At, B1); PG8_BAR;
            PG8_LDB(B0, 1, 0); PG8_SCHED; PG8_LDA(At, 1, 0); PG8_STAGE(PG8_SA(0, 1), a2 + hstepA, voffA);
            PG8_WAIT_L(8); PG8_BAR; PG8_WAIT_L(0); PG8_MMA(0, 0, At, B0); PG8_BAR; PG8_SCHED;
            PG8_LDB(B1, 1, 1); PG8_STAGE(PG8_SB(1, 0), b3, voffB);
            PG8_BAR; PG8_WAIT_L(0); PG8_MMA(0, 1, At, B1); PG8_BAR;
            PG8_LDA(At, 1, 1); PG8_STAGE(PG8_SA(1, 0), a3, voffA);
            PG8_BAR; PG8_WAIT_L(0); PG8_MMA(1, 0, At, B0); PG8_BAR; PG8_SCHED;
            PG8_STAGE(PG8_SB(1, 1), b3 + hstepB, voffB);
            PG8_WAIT_V(6); PG8_BAR; PG8_MMA(1, 1, At, B1); PG8_BAR;
            }
        }
        if constexpr (ALIGN_EPI) { if (wr == 0) PG8_BAR; }
        if constexpr (!Epi::AFTER_DRAIN) { E(acc, cur, wr, wc, fr, fq, xs);
#if defined(MK_DUP_EPI)
            if constexpr (Epi::DUP_OK) E(acc, cur, wr, wc, fr, fq, xs);
#endif
            S.done(cur); }
        if (!has_next) break;
#pragma unroll
        for (int a = 0; a < 2; ++a)
#pragma unroll
            for (int b = 0; b < 2; ++b)
#pragma unroll
                for (int m = 0; m < 4; ++m)
#pragma unroll
                    for (int n = 0; n < 2; ++n) acc[a][b][m][n] = (f32x4){0.f, 0.f, 0.f, 0.f};
        cur = nxt; cA = nA; cB = nB; ++ui;
        if constexpr (ALIGN_EPI) { if (wr == 1) PG8_BAR; }
    }
    PG8_WAIT_V(0);
    if constexpr (!ALIGN_EPI) { if (wr == 0) PG8_BAR; }
    PG8_BAR;
    if constexpr (Epi::AFTER_DRAIN) { E(acc, cur, wr, wc, fr, fq, xs); S.done(cur); }
#undef PG8_SA
#undef PG8_SB
#undef PG8_STAGE
#undef PG8_LDA
#undef PG8_LDB
#undef PG8_MMA
#undef PG8_WAIT_V
#undef PG8_WAIT_L
#undef PG8_BAR
#undef PG8_SCHED
}
}

constexpr size_t MiB = 1u << 20;
constexpr size_t WS_CTL = 0, CTL_ZERO_BYTES = 1 * MiB;
constexpr size_t WS_TAB = 1 * MiB;
constexpr size_t WS_P = 2 * MiB;
constexpr size_t WS_KR = 5 * MiB;
constexpr size_t WS_KRSS = 7 * MiB;
constexpr size_t WS_W = 8 * MiB;
constexpr size_t W_GU1 = WS_W, W_GU2 = W_GU1 + 11 * MiB, W_D1 = W_GU2 + 11 * MiB, W_D2 = W_D1 + 5632 * 1024, W_IN = W_D2 + 5632 * 1024, W_O = W_IN + 5 * MiB, W_QU = W_O + 2 * MiB, W_KVU = W_QU + 768 * 256 * 2, W_END = W_KVU + 768 * 256 * 2;
static_assert(W_END <= 50 * MiB, "weights");
constexpr size_t WS_XB = 50 * MiB;
constexpr size_t WS_R = 82 * MiB;
constexpr size_t WS_H = WS_R;
constexpr size_t WS_QD = WS_R, WS_KD = WS_QD + 8 * MiB, WS_VD = WS_KD + 8 * MiB, WS_QL = WS_VD + 8 * MiB, WS_KL = WS_QL + 12 * MiB, WS_VL = WS_KL + 12 * MiB;
constexpr size_t WS_QC = WS_VL + 12 * MiB, WS_KC = WS_QC + 18 * MiB, WS_VC = WS_KC + 18 * MiB, WS_AQ = WS_VC + 12 * MiB, WS_MIX = WS_AQ + 12 * MiB, WS_END = WS_MIX + 32 * MiB;
static_assert(WS_END <= 236 * MiB && WS_H + (size_t)MTOK * DFF * 2 <= WS_MIX, "d_ws map");
constexpr size_t WS_DO0 = WS_XB, WS_DO1 = WS_XB + 12 * MiB, WS_DL = WS_XB + 24 * MiB, WS_DO2 = 236 * MiB, WS_TOTAL = 248 * MiB;
constexpr int TAB_COS = 0, TAB_SIN = 32768;
constexpr int TAB_BD = 65536;
constexpr int TAB_BL = TAB_BD + 2 * 4 * 4096;
constexpr int TAB_SC = TAB_BL + 2 * 6 * 4096;
static_assert((TAB_SC + 64) * 4 <= (int)MiB, "tables");
constexpr int CW_BAR = 4096;

constexpr int RING_BYTES = 131072, XS_OFF = 155648, XS_BYTES = 4096, MISC_OFF = 159744, LDS_BYTES = 163840;

#define GAS __attribute__((address_space(1)))
#define LAS __attribute__((address_space(3)))
typedef unsigned short bf16;
typedef unsigned v4u __attribute__((ext_vector_type(4)));
typedef float f32x4 __attribute__((ext_vector_type(4)));
typedef GAS unsigned gu32;
#define RLX_AGENT __ATOMIC_RELAXED, __HIP_MEMORY_SCOPE_AGENT
#define LDS_WAIT() asm volatile("s_waitcnt lgkmcnt(0)" ::: "memory")
__device__ __forceinline__ unsigned f2bf(float f) { unsigned u = __builtin_bit_cast(unsigned, f); return (u + 0x7fffu + ((u >> 16) & 1u)) >> 16; }
__device__ __forceinline__ unsigned pk2(float lo, float hi) { return f2bf(lo) | (f2bf(hi) << 16); }
__device__ __forceinline__ float bflo(unsigned w) { return __builtin_bit_cast(float, w << 16); }
__device__ __forceinline__ float bfhi(unsigned w) { return __builtin_bit_cast(float, w & 0xffff0000u); }
__device__ __forceinline__ void unpack8(v4u w, float* o) { o[0] = bflo(w.x); o[1] = bfhi(w.x); o[2] = bflo(w.y); o[3] = bfhi(w.y); o[4] = bflo(w.z); o[5] = bfhi(w.z); o[6] = bflo(w.w); o[7] = bfhi(w.w); }

#define XB_TMO      128
#define XB_XCNT(j)  (256  + 64 * (j))
#define XB_XSUB(j)  (1280 + 64 * (j))
#define XB_XGEN(j)  (2304 + 64 * (j))
#define XB_TOP      3328
#define XB_TOPGEN   3392
#define XCD_BAR_WORDS 3456
#define XB_SPIN_CAP (1u << 22)

__device__ __forceinline__ unsigned xb_ld(unsigned* p)              { return __hip_atomic_load(p, __ATOMIC_RELAXED, __HIP_MEMORY_SCOPE_AGENT); }
__device__ __forceinline__ unsigned xb_add(unsigned* p, unsigned v) { return __hip_atomic_fetch_add(p, v, __ATOMIC_RELAXED, __HIP_MEMORY_SCOPE_AGENT); }
__device__ __forceinline__ unsigned xb_xcc_id() { return (unsigned)__builtin_amdgcn_s_getreg((3 << 11) | 20) & 0xFu; }
#define XB_SPIN(cond, bar) do { unsigned _sp = 0; while (cond) { __builtin_amdgcn_s_sleep(1); \
    if ((++_sp & 255u) == 0u) { if (xb_ld(&(bar)[XB_TMO])) break; if (_sp > XB_SPIN_CAP) { atomicAdd(&(bar)[XB_TMO], 1u); break; } } } } while (0)

__device__ __forceinline__ void xcd_barrier_post(unsigned* bar, volatile LAS unsigned* st, bool tid0) {
    if (tid0) { const unsigned x = xb_xcc_id(); st[2] = x; (void)xb_add(&bar[XB_XCNT(x)], 1u); }
}
__device__ __forceinline__ void xcd_barrier_complete(unsigned* bar, unsigned x, unsigned& nloc, unsigned& nx) {
    const unsigned G = gridDim.x * gridDim.y * gridDim.z;
    unsigned sum, cnt, mine, sp = 0u;
    for (;;) {
        sum = 0u; cnt = 0u; mine = 0u;
        for (unsigned j = 0; j < 16; ++j) { const unsigned c = xb_ld(&bar[XB_XCNT(j)]); sum += c; cnt += (c > 0u) ? 1u : 0u; mine = (j == x) ? c : mine; }
        if (sum == G) break;
        __builtin_amdgcn_s_sleep(1);
        if ((++sp & 255u) == 0u) { if (xb_ld(&bar[XB_TMO])) break; if (sp > XB_SPIN_CAP) { atomicAdd(&bar[XB_TMO], 1u); break; } }
    }
    nloc = mine > 0u ? mine : 1u; nx = cnt > 0u ? cnt : 1u;
}
__device__ __forceinline__ void xcd_barrier(unsigned* bar0, volatile LAS unsigned* st, bool tid0) {
    asm volatile("s_waitcnt vmcnt(0)" ::: "memory");
    __syncthreads();
    if (tid0) {
        unsigned* bar = bar0; asm volatile("" : "+v"(bar));
        __builtin_amdgcn_s_waitcnt(0);
        unsigned nloc = st[0], nx = st[1]; const unsigned x = st[2];
        if (nloc == 0u) { xcd_barrier_complete(bar, x, nloc, nx); st[0] = nloc; st[1] = nx; }
        const unsigned old = xb_add(&bar[XB_XSUB(x)], 1u);
        const unsigned gen = old / nloc;
        if (old + 1u == (gen + 1u) * nloc) {
            __builtin_amdgcn_fence(__ATOMIC_RELEASE, "agent");
            asm volatile("s_waitcnt vmcnt(0)" ::: "memory");
            const unsigned og = xb_add(&bar[XB_TOP], 1u);
            const unsigned tg = og / nx;
            if (og + 1u == (tg + 1u) * nx) xb_add(&bar[XB_TOPGEN], 1u);
            else XB_SPIN(xb_ld(&bar[XB_TOPGEN]) == tg, bar);
            __builtin_amdgcn_fence(__ATOMIC_ACQUIRE, "agent");
            xb_add(&bar[XB_XGEN(x)], 1u);
            asm volatile("s_waitcnt vmcnt(0)" ::: "memory");
        } else {
            XB_SPIN(xb_ld(&bar[XB_XGEN(x)]) == gen, bar);
            __builtin_amdgcn_fence(__ATOMIC_ACQUIRE, "agent");
            asm volatile("s_waitcnt vmcnt(0)" ::: "memory");
        }
    }
    __syncthreads();
}

struct Args { const float* in[25]; float* out; unsigned char* ws; int layer, pad; };
enum { I_X = 0, I_RELB, I_F1N, I_F1G, I_F1U, I_F1D, I_MIXN, I_WIN, I_DQN, I_DKN, I_DLAM, I_DSUB, I_LQN, I_LKN, I_MQN, I_MQU, I_MKVN, I_MKVU, I_MQNG, I_MKNG, I_WO, I_F2N, I_F2G, I_F2U, I_F2D };

__device__ __forceinline__ float wave_sum(float v) { v += swz<1>(v); v += swz<2>(v); v += swz<4>(v); v += swz<8>(v); v += swz<16>(v); return sum_x32(v); }
__device__ __forceinline__ float wave_max(float v) { v = fmaxf(v, swz<1>(v)); v = fmaxf(v, swz<2>(v)); v = fmaxf(v, swz<4>(v)); v = fmaxf(v, swz<8>(v)); v = fmaxf(v, swz<16>(v)); return max_x32(v); }

__device__ __forceinline__ const void* lds_ptr_get(volatile LAS unsigned long long* PT, int i) {
    const unsigned long long v = PT[i];
    const unsigned lo = __builtin_amdgcn_readfirstlane((unsigned)v), hi = __builtin_amdgcn_readfirstlane((unsigned)(v >> 32));
    return (const void*)(((unsigned long long)hi << 32) | lo);
}
#define AIN(i) ((const float*)lds_ptr_get(PT, (i)))
__device__ __forceinline__ void tr_item64(const float* W, int Nsrc, int ks0, const float* gain, int sc, bool valid, bf16* dstrow) {
    float v[64];
    const float* src = W + (size_t)ks0 * Nsrc + sc;
#pragma unroll
    for (int i = 0; i < 64; ++i) v[i] = valid ? src[(size_t)i * Nsrc] : 0.f;
    if (gain) {
#pragma unroll
        for (int i = 0; i < 64; ++i) v[i] *= gain[ks0 + i];
    }
#pragma unroll
    for (int j = 0; j < 8; ++j) { v4u o; o.x = pk2(v[8 * j], v[8 * j + 1]); o.y = pk2(v[8 * j + 2], v[8 * j + 3]); o.z = pk2(v[8 * j + 4], v[8 * j + 5]); o.w = pk2(v[8 * j + 6], v[8 * j + 7]);
        *(GAS v4u*)(dstrow + 8 * j) = o; }
}

__device__ __forceinline__ void win_map(int g, int& sc, int& nvalid) {
    const int pn = g >> 3, gi = g & 7, bj = gi >> 2, wc = gi & 3; nvalid = 32;
    switch (pn) {
        case 0: sc = 0 + wc * 64 + bj * 32; break;
        case 1: sc = 256 + wc * 64 + bj * 32; break;
        case 2: sc = 512 + wc * 64 + bj * 32; break;
        case 3: sc = 768 + wc * 64 + bj * 32; break;
        case 4: sc = (wc < 2) ? 768 + (4 + wc) * 64 + bj * 32 : 1152 + (wc - 2) * 64 + bj * 32; break;
        case 5: sc = 1152 + (wc + 2) * 64 + bj * 32; break;
        case 6: sc = 1536 + wc * 64 + bj * 32; break;
        case 7: sc = (wc < 2) ? 1536 + (4 + wc) * 64 + bj * 32 : 2176 + (wc - 2) * 64 + bj * 32; break;
        case 8: sc = 1920 + bj * 128 + wc * 32; break;
        default: sc = 2176 + 128 + bj * 16; nvalid = (wc == 0) ? 16 : 0; break;
    }
}

__device__ __forceinline__ void convert_weights(volatile LAS unsigned long long* PT, unsigned char* ws, int l, int sel, int gw, int NGW, int lane) {
    constexpr int I_GU = (5632 / 64) * 16, I_D = 16 * 44, I_IN = 40 * 16, I_O = 16 * 16, I_QU = 12 * 4, I_KVU = 12 * 4;
    constexpr int NITEMS = 2 * I_GU + 2 * I_D + I_IN + I_O + I_QU + I_KVU;
    const int lg = lane >> 5, li = lane & 31;
    for (int it = gw; it < NITEMS; it += NGW) {
        int r = it;
        if (r < 2 * I_GU) {
            const int f = r / I_GU; r -= f * I_GU; if (!((sel >> f) & 1)) continue; const int G2 = r >> 4, kb = r & 15, g = 2 * G2 + lg;
            const int pn = g >> 3, gi = g & 7, bj = gi >> 2, wc = gi & 3;
            const float* Wg = AIN(f == 0 ? I_F1G : I_F2G) + (size_t)l * DM * DFF; const float* Wu = AIN(f == 0 ? I_F1U : I_F2U) + (size_t)l * DM * DFF;
            const float* gain = AIN(f == 0 ? I_F1N : I_F2N) + l * DM;
            bf16* dst = (bf16*)(ws + (f == 0 ? W_GU1 : W_GU2)) + (size_t)(32 * g + li) * DM + 64 * kb;
            tr_item64(bj == 0 ? Wg : Wu, DFF, 64 * kb, gain, pn * 128 + wc * 32 + li, true, dst); continue;
        }
        r -= 2 * I_GU;
        if (r < 2 * I_D) {
            const int f = r / I_D; r -= f * I_D; if (!((sel >> (2 + f)) & 1)) continue; const int G2 = r / 44, kb = r - G2 * 44;
            const float* W = AIN(f == 0 ? I_F1D : I_F2D) + (size_t)l * DFF * DM;
            bf16* dst = (bf16*)(ws + (f == 0 ? W_D1 : W_D2)) + (size_t)(64 * G2 + lane) * DFF + 64 * kb;
            tr_item64(W, DM, 64 * kb, nullptr, 64 * G2 + lane, true, dst); continue;
        }
        r -= 2 * I_D;
        if (r < I_IN) {
            if (!(sel & 16)) continue;
            const int G2 = r >> 4, kb = r & 15, g = 2 * G2 + lg; int sc, nv; win_map(g, sc, nv);
            const float* W = AIN(I_WIN) + (size_t)l * DM * IN_W;
            bf16* dst = (bf16*)(ws + W_IN) + (size_t)(32 * g + li) * DM + 64 * kb;
            tr_item64(W, IN_W, 64 * kb, AIN(I_MIXN) + l * DM, sc + li, li < nv, dst); continue;
        }
        r -= I_IN;
        if (r < I_O) {
            if (!(sel & 32)) continue;
            const int G2 = r >> 4, kb = r & 15;
            bf16* dst = (bf16*)(ws + W_O) + (size_t)(64 * G2 + lane) * DM + 64 * kb;
            tr_item64(AIN(I_WO) + (size_t)l * DM * DM, DM, 64 * kb, nullptr, 64 * G2 + lane, true, dst); continue;
        }
        r -= I_O;
        if (r < I_QU) {
            if (!(sel & 64)) continue;
            const int G2 = r >> 2, kb = r & 3, g = 2 * G2 + lg; const int pn = g >> 3, gi = g & 7, bj = gi >> 2, wc = gi & 3, head = pn * 2 + (wc >> 1);
            const int sc = (wc & 1) ? head * 96 + 64 + 16 * bj : head * 96 + 32 * bj, nv = (wc & 1) ? 16 : 32;
            bf16* dst = (bf16*)(ws + W_QU) + (size_t)(32 * g + li) * 256 + 64 * kb;
            tr_item64(AIN(I_MQU) + (size_t)l * 256 * 576, 576, 64 * kb, AIN(I_MQN) + l * 256, sc + li, li < nv, dst); continue;
        }
        r -= I_QU;
        {
            if (!(sel & 128)) continue;
            const int G2 = r >> 2, kb = r & 3, g = 2 * G2 + lg; const int pn = g >> 3, gi = g & 7, bj = gi >> 2, wc = gi & 3, head = pn * 2 + (wc >> 1);
            const int sc = head * 128 + ((wc & 1) ? 64 : 0) + 32 * bj;
            bf16* dst = (bf16*)(ws + W_KVU) + (size_t)(32 * g + li) * 256 + 64 * kb;
            if (kb < 2) tr_item64(AIN(I_MKVU), 768, 0, nullptr, 0, false, dst);
            else tr_item64(AIN(I_MKVU) + (size_t)l * 128 * 768, 768, 64 * (kb - 2), AIN(I_MKVN) + l * 128, sc + li, true, dst);
        }
    }
}

__device__ __forceinline__ int t5_bucket(int rel) {
    const int n = rel < 0 ? -rel : rel;
    const float nf = (float)(n > 1 ? n : 1);
    int large = 8 + (int)(logf(nf / 8.0f) / 4.852030263919617f * 8.0f);
    large = large < 15 ? large : 15;
    return (rel > 0 ? 16 : 0) + (n < 8 ? n : large);
}

__device__ __forceinline__ void prologue_misc(volatile LAS unsigned long long* PT, unsigned char* ws, int gw, int NGW, int lane, int gtid, int NGT) {
    float* tab = (float*)(ws + WS_TAB);
    for (int i = gtid; i < SEQ * 16; i += NGT) { const int s = i >> 4, j = i & 15; const double inv = pow(10000.0, -(double)j / 16.0), ang = (double)s * inv; tab[TAB_COS + i] = (float)cos(ang); tab[TAB_SIN + i] = (float)sin(ang); }
    for (int l = 0; l < DEPTH; ++l) {
        const float* relb = AIN(I_RELB);
        float mbd = 0.f, mbl = 0.f;
        for (int i = lane; i < 320; i += 64) { const float v = fabsf(relb[i]); if ((i % 10) < 4) mbd = fmaxf(mbd, v); else mbl = fmaxf(mbl, v); }
        mbd = wave_max(mbd); mbl = wave_max(mbl);
        float gq = (lane < 32) ? fabsf(AIN(I_DQN)[l * 32 + lane]) : 0.f, gk = (lane < 32) ? fabsf(AIN(I_DKN)[l * 32 + lane]) : 0.f;
        gq = wave_max(gq); gk = wave_max(gk);
        const float B2d = (5.656854249f * gq * gk + mbd) * LOG2E;
        float lq = fabsf(AIN(I_LQN)[l * 64 + lane]), lk = fabsf(AIN(I_LKN)[l * 64 + lane]);
        lq = wave_max(lq); lk = wave_max(lk);
        const float B2l = (8.0f * lq * lk + mbl) * LOG2E;
        float mq = fmaxf(fabsf(AIN(I_MQNG)[l * 96 + lane]), lane < 32 ? fabsf(AIN(I_MQNG)[l * 96 + 64 + lane]) : 0.f);
        float mk = fmaxf(fabsf(AIN(I_MKNG)[l * 96 + lane]), lane < 32 ? fabsf(AIN(I_MKNG)[l * 96 + 64 + lane]) : 0.f);
        mq = wave_max(mq); mk = wave_max(mk);
        const float B2c = 9.797958971f * mq * mk * LOG2E;
        for (int i = gtid; i < 10 * 4096; i += NGT) {
            const int h = i >> 12, idx = i & 4095, rel = idx - 2048; const int bk = t5_bucket(rel);
            if (h < 4) tab[TAB_BD + (l * 4 + h) * 4096 + idx] = relb[bk * 10 + h] * LOG2E - B2d;
            else tab[TAB_BL + (l * 6 + (h - 4)) * 4096 + idx] = relb[bk * 10 + h] * LOG2E - B2l;
        }
        if (gw == 0) {
            const float* lp = AIN(I_DLAM) + l * 128;
            float s1 = (lane < 32) ? lp[lane] * lp[32 + lane] : 0.f, s2 = (lane < 32) ? lp[64 + lane] * lp[96 + lane] : 0.f;
            s1 = wave_sum(s1); s2 = wave_sum(s2);
            const float linit = 0.8f - 0.6f * expf(-0.3f * (float)(l + 1));
            if (lane == 0) { tab[TAB_SC + l * 8 + 0] = expf(s1) - expf(s2) + linit; tab[TAB_SC + l * 8 + 1] = 1.0f - linit; tab[TAB_SC + l * 8 + 2] = -B2c; }
        }
    }
    float* P0 = (float*)(ws + WS_P);
    for (int m = gw; m < MTOK; m += NGW) {
        const GAS f32x4* xr = (const GAS f32x4*)(AIN(I_X) + (size_t)m * DM) + lane;
        GAS unsigned long long* o8 = (GAS unsigned long long*)((bf16*)(ws + WS_XB) + (size_t)m * DM) + lane;
        float s = 0.f;
#pragma unroll
        for (int j = 0; j < 4; ++j) { const f32x4 v = xr[64 * j]; s += (v.x * v.x + v.y * v.y) + (v.z * v.z + v.w * v.w);
            o8[64 * j] = (unsigned long long)pk2(v.x, v.y) | ((unsigned long long)pk2(v.z, v.w) << 32); }
        s = wave_sum(s);
        if (lane < 16) P0[(size_t)m * 16 + lane] = lane == 0 ? s : 0.f;
    }
}


__device__ __forceinline__ void diff_unit_v1(const unsigned char* ws, const float* sub, const int tid, int l, int u, LAS float* lds) {
    const int c = tid >> 8, ql = tid & 255, bh = u >> 3, b = bh >> 2, h = bh & 3, qi = (u & 7) * 256 + ql;
    const bf16* Qd = (const bf16*)(ws + WS_QD); const bf16* Kd = (const bf16*)(ws + WS_KD); const bf16* Vd = (const bf16*)(ws + WS_VD);
    const float* tab = (const float*)(ws + WS_TAB) + TAB_BD + (l * 4 + h) * 4096;
    float q[32], o[64]; float lsum = 0.f;
    { const v4u* qp = (const v4u*)(Qd + ((size_t)(((b * 4 + h) * 2 + c) * SEQ + qi)) * 32);
#pragma unroll
      for (int i = 0; i < 4; ++i) unpack8(qp[i], q + 8 * i); }
#pragma unroll
    for (int d = 0; d < 64; ++d) o[d] = 0.f;
    LAS float* Ks = lds;
    LAS float* Vs = lds + 4096;
    for (int kc = 0; kc < SEQ / 64; ++kc) {
        __syncthreads();
        { const int e = tid * 8, cc = e >> 11, key = (e & 2047) >> 5, d = e & 31;
          const v4u w = *(const v4u*)(Kd + ((size_t)(((b * 4 + h) * 2 + cc) * SEQ + kc * 64 + key)) * 32 + d);
          float t[8]; unpack8(w, t);
#pragma unroll
          for (int i = 0; i < 8; ++i) Ks[e + i] = t[i];
          const int vkey = e >> 6, vd = e & 63;
          const v4u w2 = *(const v4u*)(Vd + ((size_t)((b * 4 + h) * SEQ + kc * 64 + vkey)) * 64 + vd);
          unpack8(w2, t);
#pragma unroll
          for (int i = 0; i < 8; ++i) Vs[e + i] = t[i]; }
        __syncthreads();
        for (int j = 0; j < 64; ++j) {
            const int k = kc * 64 + j;
            float s = tab[k - qi + 2048];
            const LAS f32x4* kp = (const LAS f32x4*)(Ks + (c * 64 + j) * 32);
#pragma unroll
            for (int i = 0; i < 8; ++i) { const f32x4 kv = kp[i]; s += q[4 * i] * kv.x + q[4 * i + 1] * kv.y + q[4 * i + 2] * kv.z + q[4 * i + 3] * kv.w; }
            const float p = __builtin_amdgcn_exp2f(s);
            lsum += p;
            const LAS f32x4* vp = (const LAS f32x4*)(Vs + j * 64);
#pragma unroll
            for (int i = 0; i < 16; ++i) { const f32x4 vv = vp[i]; o[4 * i] += p * vv.x; o[4 * i + 1] += p * vv.y; o[4 * i + 2] += p * vv.z; o[4 * i + 3] += p * vv.w; }
        }
    }
    __syncthreads();
    const float inv = 1.0f / lsum;
    LAS float* Xs = lds + 8192;
    if (c == 1) {
#pragma unroll
        for (int d = 0; d < 64; ++d) Xs[ql * 68 + d] = o[d] * inv;
    }
    __syncthreads();
    if (c == 0) {
        const float* sc = (const float*)(ws + WS_TAB) + TAB_SC + l * 8; const float lam = sc[0], post = sc[1];
        float ss = 0.f;
#pragma unroll
        for (int d = 0; d < 64; ++d) { o[d] = o[d] * inv - lam * Xs[ql * 68 + d]; ss += o[d] * o[d]; }
        const float rn = __builtin_amdgcn_rsqf(ss * (1.0f / 64.0f) + EPS) * post;
        bf16* dst = (bf16*)(ws + WS_MIX) + ((size_t)(b * SEQ + qi)) * DM + h * 64;
#pragma unroll
        for (int i = 0; i < 8; ++i) { v4u w; w.x = pk2(o[8 * i] * rn * sub[8 * i], o[8 * i + 1] * rn * sub[8 * i + 1]); w.y = pk2(o[8 * i + 2] * rn * sub[8 * i + 2], o[8 * i + 3] * rn * sub[8 * i + 3]);
            w.z = pk2(o[8 * i + 4] * rn * sub[8 * i + 4], o[8 * i + 5] * rn * sub[8 * i + 5]); w.w = pk2(o[8 * i + 6] * rn * sub[8 * i + 6], o[8 * i + 7] * rn * sub[8 * i + 7]); *(v4u*)(dst + 8 * i) = w; }
    }
    __syncthreads();
}

__device__ __forceinline__ void mla_unit_v1(const unsigned char* ws, const int tid, int l, int u, LAS float* lds) {
    const int bh = u >> 2, b = bh / 6, h = bh % 6, qi = (u & 3) * 512 + tid;
    const bf16* Qc = (const bf16*)(ws + WS_QC); const bf16* Kc = (const bf16*)(ws + WS_KC); const bf16* Vc = (const bf16*)(ws + WS_VC);
    const float nb2 = ((const float*)(ws + WS_TAB))[TAB_SC + l * 8 + 2];
    float q[96], o[64]; float lsum = 0.f;
    { const v4u* qp = (const v4u*)(Qc + ((size_t)((b * 6 + h) * SEQ + qi)) * 96);
#pragma unroll
      for (int i = 0; i < 12; ++i) unpack8(qp[i], q + 8 * i); }
#pragma unroll
    for (int d = 0; d < 64; ++d) o[d] = 0.f;
    LAS float* Ks = lds;
    LAS float* Vs = lds + 3072;
    for (int kc = 0; kc < SEQ / 32; ++kc) {
        __syncthreads();
        if (tid < 384) { const int e = tid * 8; const v4u w = *(const v4u*)(Kc + ((size_t)((b * 6 + h) * SEQ + kc * 32)) * 96 + e); float t[8]; unpack8(w, t);
#pragma unroll
            for (int i = 0; i < 8; ++i) Ks[e + i] = t[i]; }
        if (tid < 256) { const int e = tid * 8; const v4u w = *(const v4u*)(Vc + ((size_t)((b * 6 + h) * SEQ + kc * 32)) * 64 + e); float t[8]; unpack8(w, t);
#pragma unroll
            for (int i = 0; i < 8; ++i) Vs[e + i] = t[i]; }
        __syncthreads();
        for (int j = 0; j < 32; ++j) {
            float s = nb2;
            const LAS f32x4* kp = (const LAS f32x4*)(Ks + j * 96);
#pragma unroll
            for (int i = 0; i < 24; ++i) { const f32x4 kv = kp[i]; s += q[4 * i] * kv.x + q[4 * i + 1] * kv.y + q[4 * i + 2] * kv.z + q[4 * i + 3] * kv.w; }
            const float p = __builtin_amdgcn_exp2f(s);
            lsum += p;
            const LAS f32x4* vp = (const LAS f32x4*)(Vs + j * 64);
#pragma unroll
            for (int i = 0; i < 16; ++i) { const f32x4 vv = vp[i]; o[4 * i] += p * vv.x; o[4 * i + 1] += p * vv.y; o[4 * i + 2] += p * vv.z; o[4 * i + 3] += p * vv.w; }
        }
    }
    const float inv = 1.0f / lsum;
    bf16* dst = (bf16*)(ws + WS_MIX) + ((size_t)(b * SEQ + qi)) * DM + 640 + h * 64;
#pragma unroll
    for (int i = 0; i < 8; ++i) { v4u w; w.x = pk2(o[8 * i] * inv, o[8 * i + 1] * inv); w.y = pk2(o[8 * i + 2] * inv, o[8 * i + 3] * inv); w.z = pk2(o[8 * i + 4] * inv, o[8 * i + 5] * inv); w.w = pk2(o[8 * i + 6] * inv, o[8 * i + 7] * inv); *(v4u*)(dst + 8 * i) = w; }
    __syncthreads();
}

__device__ __forceinline__ void dil_unit_v1(const unsigned char* ws, const int tid, int l, int u) {
    const int bh = u >> 2, b = bh / 6, h = bh % 6, qi = (u & 3) * 512 + tid;
    const bf16* Ql = (const bf16*)(ws + WS_QL); const bf16* Kl = (const bf16*)(ws + WS_KL) + (size_t)((b * 6 + h) * SEQ) * 64; const bf16* Vl = (const bf16*)(ws + WS_VL) + (size_t)((b * 6 + h) * SEQ) * 64;
    const float* tab = (const float*)(ws + WS_TAB) + TAB_BL + (l * 6 + h) * 4096;
    float q[64], o[64]; float lsum = 0.f;
    { const v4u* qp = (const v4u*)(Ql + ((size_t)((b * 6 + h) * SEQ + qi)) * 64);
#pragma unroll
      for (int i = 0; i < 8; ++i) unpack8(qp[i], q + 8 * i); }
#pragma unroll
    for (int d = 0; d < 64; ++d) o[d] = 0.f;
    for (int br = 0; br < 3; ++br) {
        const int dil = br == 0 ? 1 : (br == 1 ? 4 : 16);
        for (int j = -64; j <= 64; ++j) {
            const int k = qi + dil * j; const bool valid = (k >= 0) && (k < SEQ); const int kk = valid ? k : qi;
            float s = tab[kk - qi + 2048];
            const v4u* kp = (const v4u*)(Kl + (size_t)kk * 64);
#pragma unroll
            for (int i = 0; i < 8; ++i) { float t[8]; unpack8(kp[i], t);
#pragma unroll
                for (int e = 0; e < 8; ++e) s += q[8 * i + e] * t[e]; }
            const float p = valid ? __builtin_amdgcn_exp2f(s) : 0.f;
            lsum += p;
            const v4u* vp = (const v4u*)(Vl + (size_t)kk * 64);
#pragma unroll
            for (int i = 0; i < 8; ++i) { float t[8]; unpack8(vp[i], t);
#pragma unroll
                for (int e = 0; e < 8; ++e) o[8 * i + e] += p * t[e]; }
        }
    }
    const float inv = 1.0f / lsum;
    bf16* dst = (bf16*)(ws + WS_MIX) + ((size_t)(b * SEQ + qi)) * DM + 256 + h * 64;
#pragma unroll
    for (int i = 0; i < 8; ++i) { v4u w; w.x = pk2(o[8 * i] * inv, o[8 * i + 1] * inv); w.y = pk2(o[8 * i + 2] * inv, o[8 * i + 3] * inv); w.z = pk2(o[8 * i + 4] * inv, o[8 * i + 5] * inv); w.w = pk2(o[8 * i + 6] * inv, o[8 * i + 7] * inv); *(v4u*)(dst + 8 * i) = w; }
}

namespace att {
typedef short bf16x8 __attribute__((ext_vector_type(8)));
typedef short s16x4 __attribute__((ext_vector_type(4)));
typedef short v4i16_t __attribute__((ext_vector_type(4)));
typedef float f32x16 __attribute__((ext_vector_type(16)));
typedef unsigned u32x4 __attribute__((ext_vector_type(4)));
typedef __attribute__((address_space(3))) const char* lds_cptr;
typedef __attribute__((address_space(3))) char* lds_ptr;
typedef float f32x2_t __attribute__((ext_vector_type(2))); typedef __bf16 bf16x2_t __attribute__((ext_vector_type(2)));
__device__ __forceinline__ int crow(int r, int hi) { return (r & 3) + 8 * (r >> 2) + 4 * hi; }
__device__ __forceinline__ void glds16(const void* gsrc, unsigned lds_dst) { unsigned keep;
    asm volatile("s_mov_b32 %0, m0\n\ts_mov_b32 m0, %2\n\ts_nop 0\n\tglobal_load_lds_dwordx4 %1, off\n\ts_mov_b32 m0, %0" : "=&s"(keep) : "v"(gsrc), "s"(lds_dst) : "memory"); }
__device__ __forceinline__ unsigned cvtpk_s(float lo, float hi) { f32x2_t v = {lo, hi}; bf16x2_t b = __builtin_convertvector(v, bf16x2_t); return __builtin_bit_cast(unsigned, b); }
__device__ __forceinline__ s16x4 vtr(lds_cptr p) { return __builtin_bit_cast(s16x4, __builtin_amdgcn_ds_read_tr16_b64_v4i16((__attribute__((address_space(3))) v4i16_t*)p)); }
#define ATT_WAIT_BAR(N) asm volatile("s_waitcnt vmcnt(" #N ") lgkmcnt(0)\n\ts_barrier" ::: "memory")
#define ATT_BAR() asm volatile("s_waitcnt lgkmcnt(0)\n\ts_barrier" ::: "memory")

__device__ __forceinline__ void pack_p(const f32x16& p0, const f32x16& p1, bf16x8 (&pa)[4]) {
    u32x4 w;
    w = (u32x4){cvtpk_s(p0[0], p0[1]), cvtpk_s(p0[2], p0[3]), cvtpk_s(p0[4], p0[5]), cvtpk_s(p0[6], p0[7])}; pa[0] = __builtin_bit_cast(bf16x8, w);
    w = (u32x4){cvtpk_s(p0[8], p0[9]), cvtpk_s(p0[10], p0[11]), cvtpk_s(p0[12], p0[13]), cvtpk_s(p0[14], p0[15])}; pa[1] = __builtin_bit_cast(bf16x8, w);
    w = (u32x4){cvtpk_s(p1[0], p1[1]), cvtpk_s(p1[2], p1[3]), cvtpk_s(p1[4], p1[5]), cvtpk_s(p1[6], p1[7])}; pa[2] = __builtin_bit_cast(bf16x8, w);
    w = (u32x4){cvtpk_s(p1[8], p1[9]), cvtpk_s(p1[10], p1[11]), cvtpk_s(p1[12], p1[13]), cvtpk_s(p1[14], p1[15])}; pa[3] = __builtin_bit_cast(bf16x8, w);
}
__device__ __forceinline__ void pv64(f32x16& o0, f32x16& o1, lds_cptr vp, const bf16x8 (&pa)[4]) {
#pragma unroll
    for (int ks = 0; ks < 4; ++ks) {
        const s16x4 a = vtr(vp + ks * 1024), b = vtr(vp + ks * 1024 + 512);
        const bf16x8 v = {a[0], a[1], a[2], a[3], b[0], b[1], b[2], b[3]};
        o0 = __builtin_amdgcn_mfma_f32_32x32x16_bf16(pa[ks], v, o0, 0, 0, 0);
    }
#pragma unroll
    for (int ks = 0; ks < 4; ++ks) {
        const s16x4 a = vtr(vp + 4096 + ks * 1024), b = vtr(vp + 4096 + ks * 1024 + 512);
        const bf16x8 v = {a[0], a[1], a[2], a[3], b[0], b[1], b[2], b[3]};
        o1 = __builtin_amdgcn_mfma_f32_32x32x16_bf16(pa[ks], v, o1, 0, 0, 0);
    }
}
__device__ __forceinline__ void pv32(f32x16& o0, f32x16& o1, lds_cptr vp, const bf16x8& pa0, const bf16x8& pa1) {
#pragma unroll
    for (int d0 = 0; d0 < 2; ++d0) {
        const s16x4 a = vtr(vp + d0 * 4096), b = vtr(vp + d0 * 4096 + 512), c = vtr(vp + d0 * 4096 + 1024), d = vtr(vp + d0 * 4096 + 1536);
        const bf16x8 v0 = {a[0], a[1], a[2], a[3], b[0], b[1], b[2], b[3]}, v1 = {c[0], c[1], c[2], c[3], d[0], d[1], d[2], d[3]};
        if (d0 == 0) { o0 = __builtin_amdgcn_mfma_f32_32x32x16_bf16(pa0, v0, o0, 0, 0, 0); o0 = __builtin_amdgcn_mfma_f32_32x32x16_bf16(pa1, v1, o0, 0, 0, 0); }
        else { o1 = __builtin_amdgcn_mfma_f32_32x32x16_bf16(pa0, v0, o1, 0, 0, 0); o1 = __builtin_amdgcn_mfma_f32_32x32x16_bf16(pa1, v1, o1, 0, 0, 0); }
    }
}
__device__ __forceinline__ float exp_sum1(f32x16& p) {
    float s0 = 0.f, s1 = 0.f;
#pragma unroll
    for (int r = 0; r < 16; r += 2) { p[r] = __builtin_amdgcn_exp2f(p[r]); p[r + 1] = __builtin_amdgcn_exp2f(p[r + 1]); s0 += p[r]; s1 += p[r + 1]; }
    return s0 + s1;
}
__device__ __forceinline__ void pack_p1(const f32x16& p, bf16x8& pa0, bf16x8& pa1) {
    u32x4 w;
    w = (u32x4){cvtpk_s(p[0], p[1]), cvtpk_s(p[2], p[3]), cvtpk_s(p[4], p[5]), cvtpk_s(p[6], p[7])}; pa0 = __builtin_bit_cast(bf16x8, w);
    w = (u32x4){cvtpk_s(p[8], p[9]), cvtpk_s(p[10], p[11]), cvtpk_s(p[12], p[13]), cvtpk_s(p[14], p[15])}; pa1 = __builtin_bit_cast(bf16x8, w);
}
__device__ __forceinline__ float exp_sum(f32x16& p0, f32x16& p1) {
    float s0 = 0.f, s1 = 0.f;
#pragma unroll
    for (int r = 0; r < 16; ++r) { p0[r] = __builtin_amdgcn_exp2f(p0[r]); p1[r] = __builtin_amdgcn_exp2f(p1[r]); s0 += p0[r]; s1 += p1[r]; }
    return s0 + s1;
}
__device__ __forceinline__ float half_swap_sum(float v) {
    return sum_x32(v);
}

constexpr int DN_RING = 40960, DN_BUF = 20480, DN_TAB = 81920, DN_WSF = 98304, DN_OST = 100352;
constexpr int ML_RING = 61440, ML_WSF = 122880, ML_OST = 124928;

__device__ __forceinline__ void store_o64(const f32x16& o0, const f32x16& o1, const float (&sc)[16], lds_ptr stg, bf16* orow0, int pitch, int lane) {
    asm volatile("" : "+v"(lane));
    const int r32 = lane & 31, hi = lane >> 5;
    __attribute__((address_space(3))) unsigned short* s = (__attribute__((address_space(3))) unsigned short*)stg;
#pragma unroll
    for (int r = 0; r < 16; ++r) { const int orow = crow(r, hi);
        s[orow * 64 + r32] = (unsigned short)f2bf(o0[r] * sc[r]); s[orow * 64 + 32 + r32] = (unsigned short)f2bf(o1[r] * sc[r]); }
    asm volatile("s_waitcnt lgkmcnt(0)" ::: "memory");
#pragma unroll
    for (int i = 0; i < 4; ++i) { const int row = i * 8 + (lane >> 3), ch = lane & 7;
        const u32x4 v = *(const __attribute__((address_space(3))) u32x4*)(stg + row * 128 + ch * 16); *(u32x4*)(orow0 + (size_t)row * pitch + ch * 8) = v; }
}

__device__ __forceinline__ void mla_unit(const unsigned char* ws, const int tid, int l, int u, char* shm) {
    const int lane = tid & 63, r32 = lane & 31, hi = lane >> 5, wid = __builtin_amdgcn_readfirstlane(tid >> 6), w4 = wid & 3, g = wid >> 2;
    const int bh = u >> 4, q0 = (u & 15) * 128 + w4 * 32;
    const bf16* Qb = (const bf16*)(ws + WS_QC) + ((size_t)bh * SEQ + q0) * 96;
    const bf16* Kb = (const bf16*)(ws + WS_KC) + ((size_t)bh * SEQ + g * 1024) * 96;
    const bf16* Vb = (const bf16*)(ws + WS_VC) + ((size_t)bh * SEQ + g * 1024) * 64;
    const float nb2 = ((const float*)(ws + WS_TAB))[TAB_SC + l * 8 + 2];
    const unsigned lds0 = (unsigned)(uintptr_t)shm; const lds_cptr shm3 = (lds_cptr)shm;
    const unsigned ring = lds0 + g * ML_RING;
    int koffs[3];
#pragma unroll
    for (int i = 0; i < 3; ++i) { const int idx = 64 * (w4 + 4 * i) + lane, row = idx / 12, slot = idx - 12 * row; koffs[i] = row * 96 + ((slot & ~3) | ((slot & 3) ^ ((row >> 2) & 3))) * 8; }
    const bf16* vsrc = Vb + (size_t)(16 * w4 + (lane >> 2)) * 64 + (lane & 3) * 8;
#define MLA_DMA_K(t, buf) do { const unsigned d_ = (unsigned)__builtin_amdgcn_readfirstlane(ring + (buf) * DN_BUF + w4 * 1024); \
        const bf16* kt_ = Kb + (size_t)(t) * 64 * 96; glds16(kt_ + koffs[0], d_); glds16(kt_ + koffs[1], d_ + 4096); glds16(kt_ + koffs[2], d_ + 8192); } while (0)
#define MLA_DMA_V(t, buf) do { const unsigned d_ = (unsigned)__builtin_amdgcn_readfirstlane(ring + (buf) * DN_BUF + w4 * 1024); \
        glds16(vsrc + (size_t)(t) * 64 * 64, d_ + 12288); glds16(vsrc + (size_t)(t) * 64 * 64 + 32, d_ + 12288 + 4096); } while (0)
    if (g == 0) { MLA_DMA_K(0, 0); MLA_DMA_V(0, 0); MLA_DMA_K(1, 1); MLA_DMA_V(1, 1); } else { MLA_DMA_K(0, 0); MLA_DMA_K(1, 1); MLA_DMA_V(0, 0); }
    bf16x8 qr[6];
#pragma unroll
    for (int d0 = 0; d0 < 6; ++d0) qr[d0] = *(const bf16x8*)(Qb + (size_t)r32 * 96 + d0 * 16 + hi * 8);
    asm volatile("" : "+v"(qr[0]), "+v"(qr[1]), "+v"(qr[2]), "+v"(qr[3]), "+v"(qr[4]), "+v"(qr[5]));
    f32x16 o0 = {}, o1 = {}; float lsum = 0.f;
    const int kx = (r32 >> 2) & 3;
    const lds_cptr kpe0 = shm3 + g * ML_RING + r32 * 192 + ((hi ^ kx) << 4), kpe1 = shm3 + g * ML_RING + r32 * 192 + (((2 + hi) ^ kx) << 4);
    const lds_cptr vp0 = shm3 + g * ML_RING + 12288 + ((lane >> 4) & 1) * 32 + (lane & 3) * 8 + (4 * hi + ((lane & 15) >> 2)) * 64;
#define MLA_QK(P0, P1, buf) do { \
        _Pragma("unroll") for (int r = 0; r < 16; ++r) { P0[r] = nb2; P1[r] = nb2; } \
        _Pragma("unroll") for (int d0 = 0; d0 < 6; ++d0) { const lds_cptr kp = ((d0 & 1) ? kpe1 : kpe0) + (buf) * DN_BUF + (d0 >> 1) * 64; \
            const bf16x8 a0 = *(const __attribute__((address_space(3))) bf16x8*)(kp), a1 = *(const __attribute__((address_space(3))) bf16x8*)(kp + 6144); \
            P0 = __builtin_amdgcn_mfma_f32_32x32x16_bf16(a0, qr[d0], P0, 0, 0, 0); P1 = __builtin_amdgcn_mfma_f32_32x32x16_bf16(a1, qr[d0], P1, 0, 0, 0); } } while (0)
#define MLA_SMPV(P0, P1, buf) do { lsum += exp_sum(P0, P1); bf16x8 pa[4]; pack_p(P0, P1, pa); pv64(o0, o1, vp0 + (buf) * DN_BUF, pa); } while (0)
    if (g == 0) {
        int b0 = 0, b2 = 2;
        for (int t = 0; t < 16; ++t) {
            ATT_WAIT_BAR(5);
            { const int tn = t + 2 < 16 ? t + 2 : 15; MLA_DMA_K(tn, b2); MLA_DMA_V(tn, b2); }
            f32x16 p0, p1;
            MLA_QK(p0, p1, b0);
            MLA_SMPV(p0, p1, b0);
            b0 = b0 == 2 ? 0 : b0 + 1; b2 = b2 == 2 ? 0 : b2 + 1;
        }
        ATT_WAIT_BAR(0);
    } else {
        f32x16 p0, p1;
        ATT_WAIT_BAR(5);
        MLA_DMA_K(2, 2); MLA_DMA_V(1, 1);
        MLA_QK(p0, p1, 0);
        int bk = 1, bk2 = 0, bv = 0, bv1 = 2;
        for (int t = 1; t < 16; ++t) {
            ATT_WAIT_BAR(5);
            { const int kn = t + 2 < 16 ? t + 2 : 15, vn = t + 1 < 16 ? t + 1 : 15; MLA_DMA_K(kn, bk2); MLA_DMA_V(vn, bv1); }
            MLA_SMPV(p0, p1, bv);
            MLA_QK(p0, p1, bk);
            bk = bk == 2 ? 0 : bk + 1; bk2 = bk2 == 2 ? 0 : bk2 + 1; bv = bv == 2 ? 0 : bv + 1; bv1 = bv1 == 2 ? 0 : bv1 + 1;
        }
        ATT_WAIT_BAR(0);
        MLA_SMPV(p0, p1, bv);
    }
    ATT_WAIT_BAR(0);
#undef MLA_QK
#undef MLA_SMPV
#undef MLA_DMA_K
#undef MLA_DMA_V
#define MLA_DMA(t, buf) do {} while (0)
#undef MLA_DMA
    int lane_t = lane; asm volatile("" : "+v"(lane_t));
    const int r32t = lane_t & 31, hit = lane_t >> 5;
    __attribute__((address_space(3))) float* Cs = (__attribute__((address_space(3))) float*)shm3;
    if (g == 1) {
#pragma unroll
        for (int r = 0; r < 16; ++r) { Cs[(w4 * 33 + r) * 64 + lane_t] = o0[r]; Cs[(w4 * 33 + 16 + r) * 64 + lane_t] = o1[r]; }
        Cs[(w4 * 33 + 32) * 64 + lane_t] = lsum;
    }
    ATT_BAR();
    if (g == 0) {
#pragma unroll
        for (int r = 0; r < 16; ++r) { o0[r] += Cs[(w4 * 33 + r) * 64 + lane_t]; o1[r] += Cs[(w4 * 33 + 16 + r) * 64 + lane_t]; }
        lsum += Cs[(w4 * 33 + 32) * 64 + lane_t];
        lsum = half_swap_sum(lsum);
        __attribute__((address_space(3))) float* wsf = (__attribute__((address_space(3))) float*)(shm3 + ML_WSF) + wid * 64;
        if (hit == 0) wsf[r32t] = __builtin_amdgcn_rcpf(lsum);
        asm volatile("s_waitcnt lgkmcnt(0)" ::: "memory");
        float sc[16];
#pragma unroll
        for (int r = 0; r < 16; ++r) sc[r] = wsf[crow(r, hit)];
        const int b = bh / 6, h = bh - b * 6;
        store_o64(o0, o1, sc, (lds_ptr)(shm3 + ML_OST + w4 * 4096), (bf16*)(ws + WS_MIX) + ((size_t)(b * SEQ + q0)) * DM + 640 + h * 64, DM, lane_t);
    }
    ATT_BAR();
}

__device__ __forceinline__ void diff_unit(const unsigned char* ws, const float* sub, const int tid, int l, int u, char* shm) {
    const int lane = tid & 63, r32 = lane & 31, hi = lane >> 5, wid = __builtin_amdgcn_readfirstlane(tid >> 6), w4 = wid & 3, g = wid >> 2;
    const int bh = u >> 4, q0 = (u & 15) * 128 + w4 * 32, b = bh >> 2, h = bh & 3;
    const bf16* Q0 = (const bf16*)(ws + WS_QD) + ((size_t)(bh * 2) * SEQ + q0) * 32;
    const bf16* K0 = (const bf16*)(ws + WS_KD) + ((size_t)(bh * 2) * SEQ + g * 1024) * 32;
    const bf16* Vb = (const bf16*)(ws + WS_VD) + ((size_t)bh * SEQ + g * 1024) * 64;
    const float* tabg = (const float*)(ws + WS_TAB) + TAB_BD + (l * 4 + h) * 4096;
    const unsigned lds0 = (unsigned)(uintptr_t)shm; const lds_cptr shm3 = (lds_cptr)shm;
    const unsigned ring = lds0 + g * DN_RING;
    const bf16* ksrc = K0 + (size_t)(16 * w4 + (lane >> 2)) * 32 + (((lane & 3) ^ ((lane >> 4) & 3)) * 8);
    const bf16* vsrc = Vb + (size_t)(16 * w4 + (lane >> 2)) * 64 + (lane & 3) * 8;
#define DIFF_KOFF(t) (g == 0 ? ((t) & 1) * DN_BUF : ((t) & 1) * 8192)
#define DIFF_VOFF(t) (g == 0 ? ((t) & 1) * DN_BUF + 8192 : 16384 + ((t) % 3) * 8192)
#define DIFF_DMA_K(t) do { const unsigned d_ = (unsigned)__builtin_amdgcn_readfirstlane(ring + DIFF_KOFF(t) + w4 * 1024); \
        glds16(ksrc + (size_t)(t) * 64 * 32, d_); glds16(ksrc + (size_t)SEQ * 32 + (size_t)(t) * 64 * 32, d_ + 4096); } while (0)
#define DIFF_DMA_V(t) do { const unsigned d_ = (unsigned)__builtin_amdgcn_readfirstlane(ring + DIFF_VOFF(t) + w4 * 1024); \
        glds16(vsrc + (size_t)(t) * 64 * 64, d_); glds16(vsrc + (size_t)(t) * 64 * 64 + 32, d_ + 4096); } while (0)
    DIFF_DMA_K(0); DIFF_DMA_V(0);
    { __attribute__((address_space(3))) float* tl = (__attribute__((address_space(3))) float*)(shm3 + DN_TAB);
#pragma unroll
      for (int i = 0; i < 2; ++i) { const f32x4 v = *(const f32x4*)(tabg + (i * 512 + tid) * 4); *(__attribute__((address_space(3))) f32x4*)(tl + (i * 512 + tid) * 4) = v; } }
    bf16x8 qr[2][2];
#pragma unroll
    for (int c = 0; c < 2; ++c)
#pragma unroll
        for (int d0 = 0; d0 < 2; ++d0) qr[c][d0] = *(const bf16x8*)(Q0 + (size_t)c * SEQ * 32 + (size_t)r32 * 32 + d0 * 16 + hi * 8);
    asm volatile("" : "+v"(qr[0][0]), "+v"(qr[0][1]), "+v"(qr[1][0]), "+v"(qr[1][1]));
    f32x16 oa0 = {}, oa1 = {}, ob0 = {}, ob1 = {}; float lsa = 0.f, lsb = 0.f;
    const int kx = (r32 >> 2) & 3;
    const lds_cptr kpe0 = shm3 + g * DN_RING + r32 * 64 + ((hi ^ kx) << 4), kpe1 = shm3 + g * DN_RING + r32 * 64 + (((2 + hi) ^ kx) << 4);
    const lds_cptr vp0 = shm3 + g * DN_RING + ((lane >> 4) & 1) * 32 + (lane & 3) * 8 + (4 * hi + ((lane & 15) >> 2)) * 64;
    const __attribute__((address_space(3))) float* tb0 = (const __attribute__((address_space(3))) float*)(shm3 + DN_TAB) + (2048 + g * 1024 - q0 + 4 * hi - r32);
#define DIFF_QK(S0, S1, t, blk) do { const __attribute__((address_space(3))) float* tb = tb0 + (t) * 64 + (blk) * 32; int koff_ = __builtin_amdgcn_readfirstlane(DIFF_KOFF(t) + (blk) * 2048); asm volatile("" : "+s"(koff_)); \
        _Pragma("unroll") for (int r = 0; r < 16; ++r) { S0[r] = tb[(r & 3) + 8 * (r >> 2)]; S1[r] = S0[r]; } \
        _Pragma("unroll") for (int d0 = 0; d0 < 2; ++d0) { \
            const lds_cptr kp = (d0 ? kpe1 : kpe0) + koff_; const bf16x8 a0 = *(const __attribute__((address_space(3))) bf16x8*)(kp), a1 = *(const __attribute__((address_space(3))) bf16x8*)(kp + 4096); \
            S0 = __builtin_amdgcn_mfma_f32_32x32x16_bf16(a0, qr[0][d0], S0, 0, 0, 0); S1 = __builtin_amdgcn_mfma_f32_32x32x16_bf16(a1, qr[1][d0], S1, 0, 0, 0); } __builtin_amdgcn_sched_barrier(0); } while (0)
#define DIFF_SMPV(S0, S1, t, blk) do { int voff_ = __builtin_amdgcn_readfirstlane(DIFF_VOFF(t) + (blk) * 2048); asm volatile("" : "+s"(voff_)); const lds_cptr vpb = vp0 + voff_; bf16x8 pa0, pa1; \
        lsa += exp_sum1(S0); pack_p1(S0, pa0, pa1); pv32(oa0, oa1, vpb, pa0, pa1); \
        __builtin_amdgcn_sched_barrier(0); lsb += exp_sum1(S1); pack_p1(S1, pa0, pa1); pv32(ob0, ob1, vpb, pa0, pa1); __builtin_amdgcn_sched_barrier(0); } while (0)
    if (g == 0) {
        for (int t = 0; t < 16; ++t) {
            ATT_WAIT_BAR(0);
            if (t + 1 < 16) { DIFF_DMA_K(t + 1); DIFF_DMA_V(t + 1); }
            f32x16 s0, s1;
            DIFF_QK(s0, s1, t, 0); DIFF_SMPV(s0, s1, t, 0);
            DIFF_QK(s0, s1, t, 1); DIFF_SMPV(s0, s1, t, 1);
        }
        ATT_WAIT_BAR(0);
    } else {
        f32x16 s0, s1, u0, u1;
        ATT_WAIT_BAR(0);
        DIFF_DMA_K(1); DIFF_DMA_V(1);
        DIFF_QK(s0, s1, 0, 0); DIFF_SMPV(s0, s1, 0, 0); DIFF_QK(u0, u1, 0, 1);
        for (int t = 1; t < 16; ++t) {
            ATT_WAIT_BAR(0);
            if (t + 1 < 16) { DIFF_DMA_K(t + 1); DIFF_DMA_V(t + 1); }
            DIFF_SMPV(u0, u1, t - 1, 1); DIFF_QK(s0, s1, t, 0);
            DIFF_SMPV(s0, s1, t, 0); DIFF_QK(u0, u1, t, 1);
        }
        ATT_WAIT_BAR(0);
        DIFF_SMPV(u0, u1, 15, 1);
    }
    ATT_WAIT_BAR(0);
#undef DIFF_QK
#undef DIFF_SMPV
#undef DIFF_DMA_K
#undef DIFF_DMA_V
#undef DIFF_KOFF
#undef DIFF_VOFF
#define DIFF_DMA(t, buf) do {} while (0)
#undef DIFF_DMA
    int lane_t = lane; asm volatile("" : "+v"(lane_t));
    const int r32t = lane_t & 31, hit = lane_t >> 5;
    __attribute__((address_space(3))) float* Cs = (__attribute__((address_space(3))) float*)shm3 + w4 * 66 * 64;
    if (g == 1) {
#pragma unroll
        for (int r = 0; r < 16; ++r) { Cs[r * 64 + lane_t] = oa0[r]; Cs[(16 + r) * 64 + lane_t] = oa1[r]; Cs[(32 + r) * 64 + lane_t] = ob0[r]; Cs[(48 + r) * 64 + lane_t] = ob1[r]; }
        Cs[64 * 64 + lane_t] = lsa; Cs[65 * 64 + lane_t] = lsb;
    }
    ATT_BAR();
    if (g == 0) {
#pragma unroll
        for (int r = 0; r < 16; ++r) { oa0[r] += Cs[r * 64 + lane_t]; oa1[r] += Cs[(16 + r) * 64 + lane_t]; ob0[r] += Cs[(32 + r) * 64 + lane_t]; ob1[r] += Cs[(48 + r) * 64 + lane_t]; }
        lsa += Cs[64 * 64 + lane_t]; lsb += Cs[65 * 64 + lane_t];
        lsa = half_swap_sum(lsa); lsb = half_swap_sum(lsb);
        const float* sc = (const float*)(ws + WS_TAB) + TAB_SC + l * 8; const float lam = sc[0], post = sc[1];
        __attribute__((address_space(3))) float* wsf = (__attribute__((address_space(3))) float*)(shm3 + DN_WSF) + wid * 64;
        if (hit == 0) { wsf[r32t] = __builtin_amdgcn_rcpf(lsa); wsf[32 + r32t] = lam * __builtin_amdgcn_rcpf(lsb); }
        asm volatile("s_waitcnt lgkmcnt(0)" ::: "memory");
        __attribute__((address_space(3))) float* As = Cs;
#pragma unroll
        for (int r = 0; r < 16; ++r) { const int q = crow(r, hit); const float s0 = wsf[q], s1 = wsf[32 + q];
            As[q * 65 + r32t] = oa0[r] * s0 - ob0[r] * s1; As[q * 65 + 32 + r32t] = oa1[r] * s0 - ob1[r] * s1; }
        asm volatile("s_waitcnt lgkmcnt(0)" ::: "memory");
        const int row = lane_t >> 1, hf = lane_t & 1;
        float v[32]; float ss = 0.f;
#pragma unroll
        for (int i = 0; i < 32; ++i) { v[i] = As[row * 65 + hf * 32 + i]; ss += v[i] * v[i]; }
        ss += swz<1>(ss);
        const float rn = __builtin_amdgcn_rsqf(ss * (1.0f / 64.0f) + EPS) * post;
        bf16* dst = (bf16*)(ws + WS_MIX) + ((size_t)(b * SEQ + q0 + row)) * DM + h * 64 + hf * 32;
#pragma unroll
        for (int i = 0; i < 4; ++i) { u32x4 w;
            w.x = cvtpk_s(v[8 * i] * rn * sub[hf * 32 + 8 * i], v[8 * i + 1] * rn * sub[hf * 32 + 8 * i + 1]); w.y = cvtpk_s(v[8 * i + 2] * rn * sub[hf * 32 + 8 * i + 2], v[8 * i + 3] * rn * sub[hf * 32 + 8 * i + 3]);
            w.z = cvtpk_s(v[8 * i + 4] * rn * sub[hf * 32 + 8 * i + 4], v[8 * i + 5] * rn * sub[hf * 32 + 8 * i + 5]); w.w = cvtpk_s(v[8 * i + 6] * rn * sub[hf * 32 + 8 * i + 6], v[8 * i + 7] * rn * sub[hf * 32 + 8 * i + 7]);
            *(u32x4*)(dst + 8 * i) = w; }
    }
    ATT_BAR();
}

__device__ __forceinline__ void dil_prefetch(const unsigned char* ws, const int tid, int bh, int br, int chunk, unsigned lds_dummy) {
    const int wid = __builtin_amdgcn_readfirstlane(tid >> 6);
    if (wid < 6) {
        const int s = wid, within = tid & 63, dsh = 2 * br, L = SEQ >> dsh;
        int res, k0;
        if (br == 2) { res = 2 * chunk + ((s >> 1) & 1); k0 = 64 * (s & 1); }
        else { res = br == 1 ? (chunk >> 1) : 0; k0 = (br == 1 ? 256 * (chunk & 1) : 256 * chunk) - 64 + 64 * s; }
        int ki = k0 + within; ki = ki < 0 ? 0 : (ki > L - 1 ? L - 1 : ki);
        const size_t off = ((size_t)bh * SEQ + res + ((size_t)ki << dsh)) * 64;
        const unsigned d_ = (unsigned)__builtin_amdgcn_readfirstlane(lds_dummy + wid * 1024);
        glds16((const bf16*)(ws + WS_KL) + off, d_); glds16((const bf16*)(ws + WS_VL) + off, d_);
    }
}

constexpr int DL_SLOT = 16384, DL_TAB = 98304, DL_WSF = 114688;
template <int DIL> __device__ __forceinline__ void dil_unit(const unsigned char* ws, unsigned char* wsw, const int tid, int l, int bh, int chunk, int nud, char* shm) {
    constexpr int L = SEQ / DIL, BR = DIL == 1 ? 0 : (DIL == 4 ? 1 : 2), NSLOT = DIL == 16 ? 4 : 6, NTW = DIL == 16 ? 2 : 3;
    const int lane = tid & 63, r32 = lane & 31, hi = lane >> 5, wid = __builtin_amdgcn_readfirstlane(tid >> 6);
    const int h = bh % 6, b = bh / 6;
    const bf16* Qb = (const bf16*)(ws + WS_QL) + (size_t)bh * SEQ * 64; const bf16* Kb = (const bf16*)(ws + WS_KL) + (size_t)bh * SEQ * 64; const bf16* Vb = (const bf16*)(ws + WS_VL) + (size_t)bh * SEQ * 64;
    const float* tabg = (const float*)(ws + WS_TAB) + TAB_BL + (l * 6 + h) * 4096;
    const unsigned lds0 = (unsigned)(uintptr_t)shm; const lds_cptr shm3 = (lds_cptr)shm;
    int res_w, qidx0, tf;
    if (DIL == 16) { res_w = 2 * chunk + (wid >> 2); qidx0 = 32 * (wid & 3); tf = 2 * (wid >> 2); }
    else if (DIL == 4) { res_w = chunk >> 1; qidx0 = 256 * (chunk & 1) + 32 * wid; tf = wid >> 1; }
    else { res_w = 0; qidx0 = 256 * chunk + 32 * wid; tf = wid >> 1; }
    const int t0idx = DIL == 16 ? 0 : (DIL == 4 ? 256 * (chunk & 1) - 64 : 256 * chunk - 64);
#pragma unroll
    for (int s = 0; s < NSLOT; ++s) {
        const int res_s = DIL == 16 ? 2 * chunk + (s >> 1) : res_w, k0 = DIL == 16 ? 64 * (s & 1) : t0idx + 64 * s;
        int ki = k0 + 8 * wid + (lane >> 3); ki = ki < 0 ? 0 : (ki > L - 1 ? L - 1 : ki);
        int vi = k0 + 16 * (wid & 3) + (lane >> 2); vi = vi < 0 ? 0 : (vi > L - 1 ? L - 1 : vi);
        const unsigned d_ = (unsigned)__builtin_amdgcn_readfirstlane(lds0 + s * DL_SLOT + wid * 1024);
        glds16(Kb + (size_t)(res_s + DIL * ki) * 64 + (((lane & 7) ^ (((8 * wid + (lane >> 3)) >> 1) & 7)) * 8), d_);
        glds16(Vb + (size_t)(res_s + DIL * vi) * 64 + (wid >> 2) * 32 + (lane & 3) * 8, d_ + 8192);
    }
    if (tid < 256) ((__attribute__((address_space(3))) float*)(shm3 + DL_TAB))[tid] = tabg[2048 + DIL * (tid - 128)];
    bf16x8 qr[4];
#pragma unroll
    for (int d0 = 0; d0 < 4; ++d0) qr[d0] = *(const bf16x8*)(Qb + (size_t)(res_w + DIL * (qidx0 + r32)) * 64 + d0 * 16 + hi * 8);
    ATT_WAIT_BAR(0);
    f32x16 o0 = {}, o1 = {}; float lsum = 0.f;
    const int qidx = qidx0 + r32;
#pragma unroll
    for (int tt = 0; tt < NTW; ++tt) {
        const int slot = tf + tt;
        const int k0 = DIL == 16 ? 64 * tt : t0idx + 64 * slot;
        const lds_cptr kp = shm3 + slot * DL_SLOT + r32 * 128;
        const lds_cptr vp = shm3 + slot * DL_SLOT + 8192 + ((lane >> 4) & 1) * 32 + (lane & 3) * 8 + (4 * hi + ((lane & 15) >> 2)) * 64;
        const int dbase = k0 + 4 * hi - qidx;
        int ti = 128 + dbase; ti = ti < 0 ? 0 : (ti > 255 - 59 ? 255 - 59 : ti);
        const __attribute__((address_space(3))) float* tb = (const __attribute__((address_space(3))) float*)(shm3 + DL_TAB) + ti;
        f32x16 p0, p1;
#pragma unroll
        for (int r = 0; r < 16; ++r) { p0[r] = tb[(r & 3) + 8 * (r >> 2)]; p1[r] = tb[32 + (r & 3) + 8 * (r >> 2)]; }
#pragma unroll
        for (int d0 = 0; d0 < 4; ++d0) {
            const int e_ = ((2 * d0 + hi) ^ ((r32 >> 1) & 7)) << 4;
            const bf16x8 a0 = *(const __attribute__((address_space(3))) bf16x8*)(kp + e_), a1 = *(const __attribute__((address_space(3))) bf16x8*)(kp + e_ + 4096);
            p0 = __builtin_amdgcn_mfma_f32_32x32x16_bf16(a0, qr[d0], p0, 0, 0, 0); p1 = __builtin_amdgcn_mfma_f32_32x32x16_bf16(a1, qr[d0], p1, 0, 0, 0);
        }
        float s0 = 0.f;
#pragma unroll
        for (int r = 0; r < 16; ++r) {
            const int d0_ = dbase + (r & 3) + 8 * (r >> 2), d1_ = d0_ + 32, kk0 = d0_ + qidx, kk1 = d1_ + qidx;
            const bool v0 = (d0_ >= -64) && (d0_ <= 64) && (kk0 >= 0) && (kk0 < L), v1 = (d1_ >= -64) && (d1_ <= 64) && (kk1 >= 0) && (kk1 < L);
            p0[r] = v0 ? __builtin_amdgcn_exp2f(p0[r]) : 0.f; p1[r] = v1 ? __builtin_amdgcn_exp2f(p1[r]) : 0.f; s0 += p0[r] + p1[r];
        }
        lsum += s0;
        bf16x8 pa[4]; pack_p(p0, p1, pa);
        pv64(o0, o1, vp, pa);
    }
    ATT_BAR();
    lsum = half_swap_sum(lsum);
    int lane_t = lane; asm volatile("" : "+v"(lane_t));
    const int r32t = lane_t & 31, hit = lane_t >> 5;
    __attribute__((address_space(3))) float* wsf = (__attribute__((address_space(3))) float*)(shm3 + DL_WSF) + wid * 64;
    if (hit == 0) wsf[r32t] = __builtin_amdgcn_rcpf(lsum);
    asm volatile("s_waitcnt lgkmcnt(0)" ::: "memory");
    float sc[16];
#pragma unroll
    for (int r = 0; r < 16; ++r) sc[r] = wsf[crow(r, hit)];
    bf16* DO = (bf16*)(wsw + (BR == 0 ? WS_DO0 : (BR == 1 ? WS_DO1 : WS_DO2)));
    float* DLs = (float*)(wsw + WS_DL) + (size_t)BR * MTOK * 8;
    const size_t row0 = (size_t)b * SEQ + res_w + (size_t)DIL * qidx0;
    store_o64(o0, o1, sc, (lds_ptr)(shm3 + wid * 4096), DO + row0 * 384 + h * 64, 384 * DIL, lane_t);
    if (hit == 0) DLs[(row0 + (size_t)DIL * r32t) * 8 + h] = lsum;
    ATT_BAR();
}

__device__ __forceinline__ void dil_merge(unsigned char* wsw, const int tid, int gw, int NGW) {
    const int lane = tid & 63;
    const bf16* D0 = (const bf16*)(wsw + WS_DO0); const bf16* D1 = (const bf16*)(wsw + WS_DO1); const bf16* D2 = (const bf16*)(wsw + WS_DO2);
    const float* DLs = (const float*)(wsw + WS_DL);
    bf16* mix = (bf16*)(wsw + WS_MIX);
    for (int m = gw; m < MTOK; m += NGW) {
        if (lane < 48) {
            const int h = lane >> 3;
            const float l0 = DLs[(size_t)m * 8 + h], l1 = DLs[((size_t)MTOK + m) * 8 + h], l2 = DLs[((size_t)2 * MTOK + m) * 8 + h];
            const float inv = 1.0f / (l0 + l1 + l2), w0 = l0 * inv, w1 = l1 * inv, w2 = l2 * inv;
            const v4u a = *(const v4u*)(D0 + (size_t)m * 384 + lane * 8), bq = *(const v4u*)(D1 + (size_t)m * 384 + lane * 8), c = *(const v4u*)(D2 + (size_t)m * 384 + lane * 8);
            float x[8], y[8], z[8]; unpack8(a, x); unpack8(bq, y); unpack8(c, z);
            v4u o; o.x = pk2(w0 * x[0] + w1 * y[0] + w2 * z[0], w0 * x[1] + w1 * y[1] + w2 * z[1]); o.y = pk2(w0 * x[2] + w1 * y[2] + w2 * z[2], w0 * x[3] + w1 * y[3] + w2 * z[3]);
            o.z = pk2(w0 * x[4] + w1 * y[4] + w2 * z[4], w0 * x[5] + w1 * y[5] + w2 * z[5]); o.w = pk2(w0 * x[6] + w1 * y[6] + w2 * z[6], w0 * x[7] + w1 * y[7] + w2 * z[7]);
            *(v4u*)(mix + (size_t)m * DM + 256 + lane * 8) = o;
        }
    }
}
}

#ifndef MK_PH
#define MK_PH 255
#endif
#ifndef MK_CONV_EARLY
#define MK_CONV_EARLY 1
#endif
#ifndef MK_DUP
#define MK_DUP 0
#endif
#define REP(kind) for (int rep_ = 0; rep_ < (((MK_DUP >> (kind)) & 1) ? 2 : 1); ++rep_)
#ifndef MK_ATTN_V1
#define MK_ATTN_V1 0
#endif
#ifndef MK_SP2
#define MK_SP2 true
#endif
constexpr int NPHASE = 18;
template <int MODE>
__global__ void __launch_bounds__(512, 2) enc_fwd(Args args) {
    extern __shared__ __attribute__((aligned(16))) unsigned char lds[];
    LAS unsigned char* L = (LAS unsigned char*)lds;
    volatile LAS unsigned* MISC = (volatile LAS unsigned*)(L + MISC_OFF);
    LAS float* xs = (LAS float*)(L + XS_OFF);
    const int G = gridDim.x, bx = blockIdx.x;
    const int wave0 = __builtin_amdgcn_readfirstlane(threadIdx.x >> 6);
    const int vcu = (G % 8 == 0) ? (bx % 8) * (G / 8) + bx / 8 : bx;
    for (int u = threadIdx.x; u < (LDS_BYTES - MISC_OFF) / 4; u += 512) ((LAS unsigned*)(L + MISC_OFF))[u] = 0u;
    __syncthreads();
    { volatile LAS unsigned long long* PT = (volatile LAS unsigned long long*)(L + MISC_OFF + 128);
      if (threadIdx.x == 0) {
#pragma unroll
          for (int i = 0; i < 25; ++i) PT[i] = (unsigned long long)args.in[i];
          PT[25] = (unsigned long long)args.out; } }
    __syncthreads();
    if (MODE < 0) xcd_barrier_post((unsigned*)(args.ws + WS_CTL) + CW_BAR, MISC + 8, threadIdx.x == 0);
#define IN(k) (MODE < 0 || MODE == (k))
#define SEAM(k) do { if (MODE < 0) xcd_barrier((unsigned*)(args.ws + WS_CTL) + CW_BAR, MISC + 8, wave0 == 0 && __builtin_amdgcn_mbcnt_hi(~0u, __builtin_amdgcn_mbcnt_lo(~0u, 0u)) == 0u); } while (0)
#define INP(i) ((const float*)lds_ptr_get((volatile LAS unsigned long long*)(L + MISC_OFF + 128), (i)))
#define PHASE_ENV() int tidp; asm volatile("v_mbcnt_lo_u32_b32 %0, -1, 0\n\tv_mbcnt_hi_u32_b32 %0, -1, %0" : "=v"(tidp)); tidp |= wave0 << 6; asm volatile("" : "+v"(tidp)); int bxp = bx, Gp = G, vcup = vcu; asm volatile("" : "+s"(bxp), "+s"(Gp), "+s"(vcup)); (void)vcup; unsigned char* ws; { const unsigned long long w_ = (unsigned long long)args.ws; unsigned wl_ = (unsigned)w_, wh_ = (unsigned)(w_ >> 32); \
          asm volatile("" : "+s"(wl_), "+s"(wh_)); ws = (unsigned char*)(((unsigned long long)wh_ << 32) | wl_); } \
        const int lane = tidp & 63, wave = __builtin_amdgcn_readfirstlane(tidp >> 6), gw = vcup * 8 + wave, gtid = bxp * 512 + tidp; const int NGW = Gp * 8, NGT = Gp * 512; (void)NGW; (void)NGT; (void)lane; (void)gw; (void)gtid; \
        bf16* XB = (bf16*)(ws + WS_XB); bf16* HB = (bf16*)(ws + WS_H); float* P0 = (float*)(ws + WS_P); float* P1 = P0 + (size_t)MTOK * 16; float* P2 = P1 + (size_t)MTOK * 16; \
        const float* tab = (const float*)(ws + WS_TAB); (void)XB; (void)HB; (void)P0; (void)P1; (void)P2; (void)tab;

    REP(0) if (IN(0) && (MK_PH & 1)) { PHASE_ENV();
        prologue_misc((volatile LAS unsigned long long*)(L + MISC_OFF + 128), ws, gw, NGW, lane, gtid, NGT);
        convert_weights((volatile LAS unsigned long long*)(L + MISC_OFF + 128), ws, 0, MK_CONV_EARLY ? 21 : 255, gw, NGW, lane);
    }
    SEAM(0);
    for (int l = (MODE < 0 ? 0 : args.layer); l < (MODE < 0 ? DEPTH : args.layer + 1); ++l) {
        constexpr int p0 = 1;
        REP(1) if (IN(p0 + 0) && (MK_PH & 4)) { PHASE_ENV();
            pg8::Gemm g{XB, (const bf16*)(ws + W_GU1), MTOK, 2 * DFF, DM, DM, DM}; pg8::StaticOrder S; S.init(MTOK, 2 * DFF, Gp, bxp);
            pg8::EpiSwiGLU E{HB, P0};
            pg8::gemm_phase<pg8::EpiSwiGLU, pg8::StaticOrder, true, MK_SP2>(tidp, L, xs, g, S, E);
            if (MK_CONV_EARLY && bxp >= Gp / 2) convert_weights((volatile LAS unsigned long long*)(L + MISC_OFF + 128), ws, l, l == 0 ? 234 : 10, (bxp - Gp / 2) * 8 + wave, (Gp - Gp / 2) * 8, lane);
        }
        SEAM(p0 + 0);
        REP(2) if (IN(p0 + 1) && (MK_PH & 8)) { PHASE_ENV();
            pg8::Gemm g{HB, (const bf16*)(ws + W_D1), MTOK, DM, DFF, DFF, DFF}; pg8::StaticOrder S; S.init(MTOK, DM, Gp, bxp);
            pg8::EpiResid E{l == 0 ? INP(I_X) : (const float*)INP(25), (float*)INP(25), XB, P1, (((MK_DUP >> 2) & 1) && rep_ == 0) ? 0.0f : 0.5f};
            pg8::gemm_phase<pg8::EpiResid, pg8::StaticOrder, true, MK_SP2>(tidp, L, xs, g, S, E);
        }
        SEAM(p0 + 1);
        REP(3) if (IN(p0 + 2) && (MK_PH & 16)) { PHASE_ENV();
            pg8::Gemm g{XB, (const bf16*)(ws + W_IN), MTOK, NIN, DM, DM, DM}; pg8::StaticOrder S; S.init(MTOK, NIN, Gp, bxp);
            pg8::EpiInProj E{P1, (bf16*)(ws + WS_QD), (bf16*)(ws + WS_KD), (bf16*)(ws + WS_VD), (bf16*)(ws + WS_QL), (bf16*)(ws + WS_KL), (bf16*)(ws + WS_VL), (bf16*)(ws + WS_AQ),
                             (float*)(ws + WS_KR), (float*)(ws + WS_KRSS), INP(I_DQN) + l * 32, INP(I_DKN) + l * 32, INP(I_LQN) + l * 64, INP(I_LKN) + l * 64,
                             0.17677669529663687f * LOG2E, 0.125f * LOG2E};
            pg8::gemm_phase<pg8::EpiInProj, pg8::StaticOrder, true, MK_SP2>(tidp, L, xs, g, S, E);
            if (MK_CONV_EARLY && l + 1 < DEPTH && bxp >= Gp / 2) convert_weights((volatile LAS unsigned long long*)(L + MISC_OFF + 128), ws, l + 1, 4, (bxp - Gp / 2) * 8 + wave, (Gp - Gp / 2) * 8, lane);
        }
        SEAM(p0 + 2);
        REP(10) if (IN(p0 + 3) && (MK_PH & 32)) { PHASE_ENV();
            { int Kq = 256; asm volatile("" : "+s"(Kq)); pg8::Gemm g{(const bf16*)(ws + WS_AQ), (const bf16*)(ws + W_QU), MTOK, 768, Kq, 384, 256}; pg8::StaticOrder S; S.init(MTOK, 768, Gp, bxp);
              pg8::EpiMlaQ E{(bf16*)(ws + WS_QC), INP(I_MQNG) + l * 96, tab + TAB_COS, tab + TAB_SIN, 0.10206207261596575f * LOG2E};
              pg8::gemm_phase<pg8::EpiMlaQ, pg8::StaticOrder, true, MK_SP2>(tidp, L, xs, g, S, E); }
        }
        REP(11) if (IN(p0 + 3) && (MK_PH & 32)) { PHASE_ENV();
            { int Kq = 256; asm volatile("" : "+s"(Kq)); pg8::Gemm g{(const bf16*)(ws + WS_AQ) + 128, (const bf16*)(ws + W_KVU), MTOK, 768, Kq, 384, 256}; pg8::StaticOrder S; S.init(MTOK, 768, Gp, (bxp + 128) % Gp);
              pg8::EpiMlaKV E{(bf16*)(ws + WS_KC), (bf16*)(ws + WS_VC), INP(I_MKNG) + l * 96, (const float*)(ws + WS_KR), (const float*)(ws + WS_KRSS), tab + TAB_COS, tab + TAB_SIN};
              pg8::gemm_phase<pg8::EpiMlaKV, pg8::StaticOrder, true, MK_SP2>(tidp, L, xs, g, S, E); }
        }
#if !MK_ATTN_V1
        REP(12) if (IN(p0 + 3) && (MK_PH & 32)) { PHASE_ENV();
            for (int ud = vcup; ud < 1152; ud += Gp) {
                const int bh = ud / 24, rem = ud - bh * 24, br = rem >> 3, chunk = rem & 7;
                if (br == 0) att::dil_unit<1>(ws, ws, tidp, l, bh, chunk, ud + Gp, (char*)lds);
                else if (br == 1) att::dil_unit<4>(ws, ws, tidp, l, bh, chunk, ud + Gp, (char*)lds);
                else att::dil_unit<16>(ws, ws, tidp, l, bh, chunk, ud + Gp, (char*)lds);
            }
        }
#endif
        SEAM(p0 + 3);
#if MK_ATTN_V1
        REP(5) if (IN(p0 + 4) && (MK_PH & 64)) { PHASE_ENV();
            for (int u = bxp; u < 640; u += Gp) {
                if (u < 192) mla_unit_v1(ws, tidp, l, u, (LAS float*)L);
                else if (u < 448) diff_unit_v1(ws, INP(I_DSUB) + l * 64, tidp, l, u - 192, (LAS float*)L);
                else dil_unit_v1(ws, tidp, l, u - 448);
            }
        }
#else
        REP(13) if (IN(p0 + 4) && (MK_PH & 64)) { PHASE_ENV();
            for (int u = vcup; u < 512; u += Gp) att::diff_unit(ws, INP(I_DSUB) + l * 64, tidp, l, u, (char*)lds);
        }
        REP(14) if (IN(p0 + 4) && (MK_PH & 64)) { PHASE_ENV();
            for (int u = vcup; u < 768; u += Gp) att::mla_unit(ws, tidp, l, u, (char*)lds);
        }
        REP(15) if (IN(p0 + 4) && (MK_PH & 64)) { PHASE_ENV();
            att::dil_merge(ws, tidp, gw, NGW);
        }
#endif
        SEAM(p0 + 4);
        REP(6) if (IN(p0 + 5) && (MK_PH & 128)) { PHASE_ENV();
            pg8::Gemm g{(const bf16*)(ws + WS_MIX), (const bf16*)(ws + W_O), MTOK, DM, DM, DM, DM}; pg8::StaticOrder S; S.init(MTOK, DM, Gp, bxp);
            pg8::EpiResid E{(const float*)INP(25), (float*)INP(25), XB, P2, (((MK_DUP >> 6) & 1) && rep_ == 0) ? 0.0f : 1.0f};
            pg8::gemm_phase<pg8::EpiResid, pg8::StaticOrder, true, MK_SP2>(tidp, L, xs, g, S, E);
        }
        SEAM(p0 + 5);
        REP(7) if (IN(p0 + 6) && (MK_PH & 4)) { PHASE_ENV();
            pg8::Gemm g{XB, (const bf16*)(ws + W_GU2), MTOK, 2 * DFF, DM, DM, DM}; pg8::StaticOrder S; S.init(MTOK, 2 * DFF, Gp, bxp);
            pg8::EpiSwiGLU E{HB, P2};
            pg8::gemm_phase<pg8::EpiSwiGLU, pg8::StaticOrder, true, MK_SP2>(tidp, L, xs, g, S, E);
            if (MK_CONV_EARLY && l + 1 < DEPTH && bxp >= Gp / 2) convert_weights((volatile LAS unsigned long long*)(L + MISC_OFF + 128), ws, l + 1, 241, (bxp - Gp / 2) * 8 + wave, (Gp - Gp / 2) * 8, lane);
        }
        SEAM(p0 + 6);
        REP(8) if (IN(p0 + 7) && (MK_PH & 8)) { PHASE_ENV();
            pg8::Gemm g{HB, (const bf16*)(ws + W_D2), MTOK, DM, DFF, DFF, DFF}; pg8::StaticOrder S; S.init(MTOK, DM, Gp, bxp);
            pg8::EpiResid E{(const float*)INP(25), (float*)INP(25), l == DEPTH - 1 ? nullptr : XB, l == DEPTH - 1 ? nullptr : P0, (((MK_DUP >> 8) & 1) && rep_ == 0) ? 0.0f : 0.5f};
            pg8::gemm_phase<pg8::EpiResid, pg8::StaticOrder, true, MK_SP2>(tidp, L, xs, g, S, E);
        }
        if (l + 1 < DEPTH && !MK_CONV_EARLY) {
            SEAM(p0 + 7);
            REP(9) if (IN(p0 + 8) && (MK_PH & 2)) { PHASE_ENV(); convert_weights((volatile LAS unsigned long long*)(L + MISC_OFF + 128), ws, l + 1, 255, gw, NGW, lane); }
            SEAM(p0 + 8);
        }
        if (l + 1 < DEPTH && MK_CONV_EARLY) SEAM(p0 + 7);
    }
#undef IN
#undef SEAM
#undef PHASE_ENV
}

extern "C" void kernel_launch(void* const* d_in, const int* in_sizes, int n_in, void* d_out, int out_size, void* d_ws, size_t ws_size, hipStream_t stream) {
    static int grid = 0;
    if (grid == 0) {
        if (n_in != 25 || out_size != MTOK * DM || ws_size < WS_TOTAL) { fprintf(stderr, "kernel_launch: unexpected shapes (n_in %d out %d ws %zu)\n", n_in, out_size, ws_size); grid = -1; return; }
        int dev = 0, cus = 0, per_cu = 0;
        if (hipGetDevice(&dev) != hipSuccess || hipDeviceGetAttribute(&cus, hipDeviceAttributeMultiprocessorCount, dev) != hipSuccess) { grid = -1; return; }
#if MK_ONE_LAUNCH
        if (hipFuncSetAttribute((const void*)enc_fwd<-1>, hipFuncAttributeMaxDynamicSharedMemorySize, LDS_BYTES) != hipSuccess) { fprintf(stderr, "kernel_launch: hipFuncSetAttribute failed\n"); grid = -1; return; }
        if (hipOccupancyMaxActiveBlocksPerMultiprocessor(&per_cu, (const void*)enc_fwd<-1>, 512, LDS_BYTES) != hipSuccess || per_cu < 1) { fprintf(stderr, "kernel_launch: occupancy query says %d\n", per_cu); grid = -1; return; }
#else
#define SETATTR(K) if (hipFuncSetAttribute((const void*)enc_fwd<K>, hipFuncAttributeMaxDynamicSharedMemorySize, LDS_BYTES) != hipSuccess) { fprintf(stderr, "kernel_launch: hipFuncSetAttribute failed\n"); grid = -1; return; }
        SETATTR(0) SETATTR(1) SETATTR(2) SETATTR(3) SETATTR(4) SETATTR(5) SETATTR(6) SETATTR(7) SETATTR(8) SETATTR(9)
        per_cu = 1;
#endif
        (void)hipGetLastError();
        grid = cus;
    }
    if (grid < 0) return;
    (void)hipMemsetAsync((char*)d_ws + WS_CTL, 0, CTL_ZERO_BYTES, stream);
    Args a{};
    for (int i = 0; i < 25; ++i) a.in[i] = (const float*)d_in[i];
    a.out = (float*)d_out; a.ws = (unsigned char*)d_ws;
#if MK_ONE_LAUNCH
    a.layer = 0;
    hipLaunchKernelGGL(enc_fwd<-1>, dim3(grid), dim3(512), LDS_BYTES, stream, a);
#else
#define LAUNCH_PH(K, LAYER) do { a.layer = (LAYER); hipLaunchKernelGGL(enc_fwd<K>, dim3(grid), dim3(512), LDS_BYTES, stream, a); } while (0)
    LAUNCH_PH(0, 0);
    for (int l = 0; l < DEPTH; ++l) {
        LAUNCH_PH(1, l); LAUNCH_PH(2, l); LAUNCH_PH(3, l); LAUNCH_PH(4, l); LAUNCH_PH(5, l); LAUNCH_PH(6, l); LAUNCH_PH(7, l); LAUNCH_PH(8, l);
        if (l + 1 < DEPTH) LAUNCH_PH(9, l);
    }
#endif
}
```

```cpp
#include <hip/hip_runtime.h>
#include <cstdio>
#include <cstdint>

#ifndef MK_EARLY_WB
#define MK_EARLY_WB 0
#endif
#ifndef MK_SC1_STORES
#define MK_SC1_STORES 0
#endif
#ifndef MK_ONE_LAUNCH
#define MK_ONE_LAUNCH 1
#endif

constexpr int DM = 1024, BATCH = 8, SEQ = 2048, DEPTH = 2, MTOK = BATCH * SEQ, DFF = 2816;
constexpr int IN_W = 2336, NIN = 2560;
constexpr float EPS = 1e-6f;
constexpr float LOG2E = 1.4426950408889634f;

__device__ __forceinline__ float sum_x32(float v) { const unsigned u = __builtin_bit_cast(unsigned, v); auto r = __builtin_amdgcn_permlane32_swap(u, u, false, false); return __builtin_bit_cast(float, (unsigned)r[0]) + __builtin_bit_cast(float, (unsigned)r[1]); }
__device__ __forceinline__ float max_x32(float v) { const unsigned u = __builtin_bit_cast(unsigned, v); auto r = __builtin_amdgcn_permlane32_swap(u, u, false, false); return fmaxf(__builtin_bit_cast(float, (unsigned)r[0]), __builtin_bit_cast(float, (unsigned)r[1])); }
template <int M> __device__ __forceinline__ float swz(float v) { return __builtin_bit_cast(float, __builtin_amdgcn_ds_swizzle(__builtin_bit_cast(int, v), 0x1F | (M << 10))); }

namespace pg8 {
#define PG8_LAS __attribute__((address_space(3)))
typedef unsigned short bf16_t;
typedef short bf16x8 __attribute__((ext_vector_type(8)));
typedef float f32x4 __attribute__((ext_vector_type(4)));
typedef unsigned u32x4 __attribute__((ext_vector_type(4)));
typedef unsigned u32x2 __attribute__((ext_vector_type(2)));
constexpr int BM = 256, BK = 64, HALF = 128, HTB = HALF * BK * 2  , STAGE_BYTES = 8 * HTB, NXCD = 8, WGM = 8;

__host__ __device__ __forceinline__ int lds_byte(int r, int c) { const int st = (r >> 4) * 2 + (c >> 5), rr = r & 15, cc = c & 31, ob = rr * 64 + cc * 2; return st * 1024 + (ob ^ (((ob >> 9) & 1) << 5)); }
__host__ __device__ __forceinline__ void stage_rc(int b, int& R, int& C) { const int st = b / 1024, sb = b % 1024, swz = sb ^ (((sb >> 9) & 1) << 5); R = (st >> 1) * 16 + swz / 64; C = (st & 1) * 32 + (swz % 64) / 2; }
__host__ __device__ __forceinline__ int perm32(int rho) { const int n = rho >> 4, i = rho & 15; return 8 * (i >> 2) + 4 * n + (i & 3); }

struct Unit { int pm, pn; };
struct Gemm { const bf16_t* A; const bf16_t* Bt; int M, N, K, lda, ldb; };

struct StaticOrder {
    int nM, nN, nwg, G, c;
    __host__ __device__ void init(int M, int N, int G_, int c_) { nM = M / BM; nN = N / BM; nwg = nM * nN; G = G_; c = c_; }
    __host__ __device__ bool next(int i, Unit& u) const {
        const long L = (long)i * G + c; if (L >= nwg) return false;
        int wgid = (int)L; { const int q = nwg / NXCD, r = nwg % NXCD, xcd = wgid % NXCD, off = wgid / NXCD; wgid = (xcd < r ? xcd * (q + 1) : r * (q + 1) + (xcd - r) * q) + off; }
        const int nig = WGM * nN, gid = wgid / nig, fm = gid * WGM, gsz = (nM - fm) < WGM ? (nM - fm) : WGM;
        u.pm = fm + ((wgid % nig) % gsz); u.pn = (wgid % nig) / gsz; return true;
    }
    __device__ __forceinline__ void a_ready(const Unit&) const {}
    __device__ __forceinline__ void done(const Unit&) const {}
};

__device__ __forceinline__ unsigned cvt_pk_bf16(float lo, float hi) { unsigned r; asm volatile("v_cvt_pk_bf16_f32 %0, %1, %2" : "=v"(r) : "v"(lo), "v"(hi)); return r; }

__device__ __forceinline__ float rowscale16(const float* P, int row) {
    const f32x4* p = (const f32x4*)(P + (size_t)row * 16);
    const f32x4 a = p[0], b = p[1], c = p[2], d = p[3];
    const float s = ((a[0] + a[1]) + (a[2] + a[3])) + ((b[0] + b[1]) + (b[2] + b[3])) + ((c[0] + c[1]) + (c[2] + c[3])) + ((d[0] + d[1]) + (d[2] + d[3]));
    return __builtin_amdgcn_rsqf(s * (1.0f / 1024.0f) + EPS);
}
__device__ __forceinline__ void rowscale_all(const float* P, int row0, int fq, float (&r)[8]) {
    f32x4 t[8];
#pragma unroll
    for (int i = 0; i < 8; ++i) t[i] = *(const f32x4*)(P + (size_t)(row0 + (i >> 2) * HALF + (i & 3) * 16) * 16 + fq * 4);
#pragma unroll
    for (int i = 0; i < 8; ++i) { float s = (t[i][0] + t[i][1]) + (t[i][2] + t[i][3]); s += swz<16>(s); s = sum_x32(s); r[i] = __builtin_amdgcn_rsqf(s * (1.0f / 1024.0f) + EPS); }
}
__device__ __forceinline__ u32x4 pack8(const float* v) { u32x4 w; w.x = cvt_pk_bf16(v[0], v[1]); w.y = cvt_pk_bf16(v[2], v[3]); w.z = cvt_pk_bf16(v[4], v[5]); w.w = cvt_pk_bf16(v[6], v[7]); return w; }
__device__ __forceinline__ float quad_sum(float s) { s += swz<16>(s); return sum_x32(s); }
#define EPI_OPAQUE() do { u.pm = __builtin_amdgcn_readfirstlane(u.pm); u.pn = __builtin_amdgcn_readfirstlane(u.pn); wr = __builtin_amdgcn_readfirstlane(wr); wc = __builtin_amdgcn_readfirstlane(wc); \
    asm volatile("" : "+s"(u.pm), "+s"(u.pn), "+s"(wr), "+s"(wc), "+v"(fr), "+v"(fq)); } while (0)
#if MK_SC1_STORES
__device__ __forceinline__ void st16(void* p, u32x4 v) { asm volatile("global_store_dwordx4 %0, %1, off sc1\n\ts_nop 1" :: "v"(p), "v"(v) : "memory"); }
__device__ __forceinline__ void st16f(void* p, f32x4 v) { asm volatile("global_store_dwordx4 %0, %1, off sc1\n\ts_nop 1" :: "v"(p), "v"(v) : "memory"); }
#else
__device__ __forceinline__ void st16(void* p, u32x4 v) { *(u32x4*)p = v; }
__device__ __forceinline__ void st16f(void* p, f32x4 v) { *(f32x4*)p = v; }
#endif
#define XS_BAR() do { asm volatile("s_waitcnt lgkmcnt(0)" ::: "memory"); __builtin_amdgcn_s_barrier(); asm volatile("" ::: "memory"); } while (0)

struct EpiSwiGLU {
    static constexpr bool PERM = true, AFTER_DRAIN = false, DUP_OK = true;
    bf16_t* H; const float* P;
    __device__ __forceinline__ void operator()(const f32x4 (&acc)[2][2][4][2], const Unit& u_, int wr, int wc, int fr, int fq, PG8_LAS float* xs) const {
        Unit u = u_; EPI_OPAQUE();
        float rs[8]; rowscale_all(P, u.pm * BM + wr * 64 + fr, fq, rs);
#pragma unroll
        for (int ai = 0; ai < 2; ++ai)
#pragma unroll
            for (int m = 0; m < 4; ++m) {
                const int row = u.pm * BM + ai * HALF + wr * 64 + m * 16 + fr;
                const float r = rs[ai * 4 + m];
                float h[8];
#pragma unroll
                for (int n = 0; n < 2; ++n)
#pragma unroll
                    for (int j = 0; j < 4; ++j) {
                        const float g = acc[ai][0][m][n][j] * r, up = acc[ai][1][m][n][j] * r;
                        h[n * 4 + j] = g * __builtin_amdgcn_rcpf(1.0f + __builtin_amdgcn_exp2f(-g * LOG2E)) * up;
                    }
                st16(H + (size_t)row * DFF + u.pn * 128 + wc * 32 + fq * 8, pack8(h));
            }
    }
};

struct EpiResid {
    static constexpr bool PERM = true, AFTER_DRAIN = false, DUP_OK = false;
    const float* Xin; float* X; bf16_t* XB; float* Pout; float alpha;
    __device__ __forceinline__ void operator()(const f32x4 (&acc)[2][2][4][2], const Unit& u_, int wr, int wc, int fr, int fq, PG8_LAS float* xs) const {
        Unit u = u_; EPI_OPAQUE();
        const size_t off0 = (size_t)(u.pm * BM + wr * 64 + fr) * DM + u.pn * BM + wc * 32 + fq * 8;
        f32x4 cur[4], nxt[4];
#pragma unroll
        for (int bj = 0; bj < 2; ++bj) { cur[2 * bj] = *(const f32x4*)(Xin + off0 + bj * HALF); cur[2 * bj + 1] = *(const f32x4*)(Xin + off0 + bj * HALF + 4); }
#pragma unroll
        for (int i = 0; i < 8; ++i) {
            const int ai = i >> 2, m = i & 3;
            const size_t off = off0 + (size_t)(ai * HALF + m * 16) * DM;
            if (i < 7) { const size_t offn = off0 + (size_t)(((i + 1) >> 2) * HALF + ((i + 1) & 3) * 16) * DM;
#pragma unroll
                for (int bj = 0; bj < 2; ++bj) { nxt[2 * bj] = *(const f32x4*)(Xin + offn + bj * HALF); nxt[2 * bj + 1] = *(const f32x4*)(Xin + offn + bj * HALF + 4); } }
            float ss = 0.f;
#pragma unroll
            for (int bj = 0; bj < 2; ++bj) {
                const f32x4 v0 = cur[2 * bj] + acc[ai][bj][m][0] * alpha, v1 = cur[2 * bj + 1] + acc[ai][bj][m][1] * alpha;
                st16f(X + off + bj * HALF, v0); st16f(X + off + bj * HALF + 4, v1);
                if (XB) { const float t[8] = {v0[0], v0[1], v0[2], v0[3], v1[0], v1[1], v1[2], v1[3]}; st16(XB + off + bj * HALF, pack8(t)); }
                ss += (v0[0] * v0[0] + v0[1] * v0[1]) + (v0[2] * v0[2] + v0[3] * v0[3]) + (v1[0] * v1[0] + v1[1] * v1[1]) + (v1[2] * v1[2] + v1[3] * v1[3]);
            }
            if (Pout) { ss = quad_sum(ss); if (fq == 0) Pout[(size_t)(u.pm * BM + ai * HALF + wr * 64 + m * 16 + fr) * 16 + u.pn * 4 + wc] = ss; }
#pragma unroll
            for (int j = 0; j < 4; ++j) cur[j] = nxt[j];
            asm volatile("" ::: "memory");
        }
    }
};

struct EpiInProj {
    static constexpr bool PERM = true, AFTER_DRAIN = false, DUP_OK = false;
    const float* P;
    bf16_t *Qd, *Kd, *Vd, *Ql, *Kl, *Vl, *AQ; float *kr, *krss;
    const float *g_dq, *g_dk, *g_lq, *g_lk;
    float cdiff, cdil;
    __device__ __forceinline__ void operator()(const f32x4 (&acc)[2][2][4][2], const Unit& u_, int wr, int wc, int fr, int fq, PG8_LAS float* xs) const {
        Unit u = u_; EPI_OPAQUE();
        const int t = u.pn;
        if (t == 7 || t == 8) {
#pragma unroll
            for (int ai = 0; ai < 2; ++ai)
#pragma unroll
                for (int m = 0; m < 4; ++m) {
                    const int rl = ai * HALF + wr * 64 + m * 16 + fr;
                    float ss = 0.f;
#pragma unroll
                    for (int bj = 0; bj < 2; ++bj)
#pragma unroll
                        for (int n = 0; n < 2; ++n) { const f32x4 a = acc[ai][bj][m][n]; ss += (a[0] * a[0] + a[1] * a[1]) + (a[2] * a[2] + a[3] * a[3]); }
                    ss = quad_sum(ss);
                    if (fq == 0) xs[rl * 4 + wc] = ss;
                }
            XS_BAR();
        }
        float rs[8]; rowscale_all(P, u.pm * BM + wr * 64 + fr, fq, rs);
        float gg[2][8];
        {
            const bool dil_ = (t >= 3 && t <= 5), isq_ = (t == 0) || (t == 3) || (t == 4 && wc < 2);
            const float *p_dq = g_dq, *p_dk = g_dk, *p_lq = g_lq, *p_lk = g_lk; asm volatile("" : "+s"(p_dq), "+s"(p_dk), "+s"(p_lq), "+s"(p_lk));
            const float* gp = dil_ ? (isq_ ? p_lq : p_lk) : (t == 1 ? p_dk : p_dq);
            const int gstep = dil_ ? 32 : 0;
#pragma unroll
            for (int bj = 0; bj < 2; ++bj)
#pragma unroll
                for (int i = 0; i < 8; ++i) gg[bj][i] = gp[bj * gstep + fq * 8 + i];
        }
#pragma unroll
        for (int ai = 0; ai < 2; ++ai)
#pragma unroll
            for (int m = 0; m < 4; ++m) {
                asm volatile("" ::: "memory");
                const int rl = ai * HALF + wr * 64 + m * 16 + fr, row = u.pm * BM + rl, b = row >> 11, s = row & (SEQ - 1);
                const float r = rs[ai * 4 + m];
                float v[2][8];
#pragma unroll
                for (int bj = 0; bj < 2; ++bj)
#pragma unroll
                    for (int n = 0; n < 2; ++n)
#pragma unroll
                        for (int j = 0; j < 4; ++j) v[bj][n * 4 + j] = acc[ai][bj][m][n][j] * r;
                if (t <= 1) {
                    bf16_t* dst = t == 0 ? Qd : Kd; const float post = t == 0 ? cdiff : 1.0f;
#pragma unroll
                    for (int bj = 0; bj < 2; ++bj) {
                        float ss = 0.f;
#pragma unroll
                        for (int i = 0; i < 8; ++i) ss += v[bj][i] * v[bj][i];
                        ss = quad_sum(ss);
                        const float rn = __builtin_amdgcn_rsqf(ss * (1.0f / 32.0f) + EPS) * post;
                        float o[8];
#pragma unroll
                        for (int i = 0; i < 8; ++i) o[i] = v[bj][i] * rn * gg[bj][i];
                        *(u32x4*)(dst + ((size_t)(((b * 4 + wc) * 2 + bj) * SEQ + s)) * 32 + fq * 8) = pack8(o);
                    }
                } else if (t == 2) {
#pragma unroll
                    for (int bj = 0; bj < 2; ++bj) *(u32x4*)(Vd + ((size_t)((b * 4 + wc) * SEQ + s)) * 64 + bj * 32 + fq * 8) = pack8(v[bj]);
                } else if (t <= 5) {
                    const bool isq = (t == 3) || (t == 4 && wc < 2);
                    const int head = (t == 3) ? wc : (t == 4 ? (wc < 2 ? 4 + wc : wc - 2) : wc + 2);
                    bf16_t* dst = isq ? Ql : Kl; const float post = isq ? cdil : 1.0f;
                    float ss = 0.f;
#pragma unroll
                    for (int bj = 0; bj < 2; ++bj)
#pragma unroll
                        for (int i = 0; i < 8; ++i) ss += v[bj][i] * v[bj][i];
                    ss = quad_sum(ss);
                    const float rn = __builtin_amdgcn_rsqf(ss * (1.0f / 64.0f) + EPS) * post;
#pragma unroll
                    for (int bj = 0; bj < 2; ++bj) {
                        float o[8];
#pragma unroll
                        for (int i = 0; i < 8; ++i) o[i] = v[bj][i] * rn * gg[bj][i];
                        *(u32x4*)(dst + ((size_t)((b * 6 + head) * SEQ + s)) * 64 + bj * 32 + fq * 8) = pack8(o);
                    }
                } else if (t == 6 || (t == 7 && wc < 2)) {
                    const int head = t == 6 ? wc : 4 + wc;
#pragma unroll
                    for (int bj = 0; bj < 2; ++bj) *(u32x4*)(Vl + ((size_t)((b * 6 + head) * SEQ + s)) * 64 + bj * 32 + fq * 8) = pack8(v[bj]);
                } else if (t == 7) {
                    const float ss = (xs[rl * 4 + 2] + xs[rl * 4 + 3]) * r * r;
                    const float rn = __builtin_amdgcn_rsqf(ss * (1.0f / 128.0f) + EPS);
#pragma unroll
                    for (int bj = 0; bj < 2; ++bj) {
                        float o[8];
#pragma unroll
                        for (int i = 0; i < 8; ++i) o[i] = v[bj][i] * rn;
                        *(u32x4*)(AQ + (size_t)row * 384 + 256 + (wc - 2) * 64 + bj * 32 + fq * 8) = pack8(o);
                    }
                } else if (t == 8) {
                    const float ss = ((xs[rl * 4 + 0] + xs[rl * 4 + 1]) + (xs[rl * 4 + 2] + xs[rl * 4 + 3])) * r * r;
                    const float rn = __builtin_amdgcn_rsqf(ss * (1.0f / 256.0f) + EPS);
#pragma unroll
                    for (int bj = 0; bj < 2; ++bj) {
                        float o[8];
#pragma unroll
                        for (int i = 0; i < 8; ++i) o[i] = v[bj][i] * rn;
                        *(u32x4*)(AQ + (size_t)row * 384 + bj * 128 + wc * 32 + fq * 8) = pack8(o);
                    }
                } else {
                    if (wc == 0) {
                        float ss = 0.f;
#pragma unroll
                        for (int bj = 0; bj < 2; ++bj)
#pragma unroll
                            for (int i = 0; i < 8; ++i) ss += v[bj][i] * v[bj][i];
                        ss = quad_sum(ss);
                        if (fq < 2) {
#pragma unroll
                            for (int bj = 0; bj < 2; ++bj) {
                                *(f32x4*)(kr + (size_t)row * 32 + bj * 16 + fq * 8) = (f32x4){v[bj][0], v[bj][1], v[bj][2], v[bj][3]};
                                *(f32x4*)(kr + (size_t)row * 32 + bj * 16 + fq * 8 + 4) = (f32x4){v[bj][4], v[bj][5], v[bj][6], v[bj][7]};
                            }
                        }
                        if (fq == 0) krss[row] = ss;
                    }
                }
            }
    }
};

struct EpiMlaQ {
    static constexpr bool PERM = true, AFTER_DRAIN = false, DUP_OK = false;
    bf16_t* Qc; const float* qn; const float* cs; const float* sn; float cmla;
    __device__ __forceinline__ void operator()(const f32x4 (&acc)[2][2][4][2], const Unit& u_, int wr, int wc, int fr, int fq, PG8_LAS float* xs) const {
        Unit u = u_; EPI_OPAQUE();
#pragma unroll
        for (int ai = 0; ai < 2; ++ai)
#pragma unroll
            for (int m = 0; m < 4; ++m) {
                const int rl = ai * HALF + wr * 64 + m * 16 + fr;
                float ss = 0.f;
#pragma unroll
                for (int bj = 0; bj < 2; ++bj)
#pragma unroll
                    for (int n = 0; n < 2; ++n) { const f32x4 a = acc[ai][bj][m][n]; ss += (a[0] * a[0] + a[1] * a[1]) + (a[2] * a[2] + a[3] * a[3]); }
                ss = quad_sum(ss);
                if (fq == 0) xs[rl * 4 + wc] = ss;
            }
        XS_BAR();
        const int hs = wc >> 1, head = u.pn * 2 + hs; const bool rope = wc & 1;
        float gq[16];
#pragma unroll
        for (int i = 0; i < 16; ++i) gq[i] = qn[(rope ? 64 + (i >> 3) * 16 : (i >> 3) * 32) + fq * 8 + (i & 7)];
        float cc[8], sv[8], ccn[8], svn[8];
        if (rope && fq < 2) { const int s0 = (u.pm * BM + wr * 64 + fr) & (SEQ - 1);
#pragma unroll
            for (int i = 0; i < 8; ++i) { cc[i] = cs[s0 * 16 + fq * 8 + i]; sv[i] = sn[s0 * 16 + fq * 8 + i]; } }
#pragma unroll
        for (int ig = 0; ig < 8; ++ig) {
            const int ai = ig >> 2, m = ig & 3;
            const int rl = ai * HALF + wr * 64 + m * 16 + fr, row = u.pm * BM + rl, b = row >> 11, s = row & (SEQ - 1);
            if (rope && fq < 2 && ig < 7) { const int sn_ = (u.pm * BM + ((ig + 1) >> 2) * HALF + wr * 64 + ((ig + 1) & 3) * 16 + fr) & (SEQ - 1);
#pragma unroll
                for (int i = 0; i < 8; ++i) { ccn[i] = cs[sn_ * 16 + fq * 8 + i]; svn[i] = sn[sn_ * 16 + fq * 8 + i]; } }
            const float ss = xs[rl * 4 + hs * 2] + xs[rl * 4 + hs * 2 + 1];
            const float rn = __builtin_amdgcn_rsqf(ss * (1.0f / 96.0f) + EPS) * cmla;
            bf16_t* dst = Qc + ((size_t)((b * 6 + head) * SEQ + s)) * 96;
            if (!rope) {
#pragma unroll
                for (int bj = 0; bj < 2; ++bj) {
                    float o[8];
#pragma unroll
                    for (int n = 0; n < 2; ++n)
#pragma unroll
                        for (int j = 0; j < 4; ++j) o[n * 4 + j] = acc[ai][bj][m][n][j] * rn * gq[bj * 8 + n * 4 + j];
                    *(u32x4*)(dst + bj * 32 + fq * 8) = pack8(o);
                }
            } else if (fq < 2) {
                float o1[8], o2[8];
#pragma unroll
                for (int n = 0; n < 2; ++n)
#pragma unroll
                    for (int j = 0; j < 4; ++j) {
                        const int i = n * 4 + j;
                        const float x1 = acc[ai][0][m][n][j] * rn * gq[i], x2 = acc[ai][1][m][n][j] * rn * gq[8 + i];
                        o1[i] = x1 * cc[i] - x2 * sv[i]; o2[i] = x1 * sv[i] + x2 * cc[i];
                    }
                *(u32x4*)(dst + 64 + fq * 8) = pack8(o1);
                *(u32x4*)(dst + 80 + fq * 8) = pack8(o2);
#pragma unroll
                for (int i = 0; i < 8; ++i) { cc[i] = ccn[i]; sv[i] = svn[i]; }
            }
            asm volatile("" ::: "memory");
        }
    }
};

struct EpiMlaKV {
    static constexpr bool PERM = true, AFTER_DRAIN = false, DUP_OK = false;
    bf16_t *Kc, *Vc; const float *kn, *kr, *krss, *cs, *sn;
    __device__ __forceinline__ void operator()(const f32x4 (&acc)[2][2][4][2], const Unit& u_, int wr, int wc, int fr, int fq, PG8_LAS float* xs) const {
        Unit u = u_; EPI_OPAQUE();
        const int hs = wc >> 1, head = u.pn * 2 + hs;
        if (wc & 1) {
#pragma unroll
            for (int ai = 0; ai < 2; ++ai)
#pragma unroll
                for (int m = 0; m < 4; ++m) {
                    asm volatile("" ::: "memory");
                    const int rl = ai * HALF + wr * 64 + m * 16 + fr, row = u.pm * BM + rl, b = row >> 11, s = row & (SEQ - 1);
#pragma unroll
                    for (int bj = 0; bj < 2; ++bj) {
                        float o[8];
#pragma unroll
                        for (int n = 0; n < 2; ++n)
#pragma unroll
                            for (int j = 0; j < 4; ++j) o[n * 4 + j] = acc[ai][bj][m][n][j];
                        *(u32x4*)(Vc + ((size_t)((b * 6 + head) * SEQ + s)) * 64 + bj * 32 + fq * 8) = pack8(o);
                    }
                }
        } else {
            float gk[16], gr1[4], gr2[4];
#pragma unroll
            for (int i = 0; i < 16; ++i) gk[i] = kn[(i >> 3) * 32 + fq * 8 + (i & 7)];
#pragma unroll
            for (int j = 0; j < 4; ++j) { gr1[j] = kn[64 + fq * 4 + j]; gr2[j] = kn[80 + fq * 4 + j]; }
            f32x4 k1, k2, k1n, k2n, c4, s4, c4n, s4n; float kss, kssn;
            { const int row = u.pm * BM + wr * 64 + fr, s0 = row & (SEQ - 1);
              k1 = *(const f32x4*)(kr + (size_t)row * 32 + fq * 4); k2 = *(const f32x4*)(kr + (size_t)row * 32 + 16 + fq * 4); kss = krss[row];
              c4 = *(const f32x4*)(cs + s0 * 16 + fq * 4); s4 = *(const f32x4*)(sn + s0 * 16 + fq * 4); }
#pragma unroll
            for (int ig = 0; ig < 8; ++ig) {
                const int ai = ig >> 2, m = ig & 3;
                const int rl = ai * HALF + wr * 64 + m * 16 + fr, row = u.pm * BM + rl, b = row >> 11, s = row & (SEQ - 1);
                if (ig < 7) { const int rown = u.pm * BM + ((ig + 1) >> 2) * HALF + wr * 64 + ((ig + 1) & 3) * 16 + fr, s1 = rown & (SEQ - 1);
                    k1n = *(const f32x4*)(kr + (size_t)rown * 32 + fq * 4); k2n = *(const f32x4*)(kr + (size_t)rown * 32 + 16 + fq * 4); kssn = krss[rown];
                    c4n = *(const f32x4*)(cs + s1 * 16 + fq * 4); s4n = *(const f32x4*)(sn + s1 * 16 + fq * 4); }
                float ss = 0.f;
#pragma unroll
                for (int bj = 0; bj < 2; ++bj)
#pragma unroll
                    for (int n = 0; n < 2; ++n) { const f32x4 a = acc[ai][bj][m][n]; ss += (a[0] * a[0] + a[1] * a[1]) + (a[2] * a[2] + a[3] * a[3]); }
                ss = quad_sum(ss) + kss;
                const float rn = __builtin_amdgcn_rsqf(ss * (1.0f / 96.0f) + EPS);
                bf16_t* dst = Kc + ((size_t)((b * 6 + head) * SEQ + s)) * 96;
#pragma unroll
                for (int bj = 0; bj < 2; ++bj) {
                    float o[8];
#pragma unroll
                    for (int n = 0; n < 2; ++n)
#pragma unroll
                        for (int j = 0; j < 4; ++j) o[n * 4 + j] = acc[ai][bj][m][n][j] * rn * gk[bj * 8 + n * 4 + j];
                    *(u32x4*)(dst + bj * 32 + fq * 8) = pack8(o);
                }
                float o1[4], o2[4];
#pragma unroll
                for (int j = 0; j < 4; ++j) {
                    const float x1 = k1[j] * rn * gr1[j], x2 = k2[j] * rn * gr2[j];
                    o1[j] = x1 * c4[j] - x2 * s4[j]; o2[j] = x1 * s4[j] + x2 * c4[j];
                }
                *(u32x2*)(dst + 64 + fq * 4) = (u32x2){cvt_pk_bf16(o1[0], o1[1]), cvt_pk_bf16(o1[2], o1[3])};
                *(u32x2*)(dst + 80 + fq * 4) = (u32x2){cvt_pk_bf16(o2[0], o2[1]), cvt_pk_bf16(o2[2], o2[3])};
                k1 = k1n; k2 = k2n; kss = kssn; c4 = c4n; s4 = s4n;
                asm volatile("" ::: "memory");
            }
        }
    }
};
template <class Epi, class Sched, bool ALIGN_EPI = false, bool SP2 = false>
__device__ __forceinline__ void gemm_phase(const int tid, PG8_LAS unsigned char* lds, PG8_LAS float* xs, const Gemm g, const Sched& S, const Epi& E) {
    const int wid = __builtin_amdgcn_readfirstlane(tid >> 6), lane = tid & 63, wr = wid >> 2, wc = wid & 3, fr = lane & 15, fq = lane >> 4;
    const int K = g.K, nt = K / BK;
    unsigned voffA[2], voffB[2];
#pragma unroll
    for (int i = 0; i < 2; ++i) { int R, C; stage_rc(tid * 16 + i * 8192, R, C); const int Rb = Epi::PERM ? ((R & ~31) + perm32(R & 31)) : R;
        voffA[i] = (unsigned)(R * g.lda + C) * 2u; voffB[i] = (unsigned)(Rb * g.ldb + C) * 2u; }
    const size_t kstep = (size_t)(BK * 2);
    const size_t hstepA = (size_t)HALF * g.lda * 2, hstepB = (size_t)HALF * g.ldb * 2;
    const size_t tstepA = 2 * hstepA, tstepB = 2 * hstepB;
    const unsigned ldsw = (unsigned)wid * 1024u;
    const int aoff = lds_byte(wr * 64 + fr, fq * 8), boff = lds_byte(wc * 32 + fr, fq * 8);
#define PG8_SA(b, h) (((b) * 2 + (h)) * HTB)
#define PG8_SB(b, h) ((4 + (b) * 2 + (h)) * HTB)
#define PG8_STAGE(bufoff, gbase, voff) do { _Pragma("unroll") for (int _i = 0; _i < 2; ++_i) \
        __builtin_amdgcn_global_load_lds((const unsigned*)((const char*)(gbase) + (voff)[_i]), (PG8_LAS unsigned*)(lds + (bufoff) + ldsw + _i * 8192), 16, 0, 0); } while (0)
#define PG8_LDA(dst, b, h) do { _Pragma("unroll") for (int m = 0; m < 4; ++m) _Pragma("unroll") for (int k = 0; k < 2; ++k) dst[m][k] = *(const PG8_LAS bf16x8*)(lds + PG8_SA(b, h) + aoff + m * 2048 + k * 1024); } while (0)
#define PG8_LDB(dst, b, h) do { _Pragma("unroll") for (int n = 0; n < 2; ++n) _Pragma("unroll") for (int k = 0; k < 2; ++k) dst[n][k] = *(const PG8_LAS bf16x8*)(lds + PG8_SB(b, h) + boff + n * 2048 + k * 1024); } while (0)
#define PG8_MMA(ai, bj, At, Bt) do { __builtin_amdgcn_s_setprio(1); _Pragma("unroll") for (int m = 0; m < 4; ++m) _Pragma("unroll") for (int n = 0; n < 2; ++n) _Pragma("unroll") for (int k = 0; k < 2; ++k) \
        acc[ai][bj][m][n] = __builtin_amdgcn_mfma_f32_16x16x32_bf16(Bt[n][k], At[m][k], acc[ai][bj][m][n], 0, 0, 0); __builtin_amdgcn_s_setprio(0); } while (0)
#define PG8_WAIT_V(n) asm volatile("s_waitcnt vmcnt(" #n ")" ::: "memory")
#define PG8_WAIT_L(n) asm volatile("s_waitcnt lgkmcnt(" #n ")" ::: "memory")
#define PG8_BAR __builtin_amdgcn_s_barrier()
#define PG8_SCHED __builtin_amdgcn_sched_barrier(0)
    Unit cur, nxt; int ui = 0;
    if (!S.next(0, cur)) return;
    f32x4 acc[2][2][4][2];
#pragma unroll
    for (int a = 0; a < 2; ++a)
#pragma unroll
        for (int b = 0; b < 2; ++b)
#pragma unroll
            for (int m = 0; m < 4; ++m)
#pragma unroll
                for (int n = 0; n < 2; ++n) acc[a][b][m][n] = (f32x4){0.f, 0.f, 0.f, 0.f};
    bf16x8 At[4][2], B0[2][2], B1[2][2];
    const char* cA = (const char*)g.A + (size_t)cur.pm * tstepA; const char* cB = (const char*)g.Bt + (size_t)cur.pn * tstepB;
    S.a_ready(cur);
    if constexpr (SP2) {
        PG8_STAGE(PG8_SB(0, 0), cB, voffB); PG8_STAGE(PG8_SB(0, 1), cB + hstepB, voffB); PG8_STAGE(PG8_SA(0, 0), cA, voffA); PG8_STAGE(PG8_SA(0, 1), cA + hstepA, voffA);
        if (wr == 1) PG8_BAR;
        PG8_WAIT_V(2); PG8_BAR;
        PG8_STAGE(PG8_SB(1, 0), cB + kstep, voffB); PG8_STAGE(PG8_SA(1, 0), cA + kstep, voffA); PG8_STAGE(PG8_SB(1, 1), cB + hstepB + kstep, voffB);
        PG8_WAIT_V(6); PG8_BAR;
    } else {
        PG8_STAGE(PG8_SB(0, 0), cB, voffB); PG8_STAGE(PG8_SA(0, 0), cA, voffA); PG8_STAGE(PG8_SB(0, 1), cB + hstepB, voffB); PG8_STAGE(PG8_SA(0, 1), cA + hstepA, voffA);
        if (wr == 1) PG8_BAR;
        PG8_WAIT_V(4); PG8_BAR;
        PG8_STAGE(PG8_SB(1, 0), cB + kstep, voffB); PG8_STAGE(PG8_SA(1, 0), cA + kstep, voffA); PG8_STAGE(PG8_SB(1, 1), cB + hstepB + kstep, voffB);
        PG8_WAIT_V(6); PG8_BAR;
    }
    for (;;) {
        const bool has_next = S.next(ui + 1, nxt);
        const char* nA = has_next ? (const char*)g.A + (size_t)nxt.pm * tstepA : cA; const char* nB = has_next ? (const char*)g.Bt + (size_t)nxt.pn * tstepB : cB;
        for (int t = 0; t < nt; t += 2) {
            const bool last = (t == nt - 2);
            const char* a1 = cA + (size_t)(t + 1) * kstep;
            const char* a2 = last ? nA : cA + (size_t)(t + 2) * kstep; const char* b2 = last ? nB : cB + (size_t)(t + 2) * kstep;
            const char* a3 = a2 + kstep; const char* b3 = b2 + kstep;
            if (last && has_next) S.a_ready(nxt);
            if constexpr (SP2) {
            PG8_LDB(B0, 0, 0); PG8_LDB(B1, 0, 1); PG8_SCHED; PG8_LDA(At, 0, 0); PG8_STAGE(PG8_SA(1, 1), a1 + hstepA, voffA);
            PG8_WAIT_V(8); PG8_WAIT_L(0); PG8_BAR; PG8_MMA(0, 0, At, B0); PG8_MMA(0, 1, At, B1); PG8_BAR; PG8_SCHED;
            PG8_LDA(At, 0, 1); PG8_STAGE(PG8_SB(0, 0), b2, voffB); PG8_STAGE(PG8_SB(0, 1), b2 + hstepB, voffB); PG8_STAGE(PG8_SA(0, 0), a2, voffA);
            PG8_WAIT_V(8); PG8_WAIT_L(0); PG8_BAR; PG8_MMA(1, 0, At, B0); PG8_MMA(1, 1, At, B1); PG8_BAR; PG8_SCHED;
            PG8_LDB(B0, 1, 0); PG8_LDB(B1, 1, 1); PG8_SCHED; PG8_LDA(At, 1, 0); PG8_STAGE(PG8_SA(0, 1), a2 + hstepA, voffA);
            PG8_WAIT_V(8); PG8_WAIT_L(0); PG8_BAR; PG8_MMA(0, 0, At, B0); PG8_MMA(0, 1, At, B1); PG8_BAR; PG8_SCHED;
            PG8_LDA(At, 1, 1); PG8_STAGE(PG8_SB(1, 0), b3, voffB); PG8_STAGE(PG8_SB(1, 1), b3 + hstepB, voffB); PG8_STAGE(PG8_SA(1, 0), a3, voffA);
            PG8_WAIT_V(8); PG8_WAIT_L(0); PG8_BAR; PG8_MMA(1, 0, At, B0); PG8_MMA(1, 1, At, B1); PG8_BAR; PG8_SCHED;
            } else {
            PG8_LDB(B0, 0, 0); PG8_SCHED; PG8_LDA(At, 0, 0); PG8_STAGE(PG8_SA(1, 1), a1 + hstepA, voffA);
            PG8_WAIT_L(8); PG8_BAR; PG8_WAIT_L(0); PG8_MMA(0, 0, At, B0); PG8_BAR; PG8_SCHED;
            PG8_LDB(B1, 0, 1); PG8_STAGE(PG8_SB(0, 0), b2, voffB);
            PG8_BAR; PG8_WAIT_L(0); PG8_MMA(0, 1, At, B1); PG8_BAR;
            PG8_LDA(At, 0, 1); PG8_STAGE(PG8_SA(0, 0), a2, voffA);
            PG8_BAR; PG8_WAIT_L(0); PG8_MMA(1, 0, At, B0); PG8_BAR; PG8_SCHED;
            PG8_STAGE(PG8_SB(0, 1), b2 + hstepB, voffB);
            PG8_WAIT_V(6); PG8_BAR; PG8_MMA(1, 1, At, B1); PG8_BAR;
            PG8_LDB(B0, 1, 0); PG8_SCHED; PG8_LDA(At, 1, 0); PG8_STAGE(PG8_SA(0, 1), a2 + hstepA, voffA);
            PG8_WAIT_L(8); PG8_BAR; PG8_WAIT_L(0); PG8_MMA(0, 0, At, B0); PG8_BAR; PG8_SCHED;
            PG8_LDB(B1, 1, 1); PG8_STAGE(PG8_SB(1, 0), b3, voffB);
            PG8_BAR; PG8_WAIT_L(0); PG8_MMA(0, 1, At, B1); PG8_BAR;
            PG8_LDA(At, 1, 1); PG8_STAGE(PG8_SA(1, 0), a3, voffA);
            PG8_BAR; PG8_WAIT_L(0); PG8_MMA(1, 0, At, B0); PG8_BAR; PG8_SCHED;
            PG8_STAGE(PG8_SB(1, 1), b3 + hstepB, voffB);
            PG8_WAIT_V(6); PG8_BAR; PG8_MMA(1, 1, At, B1); PG8_BAR;
            }
        }
        if constexpr (ALIGN_EPI) { if (wr == 0) PG8_BAR; }
        if constexpr (!Epi::AFTER_DRAIN) { E(acc, cur, wr, wc, fr, fq, xs);
#if defined(MK_DUP_EPI)
            if constexpr (Epi::DUP_OK) E(acc, cur, wr, wc, fr, fq, xs);
#endif
            S.done(cur); }
        if (!has_next) break;
#pragma unroll
        for (int a = 0; a < 2; ++a)
#pragma unroll
            for (int b = 0; b < 2; ++b)
#pragma unroll
                for (int m = 0; m < 4; ++m)
#pragma unroll
                    for (int n = 0; n < 2; ++n) acc[a][b][m][n] = (f32x4){0.f, 0.f, 0.f, 0.f};
        cur = nxt; cA = nA; cB = nB; ++ui;
        if constexpr (ALIGN_EPI) { if (wr == 1) PG8_BAR; }
    }
    PG8_WAIT_V(0);
    if constexpr (!ALIGN_EPI) { if (wr == 0) PG8_BAR; }
    PG8_BAR;
    if constexpr (Epi::AFTER_DRAIN) { E(acc, cur, wr, wc, fr, fq, xs); S.done(cur); }
#undef PG8_SA
#undef PG8_SB
#undef PG8_STAGE
#undef PG8_LDA
#undef PG8_LDB
#undef PG8_MMA
#undef PG8_WAIT_V
#undef PG8_WAIT_L
#undef PG8_BAR
#undef PG8_SCHED
}
}

constexpr size_t MiB = 1u << 20;
constexpr size_t WS_CTL = 0, CTL_ZERO_BYTES = 1 * MiB;
constexpr size_t WS_TAB = 1 * MiB;
constexpr size_t WS_P = 2 * MiB;
constexpr size_t WS_KR = 5 * MiB;
constexpr size_t WS_KRSS = 7 * MiB;
constexpr size_t WS_W = 8 * MiB;
constexpr size_t W_GU1 = WS_W, W_GU2 = W_GU1 + 11 * MiB, W_D1 = W_GU2 + 11 * MiB, W_D2 = W_D1 + 5632 * 1024, W_IN = W_D2 + 5632 * 1024, W_O = W_IN + 5 * MiB, W_QU = W_O + 2 * MiB, W_KVU = W_QU + 768 * 256 * 2, W_END = W_KVU + 768 * 256 * 2;
static_assert(W_END <= 50 * MiB, "weights");
constexpr size_t WS_XB = 50 * MiB;
constexpr size_t WS_R = 82 * MiB;
constexpr size_t WS_H = WS_R;
constexpr size_t WS_QD = WS_R, WS_KD = WS_QD + 8 * MiB, WS_VD = WS_KD + 8 * MiB, WS_QL = WS_VD + 8 * MiB, WS_KL = WS_QL + 12 * MiB, WS_VL = WS_KL + 12 * MiB;
constexpr size_t WS_QC = WS_VL + 12 * MiB, WS_KC = WS_QC + 18 * MiB, WS_VC = WS_KC + 18 * MiB, WS_AQ = WS_VC + 12 * MiB, WS_MIX = WS_AQ + 12 * MiB, WS_END = WS_MIX + 32 * MiB;
static_assert(WS_END <= 236 * MiB && WS_H + (size_t)MTOK * DFF * 2 <= WS_MIX, "d_ws map");
constexpr size_t WS_DO0 = WS_XB, WS_DO1 = WS_XB + 12 * MiB, WS_DL = WS_XB + 24 * MiB, WS_DO2 = 236 * MiB, WS_TOTAL = 248 * MiB;
constexpr int TAB_COS = 0, TAB_SIN = 32768;
constexpr int TAB_BD = 65536;
constexpr int TAB_BL = TAB_BD + 2 * 4 * 4096;
constexpr int TAB_SC = TAB_BL + 2 * 6 * 4096;
static_assert((TAB_SC + 64) * 4 <= (int)MiB, "tables");
constexpr int CW_BAR = 4096;

constexpr int RING_BYTES = 131072, XS_OFF = 155648, XS_BYTES = 4096, MISC_OFF = 159744, LDS_BYTES = 163840;

#define GAS __attribute__((address_space(1)))
#define LAS __attribute__((address_space(3)))
typedef unsigned short bf16;
typedef unsigned v4u __attribute__((ext_vector_type(4)));
typedef float f32x4 __attribute__((ext_vector_type(4)));
typedef GAS unsigned gu32;
#define RLX_AGENT __ATOMIC_RELAXED, __HIP_MEMORY_SCOPE_AGENT
#define LDS_WAIT() asm volatile("s_waitcnt lgkmcnt(0)" ::: "memory")
__device__ __forceinline__ unsigned f2bf(float f) { unsigned u = __builtin_bit_cast(unsigned, f); return (u + 0x7fffu + ((u >> 16) & 1u)) >> 16; }
__device__ __forceinline__ unsigned pk2(float lo, float hi) { return f2bf(lo) | (f2bf(hi) << 16); }
__device__ __forceinline__ float bflo(unsigned w) { return __builtin_bit_cast(float, w << 16); }
__device__ __forceinline__ float bfhi(unsigned w) { return __builtin_bit_cast(float, w & 0xffff0000u); }
__device__ __forceinline__ void unpack8(v4u w, float* o) { o[0] = bflo(w.x); o[1] = bfhi(w.x); o[2] = bflo(w.y); o[3] = bfhi(w.y); o[4] = bflo(w.z); o[5] = bfhi(w.z); o[6] = bflo(w.w); o[7] = bfhi(w.w); }

#define XB_TMO      128
#define XB_XCNT(j)  (256  + 64 * (j))
#define XB_XSUB(j)  (1280 + 64 * (j))
#define XB_XGEN(j)  (2304 + 64 * (j))
#define XB_TOP      3328
#define XB_TOPGEN   3392
#define XCD_BAR_WORDS 3456
#define XB_SPIN_CAP (1u << 22)

__device__ __forceinline__ unsigned xb_ld(unsigned* p)              { return __hip_atomic_load(p, __ATOMIC_RELAXED, __HIP_MEMORY_SCOPE_AGENT); }
__device__ __forceinline__ unsigned xb_add(unsigned* p, unsigned v) { return __hip_atomic_fetch_add(p, v, __ATOMIC_RELAXED, __HIP_MEMORY_SCOPE_AGENT); }
__device__ __forceinline__ unsigned xb_xcc_id() { return (unsigned)__builtin_amdgcn_s_getreg((3 << 11) | 20) & 0xFu; }
#define XB_SPIN(cond, bar) do { unsigned _sp = 0; while (cond) { __builtin_amdgcn_s_sleep(1); \
    if ((++_sp & 255u) == 0u) { if (xb_ld(&(bar)[XB_TMO])) break; if (_sp > XB_SPIN_CAP) { atomicAdd(&(bar)[XB_TMO], 1u); break; } } } } while (0)

__device__ __forceinline__ void xcd_barrier_post(unsigned* bar, volatile LAS unsigned* st, bool tid0) {
    if (tid0) { const unsigned x = xb_xcc_id(); st[2] = x; (void)xb_add(&bar[XB_XCNT(x)], 1u); }
}
__device__ __forceinline__ void xcd_barrier_complete(unsigned* bar, unsigned x, unsigned& nloc, unsigned& nx) {
    const unsigned G = gridDim.x * gridDim.y * gridDim.z;
    unsigned sum, cnt, mine, sp = 0u;
    for (;;) {
        sum = 0u; cnt = 0u; mine = 0u;
        for (unsigned j = 0; j < 16; ++j) { const unsigned c = xb_ld(&bar[XB_XCNT(j)]); sum += c; cnt += (c > 0u) ? 1u : 0u; mine = (j == x) ? c : mine; }
        if (sum == G) break;
        __builtin_amdgcn_s_sleep(1);
        if ((++sp & 255u) == 0u) { if (xb_ld(&bar[XB_TMO])) break; if (sp > XB_SPIN_CAP) { atomicAdd(&bar[XB_TMO], 1u); break; } }
    }
    nloc = mine > 0u ? mine : 1u; nx = cnt > 0u ? cnt : 1u;
}
__device__ __forceinline__ void xcd_barrier(unsigned* bar0, volatile LAS unsigned* st, bool tid0) {
    asm volatile("s_waitcnt vmcnt(0)" ::: "memory");
    __syncthreads();
    if (tid0) {
        unsigned* bar = bar0; asm volatile("" : "+v"(bar));
        __builtin_amdgcn_s_waitcnt(0);
        unsigned nloc = st[0], nx = st[1]; const unsigned x = st[2];
        if (nloc == 0u) { xcd_barrier_complete(bar, x, nloc, nx); st[0] = nloc; st[1] = nx; }
#if MK_EARLY_WB
        __builtin_amdgcn_fence(__ATOMIC_RELEASE, "agent");
        asm volatile("s_waitcnt vmcnt(0)" ::: "memory");
#endif
        const unsigned old = xb_add(&bar[XB_XSUB(x)], 1u);
        const unsigned gen = old / nloc;
        if (old + 1u == (gen + 1u) * nloc) {
            __builtin_amdgcn_fence(__ATOMIC_RELEASE, "agent");
            asm volatile("s_waitcnt vmcnt(0)" ::: "memory");
            const unsigned og = xb_add(&bar[XB_TOP], 1u);
            const unsigned tg = og / nx;
            if (og + 1u == (tg + 1u) * nx) xb_add(&bar[XB_TOPGEN], 1u);
            else XB_SPIN(xb_ld(&bar[XB_TOPGEN]) == tg, bar);
            __builtin_amdgcn_fence(__ATOMIC_ACQUIRE, "agent");
            xb_add(&bar[XB_XGEN(x)], 1u);
            asm volatile("s_waitcnt vmcnt(0)" ::: "memory");
        } else {
            XB_SPIN(xb_ld(&bar[XB_XGEN(x)]) == gen, bar);
            __builtin_amdgcn_fence(__ATOMIC_ACQUIRE, "agent");
            asm volatile("s_waitcnt vmcnt(0)" ::: "memory");
        }
    }
    __syncthreads();
}

struct Args { const float* in[25]; float* out; unsigned char* ws; int layer, pad; };
enum { I_X = 0, I_RELB, I_F1N, I_F1G, I_F1U, I_F1D, I_MIXN, I_WIN, I_DQN, I_DKN, I_DLAM, I_DSUB, I_LQN, I_LKN, I_MQN, I_MQU, I_MKVN, I_MKVU, I_MQNG, I_MKNG, I_WO, I_F2N, I_F2G, I_F2U, I_F2D };

__device__ __forceinline__ float wave_sum(float v) { v += swz<1>(v); v += swz<2>(v); v += swz<4>(v); v += swz<8>(v); v += swz<16>(v); return sum_x32(v); }
__device__ __forceinline__ float wave_max(float v) { v = fmaxf(v, swz<1>(v)); v = fmaxf(v, swz<2>(v)); v = fmaxf(v, swz<4>(v)); v = fmaxf(v, swz<8>(v)); v = fmaxf(v, swz<16>(v)); return max_x32(v); }

__device__ __forceinline__ const void* lds_ptr_get(volatile LAS unsigned long long* PT, int i) {
    const unsigned long long v = PT[i];
    const unsigned lo = __builtin_amdgcn_readfirstlane((unsigned)v), hi = __builtin_amdgcn_readfirstlane((unsigned)(v >> 32));
    return (const void*)(((unsigned long long)hi << 32) | lo);
}
#define AIN(i) ((const float*)lds_ptr_get(PT, (i)))
__device__ __forceinline__ void tr_item64(const float* W, int Nsrc, int ks0, const float* gain, int sc, bool valid, bf16* dstrow) {
    float v[64];
    const float* src = W + (size_t)ks0 * Nsrc + sc;
#pragma unroll
    for (int i = 0; i < 64; ++i) v[i] = valid ? src[(size_t)i * Nsrc] : 0.f;
    if (gain) {
#pragma unroll
        for (int i = 0; i < 64; ++i) v[i] *= gain[ks0 + i];
    }
#pragma unroll
    for (int j = 0; j < 8; ++j) { v4u o; o.x = pk2(v[8 * j], v[8 * j + 1]); o.y = pk2(v[8 * j + 2], v[8 * j + 3]); o.z = pk2(v[8 * j + 4], v[8 * j + 5]); o.w = pk2(v[8 * j + 6], v[8 * j + 7]);
        *(GAS v4u*)(dstrow + 8 * j) = o; }
}

__device__ __forceinline__ void win_map(int g, int& sc, int& nvalid) {
    const int pn = g >> 3, gi = g & 7, bj = gi >> 2, wc = gi & 3; nvalid = 32;
    switch (pn) {
        case 0: sc = 0 + wc * 64 + bj * 32; break;
        case 1: sc = 256 + wc * 64 + bj * 32; break;
        case 2: sc = 512 + wc * 64 + bj * 32; break;
        case 3: sc = 768 + wc * 64 + bj * 32; break;
        case 4: sc = (wc < 2) ? 768 + (4 + wc) * 64 + bj * 32 : 1152 + (wc - 2) * 64 + bj * 32; break;
        case 5: sc = 1152 + (wc + 2) * 64 + bj * 32; break;
        case 6: sc = 1536 + wc * 64 + bj * 32; break;
        case 7: sc = (wc < 2) ? 1536 + (4 + wc) * 64 + bj * 32 : 2176 + (wc - 2) * 64 + bj * 32; break;
        case 8: sc = 1920 + bj * 128 + wc * 32; break;
        default: sc = 2176 + 128 + bj * 16; nvalid = (wc == 0) ? 16 : 0; break;
    }
}

__device__ __forceinline__ void convert_weights(volatile LAS unsigned long long* PT, unsigned char* ws, int l, int sel, int gw, int NGW, int lane) {
    constexpr int I_GU = (5632 / 64) * 16, I_D = 16 * 44, I_IN = 40 * 16, I_O = 16 * 16, I_QU = 12 * 4, I_KVU = 12 * 4;
    constexpr int NITEMS = 2 * I_GU + 2 * I_D + I_IN + I_O + I_QU + I_KVU;
    const int lg = lane >> 5, li = lane & 31;
    for (int it = gw; it < NITEMS; it += NGW) {
        int r = it;
        if (r < 2 * I_GU) {
            const int f = r / I_GU; r -= f * I_GU; if (!((sel >> f) & 1)) continue; const int G2 = r >> 4, kb = r & 15, g = 2 * G2 + lg;
            const int pn = g >> 3, gi = g & 7, bj = gi >> 2, wc = gi & 3;
            const float* Wg = AIN(f == 0 ? I_F1G : I_F2G) + (size_t)l * DM * DFF; const float* Wu = AIN(f == 0 ? I_F1U : I_F2U) + (size_t)l * DM * DFF;
            const float* gain = AIN(f == 0 ? I_F1N : I_F2N) + l * DM;
            bf16* dst = (bf16*)(ws + (f == 0 ? W_GU1 : W_GU2)) + (size_t)(32 * g + li) * DM + 64 * kb;
            tr_item64(bj == 0 ? Wg : Wu, DFF, 64 * kb, gain, pn * 128 + wc * 32 + li, true, dst); continue;
        }
        r -= 2 * I_GU;
        if (r < 2 * I_D) {
            const int f = r / I_D; r -= f * I_D; if (!((sel >> (2 + f)) & 1)) continue; const int G2 = r / 44, kb = r - G2 * 44;
            const float* W = AIN(f == 0 ? I_F1D : I_F2D) + (size_t)l * DFF * DM;
            bf16* dst = (bf16*)(ws + (f == 0 ? W_D1 : W_D2)) + (size_t)(64 * G2 + lane) * DFF + 64 * kb;
            tr_item64(W, DM, 64 * kb, nullptr, 64 * G2 + lane, true, dst); continue;
        }
        r -= 2 * I_D;
        if (r < I_IN) {
            if (!(sel & 16)) continue;
            const int G2 = r >> 4, kb = r & 15, g = 2 * G2 + lg; int sc, nv; win_map(g, sc, nv);
            const float* W = AIN(I_WIN) + (size_t)l * DM * IN_W;
            bf16* dst = (bf16*)(ws + W_IN) + (size_t)(32 * g + li) * DM + 64 * kb;
            tr_item64(W, IN_W, 64 * kb, AIN(I_MIXN) + l * DM, sc + li, li < nv, dst); continue;
        }
        r -= I_IN;
        if (r < I_O) {
            if (!(sel & 32)) continue;
            const int G2 = r >> 4, kb = r & 15;
            bf16* dst = (bf16*)(ws + W_O) + (size_t)(64 * G2 + lane) * DM + 64 * kb;
            tr_item64(AIN(I_WO) + (size_t)l * DM * DM, DM, 64 * kb, nullptr, 64 * G2 + lane, true, dst); continue;
        }
        r -= I_O;
        if (r < I_QU) {
            if (!(sel & 64)) continue;
            const int G2 = r >> 2, kb = r & 3, g = 2 * G2 + lg; const int pn = g >> 3, gi = g & 7, bj = gi >> 2, wc = gi & 3, head = pn * 2 + (wc >> 1);
            const int sc = (wc & 1) ? head * 96 + 64 + 16 * bj : head * 96 + 32 * bj, nv = (wc & 1) ? 16 : 32;
            bf16* dst = (bf16*)(ws + W_QU) + (size_t)(32 * g + li) * 256 + 64 * kb;
            tr_item64(AIN(I_MQU) + (size_t)l * 256 * 576, 576, 64 * kb, AIN(I_MQN) + l * 256, sc + li, li < nv, dst); continue;
        }
        r -= I_QU;
        {
            if (!(sel & 128)) continue;
            const int G2 = r >> 2, kb = r & 3, g = 2 * G2 + lg; const int pn = g >> 3, gi = g & 7, bj = gi >> 2, wc = gi & 3, head = pn * 2 + (wc >> 1);
            const int sc = head * 128 + ((wc & 1) ? 64 : 0) + 32 * bj;
            bf16* dst = (bf16*)(ws + W_KVU) + (size_t)(32 * g + li) * 256 + 64 * kb;
            if (kb < 2) tr_item64(AIN(I_MKVU), 768, 0, nullptr, 0, false, dst);
            else tr_item64(AIN(I_MKVU) + (size_t)l * 128 * 768, 768, 64 * (kb - 2), AIN(I_MKVN) + l * 128, sc + li, true, dst);
        }
    }
}

__device__ __forceinline__ int t5_bucket(int rel) {
    const int n = rel < 0 ? -rel : rel;
    const float nf = (float)(n > 1 ? n : 1);
    int large = 8 + (int)(logf(nf / 8.0f) / 4.852030263919617f * 8.0f);
    large = large < 15 ? large : 15;
    return (rel > 0 ? 16 : 0) + (n < 8 ? n : large);
}

__device__ __forceinline__ void prologue_misc(volatile LAS unsigned long long* PT, unsigned char* ws, int gw, int NGW, int lane, int gtid, int NGT) {
    float* tab = (float*)(ws + WS_TAB);
    for (int i = gtid; i < SEQ * 16; i += NGT) { const int s = i >> 4, j = i & 15; const double inv = pow(10000.0, -(double)j / 16.0), ang = (double)s * inv; tab[TAB_COS + i] = (float)cos(ang); tab[TAB_SIN + i] = (float)sin(ang); }
    for (int l = 0; l < DEPTH; ++l) {
        const float* relb = AIN(I_RELB);
        float mbd = 0.f, mbl = 0.f;
        for (int i = lane; i < 320; i += 64) { const float v = fabsf(relb[i]); if ((i % 10) < 4) mbd = fmaxf(mbd, v); else mbl = fmaxf(mbl, v); }
        mbd = wave_max(mbd); mbl = wave_max(mbl);
        float gq = (lane < 32) ? fabsf(AIN(I_DQN)[l * 32 + lane]) : 0.f, gk = (lane < 32) ? fabsf(AIN(I_DKN)[l * 32 + lane]) : 0.f;
        gq = wave_max(gq); gk = wave_max(gk);
        const float B2d = (5.656854249f * gq * gk + mbd) * LOG2E;
        float lq = fabsf(AIN(I_LQN)[l * 64 + lane]), lk = fabsf(AIN(I_LKN)[l * 64 + lane]);
        lq = wave_max(lq); lk = wave_max(lk);
        const float B2l = (8.0f * lq * lk + mbl) * LOG2E;
        float mq = fmaxf(fabsf(AIN(I_MQNG)[l * 96 + lane]), lane < 32 ? fabsf(AIN(I_MQNG)[l * 96 + 64 + lane]) : 0.f);
        float mk = fmaxf(fabsf(AIN(I_MKNG)[l * 96 + lane]), lane < 32 ? fabsf(AIN(I_MKNG)[l * 96 + 64 + lane]) : 0.f);
        mq = wave_max(mq); mk = wave_max(mk);
        const float B2c = 9.797958971f * mq * mk * LOG2E;
        for (int i = gtid; i < 10 * 4096; i += NGT) {
            const int h = i >> 12, idx = i & 4095, rel = idx - 2048; const int bk = t5_bucket(rel);
            if (h < 4) tab[TAB_BD + (l * 4 + h) * 4096 + idx] = relb[bk * 10 + h] * LOG2E - B2d;
            else tab[TAB_BL + (l * 6 + (h - 4)) * 4096 + idx] = relb[bk * 10 + h] * LOG2E - B2l;
        }
        if (gw == 0) {
            const float* lp = AIN(I_DLAM) + l * 128;
            float s1 = (lane < 32) ? lp[lane] * lp[32 + lane] : 0.f, s2 = (lane < 32) ? lp[64 + lane] * lp[96 + lane] : 0.f;
            s1 = wave_sum(s1); s2 = wave_sum(s2);
            const float linit = 0.8f - 0.6f * expf(-0.3f * (float)(l + 1));
            if (lane == 0) { tab[TAB_SC + l * 8 + 0] = expf(s1) - expf(s2) + linit; tab[TAB_SC + l * 8 + 1] = 1.0f - linit; tab[TAB_SC + l * 8 + 2] = -B2c; }
        }
    }
    float* P0 = (float*)(ws + WS_P);
    for (int m = gw; m < MTOK; m += NGW) {
        const GAS f32x4* xr = (const GAS f32x4*)(AIN(I_X) + (size_t)m * DM) + lane;
        GAS unsigned long long* o8 = (GAS unsigned long long*)((bf16*)(ws + WS_XB) + (size_t)m * DM) + lane;
        float s = 0.f;
#pragma unroll
        for (int j = 0; j < 4; ++j) { const f32x4 v = xr[64 * j]; s += (v.x * v.x + v.y * v.y) + (v.z * v.z + v.w * v.w);
            o8[64 * j] = (unsigned long long)pk2(v.x, v.y) | ((unsigned long long)pk2(v.z, v.w) << 32); }
        s = wave_sum(s);
        if (lane < 16) P0[(size_t)m * 16 + lane] = lane == 0 ? s : 0.f;
    }
}

namespace att {
typedef short bf16x8 __attribute__((ext_vector_type(8)));
typedef short s16x4 __attribute__((ext_vector_type(4)));
typedef short v4i16_t __attribute__((ext_vector_type(4)));
typedef float f32x16 __attribute__((ext_vector_type(16)));
typedef unsigned u32x4 __attribute__((ext_vector_type(4)));
typedef __attribute__((address_space(3))) const char* lds_cptr;
typedef __attribute__((address_space(3))) char* lds_ptr;
typedef float f32x2_t __attribute__((ext_vector_type(2))); typedef __bf16 bf16x2_t __attribute__((ext_vector_type(2)));
__device__ __forceinline__ int crow(int r, int hi) { return (r & 3) + 8 * (r >> 2) + 4 * hi; }
__device__ __forceinline__ void glds16(const void* gsrc, unsigned lds_dst) { unsigned keep;
    asm volatile("s_mov_b32 %0, m0\n\ts_mov_b32 m0, %2\n\ts_nop 0\n\tglobal_load_lds_dwordx4 %1, off\n\ts_mov_b32 m0, %0" : "=&s"(keep) : "v"(gsrc), "s"(lds_dst) : "memory"); }
__device__ __forceinline__ unsigned cvtpk_s(float lo, float hi) { f32x2_t v = {lo, hi}; bf16x2_t b = __builtin_convertvector(v, bf16x2_t); return __builtin_bit_cast(unsigned, b); }
__device__ __forceinline__ s16x4 vtr(lds_cptr p) { return __builtin_bit_cast(s16x4, __builtin_amdgcn_ds_read_tr16_b64_v4i16((__attribute__((address_space(3))) v4i16_t*)p)); }
#define ATT_WAIT_BAR(N) asm volatile("s_waitcnt vmcnt(" #N ") lgkmcnt(0)\n\ts_barrier" ::: "memory")
#define ATT_BAR() asm volatile("s_waitcnt lgkmcnt(0)\n\ts_barrier" ::: "memory")

__device__ __forceinline__ void pack_p(const f32x16& p0, const f32x16& p1, bf16x8 (&pa)[4]) {
    u32x4 w;
    w = (u32x4){cvtpk_s(p0[0], p0[1]), cvtpk_s(p0[2], p0[3]), cvtpk_s(p0[4], p0[5]), cvtpk_s(p0[6], p0[7])}; pa[0] = __builtin_bit_cast(bf16x8, w);
    w = (u32x4){cvtpk_s(p0[8], p0[9]), cvtpk_s(p0[10], p0[11]), cvtpk_s(p0[12], p0[13]), cvtpk_s(p0[14], p0[15])}; pa[1] = __builtin_bit_cast(bf16x8, w);
    w = (u32x4){cvtpk_s(p1[0], p1[1]), cvtpk_s(p1[2], p1[3]), cvtpk_s(p1[4], p1[5]), cvtpk_s(p1[6], p1[7])}; pa[2] = __builtin_bit_cast(bf16x8, w);
    w = (u32x4){cvtpk_s(p1[8], p1[9]), cvtpk_s(p1[10], p1[11]), cvtpk_s(p1[12], p1[13]), cvtpk_s(p1[14], p1[15])}; pa[3] = __builtin_bit_cast(bf16x8, w);
}
__device__ __forceinline__ void pv64(f32x16& o0, f32x16& o1, lds_cptr vp, const bf16x8 (&pa)[4]) {
#pragma unroll
    for (int ks = 0; ks < 4; ++ks) {
        const s16x4 a = vtr(vp + ks * 1024), b = vtr(vp + ks * 1024 + 512);
        const bf16x8 v = {a[0], a[1], a[2], a[3], b[0], b[1], b[2], b[3]};
        o0 = __builtin_amdgcn_mfma_f32_32x32x16_bf16(pa[ks], v, o0, 0, 0, 0);
    }
#pragma unroll
    for (int ks = 0; ks < 4; ++ks) {
        const s16x4 a = vtr(vp + 4096 + ks * 1024), b = vtr(vp + 4096 + ks * 1024 + 512);
        const bf16x8 v = {a[0], a[1], a[2], a[3], b[0], b[1], b[2], b[3]};
        o1 = __builtin_amdgcn_mfma_f32_32x32x16_bf16(pa[ks], v, o1, 0, 0, 0);
    }
}
__device__ __forceinline__ void pv32(f32x16& o0, f32x16& o1, lds_cptr vp, const bf16x8& pa0, const bf16x8& pa1) {
#pragma unroll
    for (int d0 = 0; d0 < 2; ++d0) {
        const s16x4 a = vtr(vp + d0 * 4096), b = vtr(vp + d0 * 4096 + 512), c = vtr(vp + d0 * 4096 + 1024), d = vtr(vp + d0 * 4096 + 1536);
        const bf16x8 v0 = {a[0], a[1], a[2], a[3], b[0], b[1], b[2], b[3]}, v1 = {c[0], c[1], c[2], c[3], d[0], d[1], d[2], d[3]};
        if (d0 == 0) { o0 = __builtin_amdgcn_mfma_f32_32x32x16_bf16(pa0, v0, o0, 0, 0, 0); o0 = __builtin_amdgcn_mfma_f32_32x32x16_bf16(pa1, v1, o0, 0, 0, 0); }
        else { o1 = __builtin_amdgcn_mfma_f32_32x32x16_bf16(pa0, v0, o1, 0, 0, 0); o1 = __builtin_amdgcn_mfma_f32_32x32x16_bf16(pa1, v1, o1, 0, 0, 0); }
    }
}
__device__ __forceinline__ float exp_sum1(f32x16& p) {
    float s0 = 0.f, s1 = 0.f;
#pragma unroll
    for (int r = 0; r < 16; r += 2) { p[r] = __builtin_amdgcn_exp2f(p[r]); p[r + 1] = __builtin_amdgcn_exp2f(p[r + 1]); s0 += p[r]; s1 += p[r + 1]; }
    return s0 + s1;
}
__device__ __forceinline__ void pack_p1(const f32x16& p, bf16x8& pa0, bf16x8& pa1) {
    u32x4 w;
    w = (u32x4){cvtpk_s(p[0], p[1]), cvtpk_s(p[2], p[3]), cvtpk_s(p[4], p[5]), cvtpk_s(p[6], p[7])}; pa0 = __builtin_bit_cast(bf16x8, w);
    w = (u32x4){cvtpk_s(p[8], p[9]), cvtpk_s(p[10], p[11]), cvtpk_s(p[12], p[13]), cvtpk_s(p[14], p[15])}; pa1 = __builtin_bit_cast(bf16x8, w);
}
__device__ __forceinline__ float exp_sum(f32x16& p0, f32x16& p1) {
    float s0 = 0.f, s1 = 0.f;
#pragma unroll
    for (int r = 0; r < 16; ++r) { p0[r] = __builtin_amdgcn_exp2f(p0[r]); p1[r] = __builtin_amdgcn_exp2f(p1[r]); s0 += p0[r]; s1 += p1[r]; }
    return s0 + s1;
}
__device__ __forceinline__ float half_swap_sum(float v) {
    return sum_x32(v);
}

constexpr int DN_RING = 40960, DN_BUF = 20480, DN_TAB = 81920, DN_WSF = 98304, DN_OST = 100352;
constexpr int ML_RING = 61440, ML_WSF = 122880, ML_OST = 124928;

__device__ __forceinline__ void store_o64(const f32x16& o0, const f32x16& o1, const float (&sc)[16], lds_ptr stg, bf16* orow0, int pitch, int lane) {
    asm volatile("" : "+v"(lane));
    const int r32 = lane & 31, hi = lane >> 5;
    __attribute__((address_space(3))) unsigned short* s = (__attribute__((address_space(3))) unsigned short*)stg;
#pragma unroll
    for (int r = 0; r < 16; ++r) { const int orow = crow(r, hi);
        s[orow * 64 + r32] = (unsigned short)f2bf(o0[r] * sc[r]); s[orow * 64 + 32 + r32] = (unsigned short)f2bf(o1[r] * sc[r]); }
    asm volatile("s_waitcnt lgkmcnt(0)" ::: "memory");
#pragma unroll
    for (int i = 0; i < 4; ++i) { const int row = i * 8 + (lane >> 3), ch = lane & 7;
        const u32x4 v = *(const __attribute__((address_space(3))) u32x4*)(stg + row * 128 + ch * 16); *(u32x4*)(orow0 + (size_t)row * pitch + ch * 8) = v; }
}

__device__ __forceinline__ void mla_unit(const unsigned char* ws, const int tid, int l, int u, char* shm) {
    const int lane = tid & 63, r32 = lane & 31, hi = lane >> 5, wid = __builtin_amdgcn_readfirstlane(tid >> 6), w4 = wid & 3, g = wid >> 2;
    const int bh = u >> 4, q0 = (u & 15) * 128 + w4 * 32;
    const bf16* Qb = (const bf16*)(ws + WS_QC) + ((size_t)bh * SEQ + q0) * 96;
    const bf16* Kb = (const bf16*)(ws + WS_KC) + ((size_t)bh * SEQ + g * 1024) * 96;
    const bf16* Vb = (const bf16*)(ws + WS_VC) + ((size_t)bh * SEQ + g * 1024) * 64;
    const float nb2 = ((const float*)(ws + WS_TAB))[TAB_SC + l * 8 + 2];
    const unsigned lds0 = (unsigned)(uintptr_t)shm; const lds_cptr shm3 = (lds_cptr)shm;
    const unsigned ring = lds0 + g * ML_RING;
    int koffs[3];
#pragma unroll
    for (int i = 0; i < 3; ++i) { const int idx = 64 * (w4 + 4 * i) + lane, row = idx / 12, slot = idx - 12 * row; koffs[i] = row * 96 + ((slot & ~3) | ((slot & 3) ^ ((row >> 2) & 3))) * 8; }
    const bf16* vsrc = Vb + (size_t)(16 * w4 + (lane >> 2)) * 64 + (lane & 3) * 8;
#define MLA_DMA_K(t, buf) do { const unsigned d_ = (unsigned)__builtin_amdgcn_readfirstlane(ring + (buf) * DN_BUF + w4 * 1024); \
        const bf16* kt_ = Kb + (size_t)(t) * 64 * 96; glds16(kt_ + koffs[0], d_); glds16(kt_ + koffs[1], d_ + 4096); glds16(kt_ + koffs[2], d_ + 8192); } while (0)
#define MLA_DMA_V(t, buf) do { const unsigned d_ = (unsigned)__builtin_amdgcn_readfirstlane(ring + (buf) * DN_BUF + w4 * 1024); \
        glds16(vsrc + (size_t)(t) * 64 * 64, d_ + 12288); glds16(vsrc + (size_t)(t) * 64 * 64 + 32, d_ + 12288 + 4096); } while (0)
    if (g == 0) { MLA_DMA_K(0, 0); MLA_DMA_V(0, 0); MLA_DMA_K(1, 1); MLA_DMA_V(1, 1); } else { MLA_DMA_K(0, 0); MLA_DMA_K(1, 1); MLA_DMA_V(0, 0); }
    bf16x8 qr[6];
#pragma unroll
    for (int d0 = 0; d0 < 6; ++d0) qr[d0] = *(const bf16x8*)(Qb + (size_t)r32 * 96 + d0 * 16 + hi * 8);
    asm volatile("" : "+v"(qr[0]), "+v"(qr[1]), "+v"(qr[2]), "+v"(qr[3]), "+v"(qr[4]), "+v"(qr[5]));
    f32x16 o0 = {}, o1 = {}; float lsum = 0.f;
    const int kx = (r32 >> 2) & 3;
    const lds_cptr kpe0 = shm3 + g * ML_RING + r32 * 192 + ((hi ^ kx) << 4), kpe1 = shm3 + g * ML_RING + r32 * 192 + (((2 + hi) ^ kx) << 4);
    const lds_cptr vp0 = shm3 + g * ML_RING + 12288 + ((lane >> 4) & 1) * 32 + (lane & 3) * 8 + (4 * hi + ((lane & 15) >> 2)) * 64;
#define MLA_QK(P0, P1, buf) do { \
        _Pragma("unroll") for (int r = 0; r < 16; ++r) { P0[r] = nb2; P1[r] = nb2; } \
        _Pragma("unroll") for (int d0 = 0; d0 < 6; ++d0) { const lds_cptr kp = ((d0 & 1) ? kpe1 : kpe0) + (buf) * DN_BUF + (d0 >> 1) * 64; \
            const bf16x8 a0 = *(const __attribute__((address_space(3))) bf16x8*)(kp), a1 = *(const __attribute__((address_space(3))) bf16x8*)(kp + 6144); \
            P0 = __builtin_amdgcn_mfma_f32_32x32x16_bf16(a0, qr[d0], P0, 0, 0, 0); P1 = __builtin_amdgcn_mfma_f32_32x32x16_bf16(a1, qr[d0], P1, 0, 0, 0); } } while (0)
#define MLA_SMPV(P0, P1, buf) do { lsum += exp_sum(P0, P1); bf16x8 pa[4]; pack_p(P0, P1, pa); pv64(o0, o1, vp0 + (buf) * DN_BUF, pa); } while (0)
    if (g == 0) {
        int b0 = 0, b2 = 2;
        for (int t = 0; t < 16; ++t) {
            ATT_WAIT_BAR(5);
            { const int tn = t + 2 < 16 ? t + 2 : 15; MLA_DMA_K(tn, b2); MLA_DMA_V(tn, b2); }
            f32x16 p0, p1;
            MLA_QK(p0, p1, b0);
            MLA_SMPV(p0, p1, b0);
            b0 = b0 == 2 ? 0 : b0 + 1; b2 = b2 == 2 ? 0 : b2 + 1;
        }
        ATT_WAIT_BAR(0);
    } else {
        f32x16 p0, p1;
        ATT_WAIT_BAR(5);
        MLA_DMA_K(2, 2); MLA_DMA_V(1, 1);
        MLA_QK(p0, p1, 0);
        int bk = 1, bk2 = 0, bv = 0, bv1 = 2;
        for (int t = 1; t < 16; ++t) {
            ATT_WAIT_BAR(5);
            { const int kn = t + 2 < 16 ? t + 2 : 15, vn = t + 1 < 16 ? t + 1 : 15; MLA_DMA_K(kn, bk2); MLA_DMA_V(vn, bv1); }
            MLA_SMPV(p0, p1, bv);
            MLA_QK(p0, p1, bk);
            bk = bk == 2 ? 0 : bk + 1; bk2 = bk2 == 2 ? 0 : bk2 + 1; bv = bv == 2 ? 0 : bv + 1; bv1 = bv1 == 2 ? 0 : bv1 + 1;
        }
        ATT_WAIT_BAR(0);
        MLA_SMPV(p0, p1, bv);
    }
    ATT_WAIT_BAR(0);
#undef MLA_QK
#undef MLA_SMPV
#undef MLA_DMA_K
#undef MLA_DMA_V
#define MLA_DMA(t, buf) do {} while (0)
#undef MLA_DMA
    int lane_t = lane; asm volatile("" : "+v"(lane_t));
    const int r32t = lane_t & 31, hit = lane_t >> 5;
    __attribute__((address_space(3))) float* Cs = (__attribute__((address_space(3))) float*)shm3;
    if (g == 1) {
#pragma unroll
        for (int r = 0; r < 16; ++r) { Cs[(w4 * 33 + r) * 64 + lane_t] = o0[r]; Cs[(w4 * 33 + 16 + r) * 64 + lane_t] = o1[r]; }
        Cs[(w4 * 33 + 32) * 64 + lane_t] = lsum;
    }
    ATT_BAR();
    if (g == 0) {
#pragma unroll
        for (int r = 0; r < 16; ++r) { o0[r] += Cs[(w4 * 33 + r) * 64 + lane_t]; o1[r] += Cs[(w4 * 33 + 16 + r) * 64 + lane_t]; }
        lsum += Cs[(w4 * 33 + 32) * 64 + lane_t];
        lsum = half_swap_sum(lsum);
        __attribute__((address_space(3))) float* wsf = (__attribute__((address_space(3))) float*)(shm3 + ML_WSF) + wid * 64;
        if (hit == 0) wsf[r32t] = __builtin_amdgcn_rcpf(lsum);
        asm volatile("s_waitcnt lgkmcnt(0)" ::: "memory");
        float sc[16];
#pragma unroll
        for (int r = 0; r < 16; ++r) sc[r] = wsf[crow(r, hit)];
        const int b = bh / 6, h = bh - b * 6;
        store_o64(o0, o1, sc, (lds_ptr)(shm3 + ML_OST + w4 * 4096), (bf16*)(ws + WS_MIX) + ((size_t)(b * SEQ + q0)) * DM + 640 + h * 64, DM, lane_t);
    }
    ATT_BAR();
}

__device__ __forceinline__ void diff_unit(const unsigned char* ws, const float* sub, const int tid, int l, int u, char* shm) {
    const int lane = tid & 63, r32 = lane & 31, hi = lane >> 5, wid = __builtin_amdgcn_readfirstlane(tid >> 6), w4 = wid & 3, g = wid >> 2;
    const int bh = u >> 4, q0 = (u & 15) * 128 + w4 * 32, b = bh >> 2, h = bh & 3;
    const bf16* Q0 = (const bf16*)(ws + WS_QD) + ((size_t)(bh * 2) * SEQ + q0) * 32;
    const bf16* K0 = (const bf16*)(ws + WS_KD) + ((size_t)(bh * 2) * SEQ + g * 1024) * 32;
    const bf16* Vb = (const bf16*)(ws + WS_VD) + ((size_t)bh * SEQ + g * 1024) * 64;
    const float* tabg = (const float*)(ws + WS_TAB) + TAB_BD + (l * 4 + h) * 4096;
    const unsigned lds0 = (unsigned)(uintptr_t)shm; const lds_cptr shm3 = (lds_cptr)shm;
    const unsigned ring = lds0 + g * DN_RING;
    const bf16* ksrc = K0 + (size_t)(16 * w4 + (lane >> 2)) * 32 + (((lane & 3) ^ ((lane >> 4) & 3)) * 8);
    const bf16* vsrc = Vb + (size_t)(16 * w4 + (lane >> 2)) * 64 + (lane & 3) * 8;
#define DIFF_KOFF(t) (g == 0 ? ((t) & 1) * DN_BUF : ((t) & 1) * 8192)
#define DIFF_VOFF(t) (g == 0 ? ((t) & 1) * DN_BUF + 8192 : 16384 + ((t) % 3) * 8192)
#define DIFF_DMA_K(t) do { const unsigned d_ = (unsigned)__builtin_amdgcn_readfirstlane(ring + DIFF_KOFF(t) + w4 * 1024); \
        glds16(ksrc + (size_t)(t) * 64 * 32, d_); glds16(ksrc + (size_t)SEQ * 32 + (size_t)(t) * 64 * 32, d_ + 4096); } while (0)
#define DIFF_DMA_V(t) do { const unsigned d_ = (unsigned)__builtin_amdgcn_readfirstlane(ring + DIFF_VOFF(t) + w4 * 1024); \
        glds16(vsrc + (size_t)(t) * 64 * 64, d_); glds16(vsrc + (size_t)(t) * 64 * 64 + 32, d_ + 4096); } while (0)
    DIFF_DMA_K(0); DIFF_DMA_V(0);
    { __attribute__((address_space(3))) float* tl = (__attribute__((address_space(3))) float*)(shm3 + DN_TAB);
#pragma unroll
      for (int i = 0; i < 2; ++i) { const f32x4 v = *(const f32x4*)(tabg + (i * 512 + tid) * 4); *(__attribute__((address_space(3))) f32x4*)(tl + (i * 512 + tid) * 4) = v; } }
    bf16x8 qr[2][2];
#pragma unroll
    for (int c = 0; c < 2; ++c)
#pragma unroll
        for (int d0 = 0; d0 < 2; ++d0) qr[c][d0] = *(const bf16x8*)(Q0 + (size_t)c * SEQ * 32 + (size_t)r32 * 32 + d0 * 16 + hi * 8);
    asm volatile("" : "+v"(qr[0][0]), "+v"(qr[0][1]), "+v"(qr[1][0]), "+v"(qr[1][1]));
    f32x16 oa0 = {}, oa1 = {}, ob0 = {}, ob1 = {}; float lsa = 0.f, lsb = 0.f;
    const int kx = (r32 >> 2) & 3;
    const lds_cptr kpe0 = shm3 + g * DN_RING + r32 * 64 + ((hi ^ kx) << 4), kpe1 = shm3 + g * DN_RING + r32 * 64 + (((2 + hi) ^ kx) << 4);
    const lds_cptr vp0 = shm3 + g * DN_RING + ((lane >> 4) & 1) * 32 + (lane & 3) * 8 + (4 * hi + ((lane & 15) >> 2)) * 64;
    const __attribute__((address_space(3))) float* tb0 = (const __attribute__((address_space(3))) float*)(shm3 + DN_TAB) + (2048 + g * 1024 - q0 + 4 * hi - r32);
#define DIFF_QK(S0, S1, t, blk) do { const __attribute__((address_space(3))) float* tb = tb0 + (t) * 64 + (blk) * 32; int koff_ = __builtin_amdgcn_readfirstlane(DIFF_KOFF(t) + (blk) * 2048); asm volatile("" : "+s"(koff_)); \
        _Pragma("unroll") for (int r = 0; r < 16; ++r) { S0[r] = tb[(r & 3) + 8 * (r >> 2)]; S1[r] = S0[r]; } \
        _Pragma("unroll") for (int d0 = 0; d0 < 2; ++d0) { \
            const lds_cptr kp = (d0 ? kpe1 : kpe0) + koff_; const bf16x8 a0 = *(const __attribute__((address_space(3))) bf16x8*)(kp), a1 = *(const __attribute__((address_space(3))) bf16x8*)(kp + 4096); \
            S0 = __builtin_amdgcn_mfma_f32_32x32x16_bf16(a0, qr[0][d0], S0, 0, 0, 0); S1 = __builtin_amdgcn_mfma_f32_32x32x16_bf16(a1, qr[1][d0], S1, 0, 0, 0); } __builtin_amdgcn_sched_barrier(0); } while (0)
#define DIFF_SMPV(S0, S1, t, blk) do { int voff_ = __builtin_amdgcn_readfirstlane(DIFF_VOFF(t) + (blk) * 2048); asm volatile("" : "+s"(voff_)); const lds_cptr vpb = vp0 + voff_; bf16x8 pa0, pa1; \
        lsa += exp_sum1(S0); pack_p1(S0, pa0, pa1); pv32(oa0, oa1, vpb, pa0, pa1); \
        __builtin_amdgcn_sched_barrier(0); lsb += exp_sum1(S1); pack_p1(S1, pa0, pa1); pv32(ob0, ob1, vpb, pa0, pa1); __builtin_amdgcn_sched_barrier(0); } while (0)
    if (g == 0) {
        for (int t = 0; t < 16; ++t) {
            ATT_WAIT_BAR(0);
            if (t + 1 < 16) { DIFF_DMA_K(t + 1); DIFF_DMA_V(t + 1); }
            f32x16 s0, s1;
            DIFF_QK(s0, s1, t, 0); DIFF_SMPV(s0, s1, t, 0);
            DIFF_QK(s0, s1, t, 1); DIFF_SMPV(s0, s1, t, 1);
        }
        ATT_WAIT_BAR(0);
    } else {
        f32x16 s0, s1, u0, u1;
        ATT_WAIT_BAR(0);
        DIFF_DMA_K(1); DIFF_DMA_V(1);
        DIFF_QK(s0, s1, 0, 0); DIFF_SMPV(s0, s1, 0, 0); DIFF_QK(u0, u1, 0, 1);
        for (int t = 1; t < 16; ++t) {
            ATT_WAIT_BAR(0);
            if (t + 1 < 16) { DIFF_DMA_K(t + 1); DIFF_DMA_V(t + 1); }
            DIFF_SMPV(u0, u1, t - 1, 1); DIFF_QK(s0, s1, t, 0);
            DIFF_SMPV(s0, s1, t, 0); DIFF_QK(u0, u1, t, 1);
        }
        ATT_WAIT_BAR(0);
        DIFF_SMPV(u0, u1, 15, 1);
    }
    ATT_WAIT_BAR(0);
#undef DIFF_QK
#undef DIFF_SMPV
#undef DIFF_DMA_K
#undef DIFF_DMA_V
#undef DIFF_KOFF
#undef DIFF_VOFF
#define DIFF_DMA(t, buf) do {} while (0)
#undef DIFF_DMA
    int lane_t = lane; asm volatile("" : "+v"(lane_t));
    const int r32t = lane_t & 31, hit = lane_t >> 5;
    __attribute__((address_space(3))) float* Cs = (__attribute__((address_space(3))) float*)shm3 + w4 * 66 * 64;
    if (g == 1) {
#pragma unroll
        for (int r = 0; r < 16; ++r) { Cs[r * 64 + lane_t] = oa0[r]; Cs[(16 + r) * 64 + lane_t] = oa1[r]; Cs[(32 + r) * 64 + lane_t] = ob0[r]; Cs[(48 + r) * 64 + lane_t] = ob1[r]; }
        Cs[64 * 64 + lane_t] = lsa; Cs[65 * 64 + lane_t] = lsb;
    }
    ATT_BAR();
    if (g == 0) {
#pragma unroll
        for (int r = 0; r < 16; ++r) { oa0[r] += Cs[r * 64 + lane_t]; oa1[r] += Cs[(16 + r) * 64 + lane_t]; ob0[r] += Cs[(32 + r) * 64 + lane_t]; ob1[r] += Cs[(48 + r) * 64 + lane_t]; }
        lsa += Cs[64 * 64 + lane_t]; lsb += Cs[65 * 64 + lane_t];
        lsa = half_swap_sum(lsa); lsb = half_swap_sum(lsb);
        const float* sc = (const float*)(ws + WS_TAB) + TAB_SC + l * 8; const float lam = sc[0], post = sc[1];
        __attribute__((address_space(3))) float* wsf = (__attribute__((address_space(3))) float*)(shm3 + DN_WSF) + wid * 64;
        if (hit == 0) { wsf[r32t] = __builtin_amdgcn_rcpf(lsa); wsf[32 + r32t] = lam * __builtin_amdgcn_rcpf(lsb); }
        asm volatile("s_waitcnt lgkmcnt(0)" ::: "memory");
        __attribute__((address_space(3))) float* As = Cs;
#pragma unroll
        for (int r = 0; r < 16; ++r) { const int q = crow(r, hit); const float s0 = wsf[q], s1 = wsf[32 + q];
            As[q * 65 + r32t] = oa0[r] * s0 - ob0[r] * s1; As[q * 65 + 32 + r32t] = oa1[r] * s0 - ob1[r] * s1; }
        asm volatile("s_waitcnt lgkmcnt(0)" ::: "memory");
        const int row = lane_t >> 1, hf = lane_t & 1;
        float v[32]; float ss = 0.f;
#pragma unroll
        for (int i = 0; i < 32; ++i) { v[i] = As[row * 65 + hf * 32 + i]; ss += v[i] * v[i]; }
        ss += swz<1>(ss);
        const float rn = __builtin_amdgcn_rsqf(ss * (1.0f / 64.0f) + EPS) * post;
        bf16* dst = (bf16*)(ws + WS_MIX) + ((size_t)(b * SEQ + q0 + row)) * DM + h * 64 + hf * 32;
#pragma unroll
        for (int i = 0; i < 4; ++i) { u32x4 w;
            w.x = cvtpk_s(v[8 * i] * rn * sub[hf * 32 + 8 * i], v[8 * i + 1] * rn * sub[hf * 32 + 8 * i + 1]); w.y = cvtpk_s(v[8 * i + 2] * rn * sub[hf * 32 + 8 * i + 2], v[8 * i + 3] * rn * sub[hf * 32 + 8 * i + 3]);
            w.z = cvtpk_s(v[8 * i + 4] * rn * sub[hf * 32 + 8 * i + 4], v[8 * i + 5] * rn * sub[hf * 32 + 8 * i + 5]); w.w = cvtpk_s(v[8 * i + 6] * rn * sub[hf * 32 + 8 * i + 6], v[8 * i + 7] * rn * sub[hf * 32 + 8 * i + 7]);
            *(u32x4*)(dst + 8 * i) = w; }
    }
    ATT_BAR();
}

__device__ __forceinline__ void dil_prefetch(const unsigned char* ws, const int tid, int bh, int br, int chunk, unsigned lds_dummy) {
    const int wid = __builtin_amdgcn_readfirstlane(tid >> 6);
    if (wid < 6) {
        const int s = wid, within = tid & 63, dsh = 2 * br, L = SEQ >> dsh;
        int res, k0;
        if (br == 2) { res = 2 * chunk + ((s >> 1) & 1); k0 = 64 * (s & 1); }
        else { res = br == 1 ? (chunk >> 1) : 0; k0 = (br == 1 ? 256 * (chunk & 1) : 256 * chunk) - 64 + 64 * s; }
        int ki = k0 + within; ki = ki < 0 ? 0 : (ki > L - 1 ? L - 1 : ki);
        const size_t off = ((size_t)bh * SEQ + res + ((size_t)ki << dsh)) * 64;
        const unsigned d_ = (unsigned)__builtin_amdgcn_readfirstlane(lds_dummy + wid * 1024);
        glds16((const bf16*)(ws + WS_KL) + off, d_); glds16((const bf16*)(ws + WS_VL) + off, d_);
    }
}

constexpr int DL_SLOT = 16384, DL_TAB = 98304, DL_WSF = 114688;
template <int DIL> __device__ __forceinline__ void dil_unit(const unsigned char* ws, unsigned char* wsw, const int tid, int l, int bh, int chunk, int nud, char* shm) {
    constexpr int L = SEQ / DIL, BR = DIL == 1 ? 0 : (DIL == 4 ? 1 : 2), NSLOT = DIL == 16 ? 4 : 6, NTW = DIL == 16 ? 2 : 3;
    const int lane = tid & 63, r32 = lane & 31, hi = lane >> 5, wid = __builtin_amdgcn_readfirstlane(tid >> 6);
    const int h = bh % 6, b = bh / 6;
    const bf16* Qb = (const bf16*)(ws + WS_QL) + (size_t)bh * SEQ * 64; const bf16* Kb = (const bf16*)(ws + WS_KL) + (size_t)bh * SEQ * 64; const bf16* Vb = (const bf16*)(ws + WS_VL) + (size_t)bh * SEQ * 64;
    const float* tabg = (const float*)(ws + WS_TAB) + TAB_BL + (l * 6 + h) * 4096;
    const unsigned lds0 = (unsigned)(uintptr_t)shm; const lds_cptr shm3 = (lds_cptr)shm;
    int res_w, qidx0, tf;
    if (DIL == 16) { res_w = 2 * chunk + (wid >> 2); qidx0 = 32 * (wid & 3); tf = 2 * (wid >> 2); }
    else if (DIL == 4) { res_w = chunk >> 1; qidx0 = 256 * (chunk & 1) + 32 * wid; tf = wid >> 1; }
    else { res_w = 0; qidx0 = 256 * chunk + 32 * wid; tf = wid >> 1; }
    const int t0idx = DIL == 16 ? 0 : (DIL == 4 ? 256 * (chunk & 1) - 64 : 256 * chunk - 64);
#pragma unroll
    for (int s = 0; s < NSLOT; ++s) {
        const int res_s = DIL == 16 ? 2 * chunk + (s >> 1) : res_w, k0 = DIL == 16 ? 64 * (s & 1) : t0idx + 64 * s;
        int ki = k0 + 8 * wid + (lane >> 3); ki = ki < 0 ? 0 : (ki > L - 1 ? L - 1 : ki);
        int vi = k0 + 16 * (wid & 3) + (lane >> 2); vi = vi < 0 ? 0 : (vi > L - 1 ? L - 1 : vi);
        const unsigned d_ = (unsigned)__builtin_amdgcn_readfirstlane(lds0 + s * DL_SLOT + wid * 1024);
        glds16(Kb + (size_t)(res_s + DIL * ki) * 64 + (((lane & 7) ^ (((8 * wid + (lane >> 3)) >> 1) & 7)) * 8), d_);
        glds16(Vb + (size_t)(res_s + DIL * vi) * 64 + (wid >> 2) * 32 + (lane & 3) * 8, d_ + 8192);
    }
    if (tid < 256) ((__attribute__((address_space(3))) float*)(shm3 + DL_TAB))[tid] = tabg[2048 + DIL * (tid - 128)];
    bf16x8 qr[4];
#pragma unroll
    for (int d0 = 0; d0 < 4; ++d0) qr[d0] = *(const bf16x8*)(Qb + (size_t)(res_w + DIL * (qidx0 + r32)) * 64 + d0 * 16 + hi * 8);
    ATT_WAIT_BAR(0);
    f32x16 o0 = {}, o1 = {}; float lsum = 0.f;
    const int qidx = qidx0 + r32;
#pragma unroll
    for (int tt = 0; tt < NTW; ++tt) {
        const int slot = tf + tt;
        const int k0 = DIL == 16 ? 64 * tt : t0idx + 64 * slot;
        const lds_cptr kp = shm3 + slot * DL_SLOT + r32 * 128;
        const lds_cptr vp = shm3 + slot * DL_SLOT + 8192 + ((lane >> 4) & 1) * 32 + (lane & 3) * 8 + (4 * hi + ((lane & 15) >> 2)) * 64;
        const int dbase = k0 + 4 * hi - qidx;
        int ti = 128 + dbase; ti = ti < 0 ? 0 : (ti > 255 - 59 ? 255 - 59 : ti);
        const __attribute__((address_space(3))) float* tb = (const __attribute__((address_space(3))) float*)(shm3 + DL_TAB) + ti;
        f32x16 p0, p1;
#pragma unroll
        for (int r = 0; r < 16; ++r) { p0[r] = tb[(r & 3) + 8 * (r >> 2)]; p1[r] = tb[32 + (r & 3) + 8 * (r >> 2)]; }
#pragma unroll
        for (int d0 = 0; d0 < 4; ++d0) {
            const int e_ = ((2 * d0 + hi) ^ ((r32 >> 1) & 7)) << 4;
            const bf16x8 a0 = *(const __attribute__((address_space(3))) bf16x8*)(kp + e_), a1 = *(const __attribute__((address_space(3))) bf16x8*)(kp + e_ + 4096);
            p0 = __builtin_amdgcn_mfma_f32_32x32x16_bf16(a0, qr[d0], p0, 0, 0, 0); p1 = __builtin_amdgcn_mfma_f32_32x32x16_bf16(a1, qr[d0], p1, 0, 0, 0);
        }
        float s0 = 0.f;
#pragma unroll
        for (int r = 0; r < 16; ++r) {
            const int d0_ = dbase + (r & 3) + 8 * (r >> 2), d1_ = d0_ + 32, kk0 = d0_ + qidx, kk1 = d1_ + qidx;
            const bool v0 = (d0_ >= -64) && (d0_ <= 64) && (kk0 >= 0) && (kk0 < L), v1 = (d1_ >= -64) && (d1_ <= 64) && (kk1 >= 0) && (kk1 < L);
            p0[r] = v0 ? __builtin_amdgcn_exp2f(p0[r]) : 0.f; p1[r] = v1 ? __builtin_amdgcn_exp2f(p1[r]) : 0.f; s0 += p0[r] + p1[r];
        }
        lsum += s0;
        bf16x8 pa[4]; pack_p(p0, p1, pa);
        pv64(o0, o1, vp, pa);
    }
    ATT_BAR();
    lsum = half_swap_sum(lsum);
    int lane_t = lane; asm volatile("" : "+v"(lane_t));
    const int r32t = lane_t & 31, hit = lane_t >> 5;
    __attribute__((address_space(3))) float* wsf = (__attribute__((address_space(3))) float*)(shm3 + DL_WSF) + wid * 64;
    if (hit == 0) wsf[r32t] = __builtin_amdgcn_rcpf(lsum);
    asm volatile("s_waitcnt lgkmcnt(0)" ::: "memory");
    float sc[16];
#pragma unroll
    for (int r = 0; r < 16; ++r) sc[r] = wsf[crow(r, hit)];
    bf16* DO = (bf16*)(wsw + (BR == 0 ? WS_DO0 : (BR == 1 ? WS_DO1 : WS_DO2)));
    float* DLs = (float*)(wsw + WS_DL) + (size_t)BR * MTOK * 8;
    const size_t row0 = (size_t)b * SEQ + res_w + (size_t)DIL * qidx0;
    store_o64(o0, o1, sc, (lds_ptr)(shm3 + wid * 4096), DO + row0 * 384 + h * 64, 384 * DIL, lane_t);
    if (hit == 0) DLs[(row0 + (size_t)DIL * r32t) * 8 + h] = lsum;
    ATT_BAR();
}

__device__ __forceinline__ void dil_merge(unsigned char* wsw, const int tid, int gw, int NGW) {
    const int lane = tid & 63;
    const bf16* D0 = (const bf16*)(wsw + WS_DO0); const bf16* D1 = (const bf16*)(wsw + WS_DO1); const bf16* D2 = (const bf16*)(wsw + WS_DO2);
    const float* DLs = (const float*)(wsw + WS_DL);
    bf16* mix = (bf16*)(wsw + WS_MIX);
    for (int m = gw; m < MTOK; m += NGW) {
        if (lane < 48) {
            const int h = lane >> 3;
            const float l0 = DLs[(size_t)m * 8 + h], l1 = DLs[((size_t)MTOK + m) * 8 + h], l2 = DLs[((size_t)2 * MTOK + m) * 8 + h];
            const float inv = 1.0f / (l0 + l1 + l2), w0 = l0 * inv, w1 = l1 * inv, w2 = l2 * inv;
            const v4u a = *(const v4u*)(D0 + (size_t)m * 384 + lane * 8), bq = *(const v4u*)(D1 + (size_t)m * 384 + lane * 8), c = *(const v4u*)(D2 + (size_t)m * 384 + lane * 8);
            float x[8], y[8], z[8]; unpack8(a, x); unpack8(bq, y); unpack8(c, z);
            v4u o; o.x = pk2(w0 * x[0] + w1 * y[0] + w2 * z[0], w0 * x[1] + w1 * y[1] + w2 * z[1]); o.y = pk2(w0 * x[2] + w1 * y[2] + w2 * z[2], w0 * x[3] + w1 * y[3] + w2 * z[3]);
            o.z = pk2(w0 * x[4] + w1 * y[4] + w2 * z[4], w0 * x[5] + w1 * y[5] + w2 * z[5]); o.w = pk2(w0 * x[6] + w1 * y[6] + w2 * z[6], w0 * x[7] + w1 * y[7] + w2 * z[7]);
            *(v4u*)(mix + (size_t)m * DM + 256 + lane * 8) = o;
        }
    }
}
}

#ifndef MK_PH
#define MK_PH 255
#endif
#ifndef MK_CONV_EARLY
#define MK_CONV_EARLY 1
#endif
#ifndef MK_DUP
#define MK_DUP 0
#endif
#define REP(kind) for (int rep_ = 0; rep_ < (((MK_DUP >> (kind)) & 1) ? 2 : 1); ++rep_)
#ifndef MK_ATTN_V1
#define MK_ATTN_V1 0
#endif
#ifndef MK_SP2
#define MK_SP2 true
#endif
constexpr int NPHASE = 18;
template <int MODE>
__global__ void __launch_bounds__(512, 2) enc_fwd(Args args) {
    extern __shared__ __attribute__((aligned(16))) unsigned char lds[];
    LAS unsigned char* L = (LAS unsigned char*)lds;
    volatile LAS unsigned* MISC = (volatile LAS unsigned*)(L + MISC_OFF);
    LAS float* xs = (LAS float*)(L + XS_OFF);
    const int G = gridDim.x, bx = blockIdx.x;
    const int wave0 = __builtin_amdgcn_readfirstlane(threadIdx.x >> 6);
    const int vcu = (G % 8 == 0) ? (bx % 8) * (G / 8) + bx / 8 : bx;
    for (int u = threadIdx.x; u < (LDS_BYTES - MISC_OFF) / 4; u += 512) ((LAS unsigned*)(L + MISC_OFF))[u] = 0u;
    __syncthreads();
    { volatile LAS unsigned long long* PT = (volatile LAS unsigned long long*)(L + MISC_OFF + 128);
      if (threadIdx.x == 0) {
#pragma unroll
          for (int i = 0; i < 25; ++i) PT[i] = (unsigned long long)args.in[i];
          PT[25] = (unsigned long long)args.out; } }
    __syncthreads();
    if (MODE < 0) xcd_barrier_post((unsigned*)(args.ws + WS_CTL) + CW_BAR, MISC + 8, threadIdx.x == 0);
#define IN(k) (MODE < 0 || MODE == (k))
#define SEAM(k) do { if (MODE < 0) xcd_barrier((unsigned*)(args.ws + WS_CTL) + CW_BAR, MISC + 8, wave0 == 0 && __builtin_amdgcn_mbcnt_hi(~0u, __builtin_amdgcn_mbcnt_lo(~0u, 0u)) == 0u); } while (0)
#define INP(i) ((const float*)lds_ptr_get((volatile LAS unsigned long long*)(L + MISC_OFF + 128), (i)))
#define PHASE_ENV() int tidp; asm volatile("v_mbcnt_lo_u32_b32 %0, -1, 0\n\tv_mbcnt_hi_u32_b32 %0, -1, %0" : "=v"(tidp)); tidp |= wave0 << 6; asm volatile("" : "+v"(tidp)); int bxp = bx, Gp = G, vcup = vcu; asm volatile("" : "+s"(bxp), "+s"(Gp), "+s"(vcup)); (void)vcup; unsigned char* ws; { const unsigned long long w_ = (unsigned long long)args.ws; unsigned wl_ = (unsigned)w_, wh_ = (unsigned)(w_ >> 32); \
          asm volatile("" : "+s"(wl_), "+s"(wh_)); ws = (unsigned char*)(((unsigned long long)wh_ << 32) | wl_); } \
        const int lane = tidp & 63, wave = __builtin_amdgcn_readfirstlane(tidp >> 6), gw = vcup * 8 + wave, gtid = bxp * 512 + tidp; const int NGW = Gp * 8, NGT = Gp * 512; (void)NGW; (void)NGT; (void)lane; (void)gw; (void)gtid; \
        bf16* XB = (bf16*)(ws + WS_XB); bf16* HB = (bf16*)(ws + WS_H); float* P0 = (float*)(ws + WS_P); float* P1 = P0 + (size_t)MTOK * 16; float* P2 = P1 + (size_t)MTOK * 16; \
        const float* tab = (const float*)(ws + WS_TAB); (void)XB; (void)HB; (void)P0; (void)P1; (void)P2; (void)tab;

    REP(0) if (IN(0) && (MK_PH & 1)) { PHASE_ENV();
        prologue_misc((volatile LAS unsigned long long*)(L + MISC_OFF + 128), ws, gw, NGW, lane, gtid, NGT);
        convert_weights((volatile LAS unsigned long long*)(L + MISC_OFF + 128), ws, 0, MK_CONV_EARLY ? 21 : 255, gw, NGW, lane);
    }
    SEAM(0);
    for (int l = (MODE < 0 ? 0 : args.layer); l < (MODE < 0 ? DEPTH : args.layer + 1); ++l) {
        constexpr int p0 = 1;
        REP(1) if (IN(p0 + 0) && (MK_PH & 4)) { PHASE_ENV();
            pg8::Gemm g{XB, (const bf16*)(ws + W_GU1), MTOK, 2 * DFF, DM, DM, DM}; pg8::StaticOrder S; S.init(MTOK, 2 * DFF, Gp, bxp);
            pg8::EpiSwiGLU E{HB, P0};
            pg8::gemm_phase<pg8::EpiSwiGLU, pg8::StaticOrder, true, MK_SP2>(tidp, L, xs, g, S, E);
            if (MK_CONV_EARLY && bxp >= Gp / 2) convert_weights((volatile LAS unsigned long long*)(L + MISC_OFF + 128), ws, l, l == 0 ? 234 : 10, (bxp - Gp / 2) * 8 + wave, (Gp - Gp / 2) * 8, lane);
        }
        SEAM(p0 + 0);
        REP(2) if (IN(p0 + 1) && (MK_PH & 8)) { PHASE_ENV();
            pg8::Gemm g{HB, (const bf16*)(ws + W_D1), MTOK, DM, DFF, DFF, DFF}; pg8::StaticOrder S; S.init(MTOK, DM, Gp, bxp);
            pg8::EpiResid E{l == 0 ? INP(I_X) : (const float*)INP(25), (float*)INP(25), XB, P1, (((MK_DUP >> 2) & 1) && rep_ == 0) ? 0.0f : 0.5f};
            pg8::gemm_phase<pg8::EpiResid, pg8::StaticOrder, true, MK_SP2>(tidp, L, xs, g, S, E);
        }
        SEAM(p0 + 1);
        REP(3) if (IN(p0 + 2) && (MK_PH & 16)) { PHASE_ENV();
            pg8::Gemm g{XB, (const bf16*)(ws + W_IN), MTOK, NIN, DM, DM, DM}; pg8::StaticOrder S; S.init(MTOK, NIN, Gp, bxp);
            pg8::EpiInProj E{P1, (bf16*)(ws + WS_QD), (bf16*)(ws + WS_KD), (bf16*)(ws + WS_VD), (bf16*)(ws + WS_QL), (bf16*)(ws + WS_KL), (bf16*)(ws + WS_VL), (bf16*)(ws + WS_AQ),
                             (float*)(ws + WS_KR), (float*)(ws + WS_KRSS), INP(I_DQN) + l * 32, INP(I_DKN) + l * 32, INP(I_LQN) + l * 64, INP(I_LKN) + l * 64,
                             0.17677669529663687f * LOG2E, 0.125f * LOG2E};
            pg8::gemm_phase<pg8::EpiInProj, pg8::StaticOrder, true, MK_SP2>(tidp, L, xs, g, S, E);
            if (MK_CONV_EARLY && l + 1 < DEPTH && bxp >= Gp / 2) convert_weights((volatile LAS unsigned long long*)(L + MISC_OFF + 128), ws, l + 1, 4, (bxp - Gp / 2) * 8 + wave, (Gp - Gp / 2) * 8, lane);
        }
        SEAM(p0 + 2);
        REP(10) if (IN(p0 + 3) && (MK_PH & 32)) { PHASE_ENV();
            { int Kq = 256; asm volatile("" : "+s"(Kq)); pg8::Gemm g{(const bf16*)(ws + WS_AQ), (const bf16*)(ws + W_QU), MTOK, 768, Kq, 384, 256}; pg8::StaticOrder S; S.init(MTOK, 768, Gp, bxp);
              pg8::EpiMlaQ E{(bf16*)(ws + WS_QC), INP(I_MQNG) + l * 96, tab + TAB_COS, tab + TAB_SIN, 0.10206207261596575f * LOG2E};
              pg8::gemm_phase<pg8::EpiMlaQ, pg8::StaticOrder, true, MK_SP2>(tidp, L, xs, g, S, E); }
        }
        REP(11) if (IN(p0 + 3) && (MK_PH & 32)) { PHASE_ENV();
            { int Kq = 256; asm volatile("" : "+s"(Kq)); pg8::Gemm g{(const bf16*)(ws + WS_AQ) + 128, (const bf16*)(ws + W_KVU), MTOK, 768, Kq, 384, 256}; pg8::StaticOrder S; S.init(MTOK, 768, Gp, (bxp + 128) % Gp);
              pg8::EpiMlaKV E{(bf16*)(ws + WS_KC), (bf16*)(ws + WS_VC), INP(I_MKNG) + l * 96, (const float*)(ws + WS_KR), (const float*)(ws + WS_KRSS), tab + TAB_COS, tab + TAB_SIN};
              pg8::gemm_phase<pg8::EpiMlaKV, pg8::StaticOrder, true, MK_SP2>(tidp, L, xs, g, S, E); }
        }
#if !MK_ATTN_V1
        REP(12) if (IN(p0 + 3) && (MK_PH & 32)) { PHASE_ENV();
            for (int ud = vcup; ud < 1152; ud += Gp) {
                const int bh = ud / 24, rem = ud - bh * 24, br = rem >> 3, chunk = rem & 7;
                if (br == 0) att::dil_unit<1>(ws, ws, tidp, l, bh, chunk, ud + Gp, (char*)lds);
                else if (br == 1) att::dil_unit<4>(ws, ws, tidp, l, bh, chunk, ud + Gp, (char*)lds);
                else att::dil_unit<16>(ws, ws, tidp, l, bh, chunk, ud + Gp, (char*)lds);
            }
        }
#endif
        SEAM(p0 + 3);
#if MK_ATTN_V1
        REP(5) if (IN(p0 + 4) && (MK_PH & 64)) { PHASE_ENV();
            for (int u = bxp; u < 640; u += Gp) {
                if (u < 192) mla_unit_v1(ws, tidp, l, u, (LAS float*)L);
                else if (u < 448) diff_unit_v1(ws, INP(I_DSUB) + l * 64, tidp, l, u - 192, (LAS float*)L);
                else dil_unit_v1(ws, tidp, l, u - 448);
            }
        }
#else
        REP(13) if (IN(p0 + 4) && (MK_PH & 64)) { PHASE_ENV();
            for (int u = vcup; u < 512; u += Gp) att::diff_unit(ws, INP(I_DSUB) + l * 64, tidp, l, u, (char*)lds);
        }
        REP(14) if (IN(p0 + 4) && (MK_PH & 64)) { PHASE_ENV();
            for (int u = vcup; u < 768; u += Gp) att::mla_unit(ws, tidp, l, u, (char*)lds);
        }
        REP(15) if (IN(p0 + 4) && (MK_PH & 64)) { PHASE_ENV();
            att::dil_merge(ws, tidp, gw, NGW);
        }
#endif
        SEAM(p0 + 4);
        REP(6) if (IN(p0 + 5) && (MK_PH & 128)) { PHASE_ENV();
            pg8::Gemm g{(const bf16*)(ws + WS_MIX), (const bf16*)(ws + W_O), MTOK, DM, DM, DM, DM}; pg8::StaticOrder S; S.init(MTOK, DM, Gp, bxp);
            pg8::EpiResid E{(const float*)INP(25), (float*)INP(25), XB, P2, (((MK_DUP >> 6) & 1) && rep_ == 0) ? 0.0f : 1.0f};
            pg8::gemm_phase<pg8::EpiResid, pg8::StaticOrder, true, MK_SP2>(tidp, L, xs, g, S, E);
        }
        SEAM(p0 + 5);
        REP(7) if (IN(p0 + 6) && (MK_PH & 4)) { PHASE_ENV();
            pg8::Gemm g{XB, (const bf16*)(ws + W_GU2), MTOK, 2 * DFF, DM, DM, DM}; pg8::StaticOrder S; S.init(MTOK, 2 * DFF, Gp, bxp);
            pg8::EpiSwiGLU E{HB, P2};
            pg8::gemm_phase<pg8::EpiSwiGLU, pg8::StaticOrder, true, MK_SP2>(tidp, L, xs, g, S, E);
            if (MK_CONV_EARLY && l + 1 < DEPTH && bxp >= Gp / 2) convert_weights((volatile LAS unsigned long long*)(L + MISC_OFF + 128), ws, l + 1, 241, (bxp - Gp / 2) * 8 + wave, (Gp - Gp / 2) * 8, lane);
        }
        SEAM(p0 + 6);
        REP(8) if (IN(p0 + 7) && (MK_PH & 8)) { PHASE_ENV();
            pg8::Gemm g{HB, (const bf16*)(ws + W_D2), MTOK, DM, DFF, DFF, DFF}; pg8::StaticOrder S; S.init(MTOK, DM, Gp, bxp);
            pg8::EpiResid E{(const float*)INP(25), (float*)INP(25), l == DEPTH - 1 ? nullptr : XB, l == DEPTH - 1 ? nullptr : P0, (((MK_DUP >> 8) & 1) && rep_ == 0) ? 0.0f : 0.5f};
            pg8::gemm_phase<pg8::EpiResid, pg8::StaticOrder, true, MK_SP2>(tidp, L, xs, g, S, E);
        }
        if (l + 1 < DEPTH && !MK_CONV_EARLY) {
            SEAM(p0 + 7);
            REP(9) if (IN(p0 + 8) && (MK_PH & 2)) { PHASE_ENV(); convert_weights((volatile LAS unsigned long long*)(L + MISC_OFF + 128), ws, l + 1, 255, gw, NGW, lane); }
            SEAM(p0 + 8);
        }
        if (l + 1 < DEPTH && MK_CONV_EARLY) SEAM(p0 + 7);
    }
#undef IN
#undef SEAM
#undef PHASE_ENV
}

extern "C" void kernel_launch(void* const* d_in, const int* in_sizes, int n_in, void* d_out, int out_size, void* d_ws, size_t ws_size, hipStream_t stream) {
    static int grid = 0;
    if (grid == 0) {
        if (n_in != 25 || out_size != MTOK * DM || ws_size < WS_TOTAL) { fprintf(stderr, "kernel_launch: unexpected shapes (n_in %d out %d ws %zu)\n", n_in, out_size, ws_size); grid = -1; return; }
        int dev = 0, cus = 0, per_cu = 0;
        if (hipGetDevice(&dev) != hipSuccess || hipDeviceGetAttribute(&cus, hipDeviceAttributeMultiprocessorCount, dev) != hipSuccess) { grid = -1; return; }
#if MK_ONE_LAUNCH
        if (hipFuncSetAttribute((const void*)enc_fwd<-1>, hipFuncAttributeMaxDynamicSharedMemorySize, LDS_BYTES) != hipSuccess) { fprintf(stderr, "kernel_launch: hipFuncSetAttribute failed\n"); grid = -1; return; }
        if (hipOccupancyMaxActiveBlocksPerMultiprocessor(&per_cu, (const void*)enc_fwd<-1>, 512, LDS_BYTES) != hipSuccess || per_cu < 1) { fprintf(stderr, "kernel_launch: occupancy query says %d\n", per_cu); grid = -1; return; }
#else
#define SETATTR(K) if (hipFuncSetAttribute((const void*)enc_fwd<K>, hipFuncAttributeMaxDynamicSharedMemorySize, LDS_BYTES) != hipSuccess) { fprintf(stderr, "kernel_launch: hipFuncSetAttribute failed\n"); grid = -1; return; }
        SETATTR(0) SETATTR(1) SETATTR(2) SETATTR(3) SETATTR(4) SETATTR(5) SETATTR(6) SETATTR(7) SETATTR(8) SETATTR(9)
        per_cu = 1;
#endif
        (void)hipGetLastError();
        grid = cus;
    }
    if (grid < 0) return;
    (void)hipMemsetAsync((char*)d_ws + WS_CTL, 0, CTL_ZERO_BYTES, stream);
    Args a{};
    for (int i = 0; i < 25; ++i) a.in[i] = (const float*)d_in[i];
    a.out = (float*)d_out; a.ws = (unsigned char*)d_ws;
#if MK_ONE_LAUNCH
    a.layer = 0;
    hipLaunchKernelGGL(enc_fwd<-1>, dim3(grid), dim3(512), LDS_BYTES, stream, a);
#else
#define LAUNCH_PH(K, LAYER) do { a.layer = (LAYER); hipLaunchKernelGGL(enc_fwd<K>, dim3(grid), dim3(512), LDS_BYTES, stream, a); } while (0)
    LAUNCH_PH(0, 0);
    for (int l = 0; l < DEPTH; ++l) {
        LAUNCH_PH(1, l); LAUNCH_PH(2, l); LAUNCH_PH(3, l); LAUNCH_PH(4, l); LAUNCH_PH(5, l); LAUNCH_PH(6, l); LAUNCH_PH(7, l); LAUNCH_PH(8, l);
        if (l + 1 < DEPTH) LAUNCH_PH(9, l);
    }
#endif
}
```

```cpp
#include <hip/hip_runtime.h>
#include <cstdio>
#include <cstdint>

#ifndef MK_PROBE
#define MK_PROBE 0
#endif
#ifndef MK_PROBE_SCALE
#define MK_PROBE_SCALE 1000.0f
#endif
#ifndef MK_EARLY_WB
#define MK_EARLY_WB 0
#endif
#ifndef MK_SC1_STORES
#define MK_SC1_STORES 0
#endif
#ifndef MK_ONE_LAUNCH
#define MK_ONE_LAUNCH 1
#endif

constexpr int DM = 1024, BATCH = 8, SEQ = 2048, DEPTH = 2, MTOK = BATCH * SEQ, DFF = 2816;
constexpr int IN_W = 2336, NIN = 2560;
constexpr float EPS = 1e-6f;
constexpr float LOG2E = 1.4426950408889634f;

__device__ __forceinline__ float sum_x32(float v) { const unsigned u = __builtin_bit_cast(unsigned, v); auto r = __builtin_amdgcn_permlane32_swap(u, u, false, false); return __builtin_bit_cast(float, (unsigned)r[0]) + __builtin_bit_cast(float, (unsigned)r[1]); }
__device__ __forceinline__ float max_x32(float v) { const unsigned u = __builtin_bit_cast(unsigned, v); auto r = __builtin_amdgcn_permlane32_swap(u, u, false, false); return fmaxf(__builtin_bit_cast(float, (unsigned)r[0]), __builtin_bit_cast(float, (unsigned)r[1])); }
template <int M> __device__ __forceinline__ float swz(float v) { return __builtin_bit_cast(float, __builtin_amdgcn_ds_swizzle(__builtin_bit_cast(int, v), 0x1F | (M << 10))); }

namespace pg8 {
#define PG8_LAS __attribute__((address_space(3)))
typedef unsigned short bf16_t;
typedef short bf16x8 __attribute__((ext_vector_type(8)));
typedef float f32x4 __attribute__((ext_vector_type(4)));
typedef unsigned u32x4 __attribute__((ext_vector_type(4)));
typedef unsigned u32x2 __attribute__((ext_vector_type(2)));
constexpr int BM = 256, BK = 64, HALF = 128, HTB = HALF * BK * 2  , STAGE_BYTES = 8 * HTB, NXCD = 8, WGM = 8;

__host__ __device__ __forceinline__ int lds_byte(int r, int c) { const int st = (r >> 4) * 2 + (c >> 5), rr = r & 15, cc = c & 31, ob = rr * 64 + cc * 2; return st * 1024 + (ob ^ (((ob >> 9) & 1) << 5)); }
__host__ __device__ __forceinline__ void stage_rc(int b, int& R, int& C) { const int st = b / 1024, sb = b % 1024, swz = sb ^ (((sb >> 9) & 1) << 5); R = (st >> 1) * 16 + swz / 64; C = (st & 1) * 32 + (swz % 64) / 2; }
__host__ __device__ __forceinline__ int perm32(int rho) { const int n = rho >> 4, i = rho & 15; return 8 * (i >> 2) + 4 * n + (i & 3); }

struct Unit { int pm, pn; };
struct Gemm { const bf16_t* A; const bf16_t* Bt; int M, N, K, lda, ldb; int asplit = 1 << 30, aoff = 0; };

struct StaticOrder {
    int nM, nN, nwg, G, c;
    __host__ __device__ void init(int M, int N, int G_, int c_) { nM = M / BM; nN = N / BM; nwg = nM * nN; G = G_; c = c_; }
    __host__ __device__ bool next(int i, Unit& u) const {
        const long L = (long)i * G + c; if (L >= nwg) return false;
        int wgid = (int)L; { const int q = nwg / NXCD, r = nwg % NXCD, xcd = wgid % NXCD, off = wgid / NXCD; wgid = (xcd < r ? xcd * (q + 1) : r * (q + 1) + (xcd - r) * q) + off; }
        const int nig = WGM * nN, gid = wgid / nig, fm = gid * WGM, gsz = (nM - fm) < WGM ? (nM - fm) : WGM;
        u.pm = fm + ((wgid % nig) % gsz); u.pn = (wgid % nig) / gsz; return true;
    }
    __device__ __forceinline__ void a_ready(const Unit&) const {}
    __device__ __forceinline__ void done(const Unit&) const {}
};

__device__ __forceinline__ unsigned cvt_pk_bf16(float lo, float hi) { unsigned r; asm volatile("v_cvt_pk_bf16_f32 %0, %1, %2" : "=v"(r) : "v"(lo), "v"(hi)); return r; }

__device__ __forceinline__ float rowscale16(const float* P, int row) {
    const f32x4* p = (const f32x4*)(P + (size_t)row * 16);
    const f32x4 a = p[0], b = p[1], c = p[2], d = p[3];
    const float s = ((a[0] + a[1]) + (a[2] + a[3])) + ((b[0] + b[1]) + (b[2] + b[3])) + ((c[0] + c[1]) + (c[2] + c[3])) + ((d[0] + d[1]) + (d[2] + d[3]));
    return __builtin_amdgcn_rsqf(s * (1.0f / 1024.0f) + EPS);
}
__device__ __forceinline__ void rowscale_all(const float* P, int row0, int fq, float (&r)[8]) {
    f32x4 t[8];
#pragma unroll
    for (int i = 0; i < 8; ++i) t[i] = *(const f32x4*)(P + (size_t)(row0 + (i >> 2) * HALF + (i & 3) * 16) * 16 + fq * 4);
#pragma unroll
    for (int i = 0; i < 8; ++i) { float s = (t[i][0] + t[i][1]) + (t[i][2] + t[i][3]); s += swz<16>(s); s = sum_x32(s); r[i] = __builtin_amdgcn_rsqf(s * (1.0f / 1024.0f) + EPS); }
}
__device__ __forceinline__ u32x4 pack8(const float* v) { u32x4 w; w.x = cvt_pk_bf16(v[0], v[1]); w.y = cvt_pk_bf16(v[2], v[3]); w.z = cvt_pk_bf16(v[4], v[5]); w.w = cvt_pk_bf16(v[6], v[7]); return w; }
__device__ __forceinline__ float quad_sum(float s) { s += swz<16>(s); return sum_x32(s); }
#define EPI_OPAQUE() do { u.pm = __builtin_amdgcn_readfirstlane(u.pm); u.pn = __builtin_amdgcn_readfirstlane(u.pn); wr = __builtin_amdgcn_readfirstlane(wr); wc = __builtin_amdgcn_readfirstlane(wc); \
    asm volatile("" : "+s"(u.pm), "+s"(u.pn), "+s"(wr), "+s"(wc), "+v"(fr), "+v"(fq)); } while (0)
#if MK_SC1_STORES
__device__ __forceinline__ void st16(void* p, u32x4 v) { asm volatile("global_store_dwordx4 %0, %1, off sc1\n\ts_nop 1" :: "v"(p), "v"(v) : "memory"); }
__device__ __forceinline__ void st16f(void* p, f32x4 v) { asm volatile("global_store_dwordx4 %0, %1, off sc1\n\ts_nop 1" :: "v"(p), "v"(v) : "memory"); }
#else
__device__ __forceinline__ void st16(void* p, u32x4 v) { *(u32x4*)p = v; }
__device__ __forceinline__ void st16f(void* p, f32x4 v) { *(f32x4*)p = v; }
#endif
#define XS_BAR() do { asm volatile("s_waitcnt lgkmcnt(0)" ::: "memory"); __builtin_amdgcn_s_barrier(); asm volatile("" ::: "memory"); } while (0)

struct EpiSwiGLU {
    static constexpr bool PERM = true, AFTER_DRAIN = false, DUP_OK = true;
    bf16_t* H; const float* P;
    __device__ __forceinline__ void operator()(const f32x4 (&acc)[2][2][4][2], const Unit& u_, int wr, int wc, int fr, int fq, PG8_LAS float* xs) const {
        Unit u = u_; EPI_OPAQUE();
        float rs[8]; rowscale_all(P, u.pm * BM + wr * 64 + fr, fq, rs);
#pragma unroll
        for (int ai = 0; ai < 2; ++ai)
#pragma unroll
            for (int m = 0; m < 4; ++m) {
                const int row = u.pm * BM + ai * HALF + wr * 64 + m * 16 + fr;
                const float r = rs[ai * 4 + m], rn = -LOG2E * r, r2 = r * r;
                float h[8];
#pragma unroll
                for (int n = 0; n < 2; ++n)
#pragma unroll
                    for (int j = 0; j < 4; ++j) {
                        const float a = acc[ai][0][m][n][j], b = acc[ai][1][m][n][j];
                        h[n * 4 + j] = (a * b) * (r2 * __builtin_amdgcn_rcpf(1.0f + __builtin_amdgcn_exp2f(a * rn)));
                    }
                st16(H + (size_t)row * DFF + u.pn * 128 + wc * 32 + fq * 8, pack8(h));
            }
    }
};

struct EpiResidB {
    static constexpr bool PERM = true, AFTER_DRAIN = false, DUP_OK = false;
    bf16_t* XB; float* Xout; float* Pout; float alpha;
    __device__ __forceinline__ void operator()(const f32x4 (&acc)[2][2][4][2], const Unit& u_, int wr, int wc, int fr, int fq, PG8_LAS float* xs) const {
        Unit u = u_; EPI_OPAQUE();
        const bool FINAL = Xout != nullptr;
        const size_t off0 = (size_t)(u.pm * BM + wr * 64 + fr) * DM + u.pn * BM + wc * 32 + fq * 8;
        u32x4 res[8][2];
#pragma unroll
        for (int i = 0; i < 8; ++i)
#pragma unroll
            for (int bj = 0; bj < 2; ++bj) res[i][bj] = *(const u32x4*)(XB + off0 + (size_t)((i >> 2) * HALF + (i & 3) * 16) * DM + bj * HALF);
#pragma unroll
        for (int i = 0; i < 8; ++i) {
            const int ai = i >> 2, m = i & 3;
            const size_t off = off0 + (size_t)(ai * HALF + m * 16) * DM;
            float ss = 0.f;
#pragma unroll
            for (int bj = 0; bj < 2; ++bj) {
                const u32x4 c = res[i][bj];
                const f32x4 r0 = {__builtin_bit_cast(float, c[0] << 16), __builtin_bit_cast(float, c[0] & 0xffff0000u), __builtin_bit_cast(float, c[1] << 16), __builtin_bit_cast(float, c[1] & 0xffff0000u)};
                const f32x4 r1 = {__builtin_bit_cast(float, c[2] << 16), __builtin_bit_cast(float, c[2] & 0xffff0000u), __builtin_bit_cast(float, c[3] << 16), __builtin_bit_cast(float, c[3] & 0xffff0000u)};
                const f32x4 v0 = r0 + acc[ai][bj][m][0] * alpha, v1 = r1 + acc[ai][bj][m][1] * alpha;
                if (FINAL) { st16f(Xout + off + bj * HALF, v0); st16f(Xout + off + bj * HALF + 4, v1); }
                else { const float t[8] = {v0[0], v0[1], v0[2], v0[3], v1[0], v1[1], v1[2], v1[3]}; st16(XB + off + bj * HALF, pack8(t));
                    ss += (v0[0] * v0[0] + v0[1] * v0[1]) + (v0[2] * v0[2] + v0[3] * v0[3]) + (v1[0] * v1[0] + v1[1] * v1[1]) + (v1[2] * v1[2] + v1[3] * v1[3]); }
            }
            if (!FINAL) { ss = quad_sum(ss); if (fq == 0) Pout[(size_t)(u.pm * BM + ai * HALF + wr * 64 + m * 16 + fr) * 16 + u.pn * 4 + wc] = ss; }
        }
    }
};

struct EpiInProj {
    static constexpr bool PERM = true, AFTER_DRAIN = false, DUP_OK = false;
    const float* P;
    bf16_t *Qd, *Kd, *Vd, *Ql, *Kl, *Vl, *AQ; float *kr, *krss;
    const float *g_dq, *g_dk, *g_lq, *g_lk;
    float cdiff, cdil;
    int pn0;
    __device__ __forceinline__ void operator()(const f32x4 (&acc)[2][2][4][2], const Unit& u_, int wr, int wc, int fr, int fq, PG8_LAS float* xs) const {
        Unit u = u_; EPI_OPAQUE();
        const int t = u.pn + pn0;
        if (t == 7 || t == 8) {
#pragma unroll
            for (int ai = 0; ai < 2; ++ai)
#pragma unroll
                for (int m = 0; m < 4; ++m) {
                    const int rl = ai * HALF + wr * 64 + m * 16 + fr;
                    float ss = 0.f;
#pragma unroll
                    for (int bj = 0; bj < 2; ++bj)
#pragma unroll
                        for (int n = 0; n < 2; ++n) { const f32x4 a = acc[ai][bj][m][n]; ss += (a[0] * a[0] + a[1] * a[1]) + (a[2] * a[2] + a[3] * a[3]); }
                    ss = quad_sum(ss);
                    if (fq == 0) xs[rl * 4 + wc] = ss;
                }
            XS_BAR();
        }
        float rs[8]; rowscale_all(P, u.pm * BM + wr * 64 + fr, fq, rs);
        float gg[2][8];
        {
            const bool dil_ = (t >= 3 && t <= 5), isq_ = (t == 0) || (t == 3) || (t == 4 && wc < 2);
            const float *p_dq = g_dq, *p_dk = g_dk, *p_lq = g_lq, *p_lk = g_lk; asm volatile("" : "+s"(p_dq), "+s"(p_dk), "+s"(p_lq), "+s"(p_lk));
            const float* gp = dil_ ? (isq_ ? p_lq : p_lk) : (t == 1 ? p_dk : p_dq);
            const int gstep = dil_ ? 32 : 0;
#pragma unroll
            for (int bj = 0; bj < 2; ++bj)
#pragma unroll
                for (int i = 0; i < 8; ++i) gg[bj][i] = gp[bj * gstep + fq * 8 + i];
        }
#pragma unroll
        for (int ai = 0; ai < 2; ++ai)
#pragma unroll
            for (int m = 0; m < 4; ++m) {
                asm volatile("" ::: "memory");
                const int rl = ai * HALF + wr * 64 + m * 16 + fr, row = u.pm * BM + rl, b = row >> 11, s = row & (SEQ - 1);
                const float r = rs[ai * 4 + m];
                float v[2][8];
#pragma unroll
                for (int bj = 0; bj < 2; ++bj)
#pragma unroll
                    for (int n = 0; n < 2; ++n)
#pragma unroll
                        for (int j = 0; j < 4; ++j) v[bj][n * 4 + j] = acc[ai][bj][m][n][j] * r;
                if (t <= 1) {
                    bf16_t* dst = t == 0 ? Qd : Kd; const float post = t == 0 ? cdiff : 1.0f;
#pragma unroll
                    for (int bj = 0; bj < 2; ++bj) {
                        float ss = 0.f;
#pragma unroll
                        for (int i = 0; i < 8; ++i) ss += v[bj][i] * v[bj][i];
                        ss = quad_sum(ss);
                        const float rn = __builtin_amdgcn_rsqf(ss * (1.0f / 32.0f) + EPS) * post;
                        float o[8];
#pragma unroll
                        for (int i = 0; i < 8; ++i) o[i] = v[bj][i] * rn * gg[bj][i];
                        *(u32x4*)(dst + ((size_t)(((b * 4 + wc) * 2 + bj) * SEQ + s)) * 32 + fq * 8) = pack8(o);
                    }
                } else if (t == 2) {
#pragma unroll
                    for (int bj = 0; bj < 2; ++bj) *(u32x4*)(Vd + ((size_t)((b * 4 + wc) * SEQ + s)) * 64 + bj * 32 + fq * 8) = pack8(v[bj]);
                } else if (t <= 5) {
                    const bool isq = (t == 3) || (t == 4 && wc < 2);
                    const int head = (t == 3) ? wc : (t == 4 ? (wc < 2 ? 4 + wc : wc - 2) : wc + 2);
                    bf16_t* dst = isq ? Ql : Kl; const float post = isq ? cdil : 1.0f;
                    float ss = 0.f;
#pragma unroll
                    for (int bj = 0; bj < 2; ++bj)
#pragma unroll
                        for (int i = 0; i < 8; ++i) ss += v[bj][i] * v[bj][i];
                    ss = quad_sum(ss);
                    const float rn = __builtin_amdgcn_rsqf(ss * (1.0f / 64.0f) + EPS) * post;
#pragma unroll
                    for (int bj = 0; bj < 2; ++bj) {
                        float o[8];
#pragma unroll
                        for (int i = 0; i < 8; ++i) o[i] = v[bj][i] * rn * gg[bj][i];
                        *(u32x4*)(dst + ((size_t)((b * 6 + head) * SEQ + s)) * 64 + bj * 32 + fq * 8) = pack8(o);
                    }
                } else if (t == 6 || (t == 7 && wc < 2)) {
                    const int head = t == 6 ? wc : 4 + wc;
#pragma unroll
                    for (int bj = 0; bj < 2; ++bj) *(u32x4*)(Vl + ((size_t)((b * 6 + head) * SEQ + s)) * 64 + bj * 32 + fq * 8) = pack8(v[bj]);
                } else if (t == 7) {
                    const float ss = (xs[rl * 4 + 2] + xs[rl * 4 + 3]) * r * r;
                    const float rn = __builtin_amdgcn_rsqf(ss * (1.0f / 128.0f) + EPS);
#pragma unroll
                    for (int bj = 0; bj < 2; ++bj) {
                        float o[8];
#pragma unroll
                        for (int i = 0; i < 8; ++i) o[i] = v[bj][i] * rn;
                        *(u32x4*)(AQ + (size_t)row * 384 + 256 + (wc - 2) * 64 + bj * 32 + fq * 8) = pack8(o);
                    }
                } else if (t == 8) {
                    const float ss = ((xs[rl * 4 + 0] + xs[rl * 4 + 1]) + (xs[rl * 4 + 2] + xs[rl * 4 + 3])) * r * r;
                    const float rn = __builtin_amdgcn_rsqf(ss * (1.0f / 256.0f) + EPS);
#pragma unroll
                    for (int bj = 0; bj < 2; ++bj) {
                        float o[8];
#pragma unroll
                        for (int i = 0; i < 8; ++i) o[i] = v[bj][i] * rn;
                        *(u32x4*)(AQ + (size_t)row * 384 + bj * 128 + wc * 32 + fq * 8) = pack8(o);
                    }
                } else {
                    if (wc == 0) {
                        float ss = 0.f;
#pragma unroll
                        for (int bj = 0; bj < 2; ++bj)
#pragma unroll
                            for (int i = 0; i < 8; ++i) ss += v[bj][i] * v[bj][i];
                        ss = quad_sum(ss);
                        if (fq < 2) {
#pragma unroll
                            for (int bj = 0; bj < 2; ++bj) {
                                *(f32x4*)(kr + (size_t)row * 32 + bj * 16 + fq * 8) = (f32x4){v[bj][0], v[bj][1], v[bj][2], v[bj][3]};
                                *(f32x4*)(kr + (size_t)row * 32 + bj * 16 + fq * 8 + 4) = (f32x4){v[bj][4], v[bj][5], v[bj][6], v[bj][7]};
                            }
                        }
                        if (fq == 0) krss[row] = ss;
                    }
                }
            }
    }
};

struct EpiMlaQ {
    static constexpr bool PERM = true, AFTER_DRAIN = false, DUP_OK = false;
    bf16_t* Qc; const float* qn; const float* cs; const float* sn; float cmla;
    __device__ __forceinline__ void operator()(const f32x4 (&acc)[2][2][4][2], const Unit& u_, int wr, int wc, int fr, int fq, PG8_LAS float* xs) const {
        Unit u = u_; EPI_OPAQUE();
#pragma unroll
        for (int ai = 0; ai < 2; ++ai)
#pragma unroll
            for (int m = 0; m < 4; ++m) {
                const int rl = ai * HALF + wr * 64 + m * 16 + fr;
                float ss = 0.f;
#pragma unroll
                for (int bj = 0; bj < 2; ++bj)
#pragma unroll
                    for (int n = 0; n < 2; ++n) { const f32x4 a = acc[ai][bj][m][n]; ss += (a[0] * a[0] + a[1] * a[1]) + (a[2] * a[2] + a[3] * a[3]); }
                ss = quad_sum(ss);
                if (fq == 0) xs[rl * 4 + wc] = ss;
            }
        XS_BAR();
        const int hs = wc >> 1, head = u.pn * 2 + hs; const bool rope = wc & 1;
        float gq[16];
#pragma unroll
        for (int i = 0; i < 16; ++i) gq[i] = qn[(rope ? 64 + (i >> 3) * 16 : (i >> 3) * 32) + fq * 8 + (i & 7)];
        float cc[8], sv[8], ccn[8], svn[8];
        if (rope && fq < 2) { const int s0 = (u.pm * BM + wr * 64 + fr) & (SEQ - 1);
#pragma unroll
            for (int i = 0; i < 8; ++i) { cc[i] = cs[s0 * 16 + fq * 8 + i]; sv[i] = sn[s0 * 16 + fq * 8 + i]; } }
#pragma unroll
        for (int ig = 0; ig < 8; ++ig) {
            const int ai = ig >> 2, m = ig & 3;
            const int rl = ai * HALF + wr * 64 + m * 16 + fr, row = u.pm * BM + rl, b = row >> 11, s = row & (SEQ - 1);
            if (rope && fq < 2 && ig < 7) { const int sn_ = (u.pm * BM + ((ig + 1) >> 2) * HALF + wr * 64 + ((ig + 1) & 3) * 16 + fr) & (SEQ - 1);
#pragma unroll
                for (int i = 0; i < 8; ++i) { ccn[i] = cs[sn_ * 16 + fq * 8 + i]; svn[i] = sn[sn_ * 16 + fq * 8 + i]; } }
            const float ss = xs[rl * 4 + hs * 2] + xs[rl * 4 + hs * 2 + 1];
            const float rn = __builtin_amdgcn_rsqf(ss * (1.0f / 96.0f) + EPS) * cmla;
            bf16_t* dst = Qc + ((size_t)((b * 6 + head) * SEQ + s)) * 96;
            if (!rope) {
#pragma unroll
                for (int bj = 0; bj < 2; ++bj) {
                    float o[8];
#pragma unroll
                    for (int n = 0; n < 2; ++n)
#pragma unroll
                        for (int j = 0; j < 4; ++j) o[n * 4 + j] = acc[ai][bj][m][n][j] * rn * gq[bj * 8 + n * 4 + j];
                    *(u32x4*)(dst + bj * 32 + fq * 8) = pack8(o);
                }
            } else if (fq < 2) {
                float o1[8], o2[8];
#pragma unroll
                for (int n = 0; n < 2; ++n)
#pragma unroll
                    for (int j = 0; j < 4; ++j) {
                        const int i = n * 4 + j;
                        const float x1 = acc[ai][0][m][n][j] * rn * gq[i], x2 = acc[ai][1][m][n][j] * rn * gq[8 + i];
                        o1[i] = x1 * cc[i] - x2 * sv[i]; o2[i] = x1 * sv[i] + x2 * cc[i];
                    }
                *(u32x4*)(dst + 64 + fq * 8) = pack8(o1);
                *(u32x4*)(dst + 80 + fq * 8) = pack8(o2);
#pragma unroll
                for (int i = 0; i < 8; ++i) { cc[i] = ccn[i]; sv[i] = svn[i]; }
            }
            asm volatile("" ::: "memory");
        }
    }
};

struct EpiMlaKV {
    static constexpr bool PERM = true, AFTER_DRAIN = false, DUP_OK = false;
    bf16_t *Kc, *Vc; const float *kn, *kr, *krss, *cs, *sn;
    __device__ __forceinline__ void operator()(const f32x4 (&acc)[2][2][4][2], const Unit& u_, int wr, int wc, int fr, int fq, PG8_LAS float* xs) const {
        Unit u = u_; EPI_OPAQUE();
        const int hs = wc >> 1, head = u.pn * 2 + hs;
        if (wc & 1) {
#pragma unroll
            for (int ai = 0; ai < 2; ++ai)
#pragma unroll
                for (int m = 0; m < 4; ++m) {
                    asm volatile("" ::: "memory");
                    const int rl = ai * HALF + wr * 64 + m * 16 + fr, row = u.pm * BM + rl, b = row >> 11, s = row & (SEQ - 1);
#pragma unroll
                    for (int bj = 0; bj < 2; ++bj) {
                        float o[8];
#pragma unroll
                        for (int n = 0; n < 2; ++n)
#pragma unroll
                            for (int j = 0; j < 4; ++j) o[n * 4 + j] = acc[ai][bj][m][n][j];
                        *(u32x4*)(Vc + ((size_t)((b * 6 + head) * SEQ + s)) * 64 + bj * 32 + fq * 8) = pack8(o);
                    }
                }
        } else {
            float gk[16], gr1[4], gr2[4];
#pragma unroll
            for (int i = 0; i < 16; ++i) gk[i] = kn[(i >> 3) * 32 + fq * 8 + (i & 7)];
#pragma unroll
            for (int j = 0; j < 4; ++j) { gr1[j] = kn[64 + fq * 4 + j]; gr2[j] = kn[80 + fq * 4 + j]; }
            f32x4 k1, k2, k1n, k2n, c4, s4, c4n, s4n; float kss, kssn;
            { const int row = u.pm * BM + wr * 64 + fr, s0 = row & (SEQ - 1);
              k1 = *(const f32x4*)(kr + (size_t)row * 32 + fq * 4); k2 = *(const f32x4*)(kr + (size_t)row * 32 + 16 + fq * 4); kss = krss[row];
              c4 = *(const f32x4*)(cs + s0 * 16 + fq * 4); s4 = *(const f32x4*)(sn + s0 * 16 + fq * 4); }
#pragma unroll
            for (int ig = 0; ig < 8; ++ig) {
                const int ai = ig >> 2, m = ig & 3;
                const int rl = ai * HALF + wr * 64 + m * 16 + fr, row = u.pm * BM + rl, b = row >> 11, s = row & (SEQ - 1);
                if (ig < 7) { const int rown = u.pm * BM + ((ig + 1) >> 2) * HALF + wr * 64 + ((ig + 1) & 3) * 16 + fr, s1 = rown & (SEQ - 1);
                    k1n = *(const f32x4*)(kr + (size_t)rown * 32 + fq * 4); k2n = *(const f32x4*)(kr + (size_t)rown * 32 + 16 + fq * 4); kssn = krss[rown];
                    c4n = *(const f32x4*)(cs + s1 * 16 + fq * 4); s4n = *(const f32x4*)(sn + s1 * 16 + fq * 4); }
                float ss = 0.f;
#pragma unroll
                for (int bj = 0; bj < 2; ++bj)
#pragma unroll
                    for (int n = 0; n < 2; ++n) { const f32x4 a = acc[ai][bj][m][n]; ss += (a[0] * a[0] + a[1] * a[1]) + (a[2] * a[2] + a[3] * a[3]); }
                ss = quad_sum(ss) + kss;
                const float rn = __builtin_amdgcn_rsqf(ss * (1.0f / 96.0f) + EPS);
                bf16_t* dst = Kc + ((size_t)((b * 6 + head) * SEQ + s)) * 96;
#pragma unroll
                for (int bj = 0; bj < 2; ++bj) {
                    float o[8];
#pragma unroll
                    for (int n = 0; n < 2; ++n)
#pragma unroll
                        for (int j = 0; j < 4; ++j) o[n * 4 + j] = acc[ai][bj][m][n][j] * rn * gk[bj * 8 + n * 4 + j];
                    *(u32x4*)(dst + bj * 32 + fq * 8) = pack8(o);
                }
                float o1[4], o2[4];
#pragma unroll
                for (int j = 0; j < 4; ++j) {
                    const float x1 = k1[j] * rn * gr1[j], x2 = k2[j] * rn * gr2[j];
                    o1[j] = x1 * c4[j] - x2 * s4[j]; o2[j] = x1 * s4[j] + x2 * c4[j];
                }
                *(u32x2*)(dst + 64 + fq * 4) = (u32x2){cvt_pk_bf16(o1[0], o1[1]), cvt_pk_bf16(o1[2], o1[3])};
                *(u32x2*)(dst + 80 + fq * 4) = (u32x2){cvt_pk_bf16(o2[0], o2[1]), cvt_pk_bf16(o2[2], o2[3])};
                k1 = k1n; k2 = k2n; kss = kssn; c4 = c4n; s4 = s4n;
                asm volatile("" ::: "memory");
            }
        }
    }
};

struct EpiMlaQKV {
    static constexpr bool PERM = true, AFTER_DRAIN = false, DUP_OK = false;
    EpiMlaQ eq; EpiMlaKV ekv;
    __device__ __forceinline__ void operator()(const f32x4 (&acc)[2][2][4][2], const Unit& u_, int wr, int wc, int fr, int fq, PG8_LAS float* xs) const {
        if (u_.pn < 3) eq(acc, u_, wr, wc, fr, fq, xs);
        else { Unit v = u_; v.pn -= 3; ekv(acc, v, wr, wc, fr, fq, xs); }
    }
};
template <class Epi, class Sched, bool ALIGN_EPI = false, bool SP2 = false>
__device__ __forceinline__ void gemm_phase(const int tid, PG8_LAS unsigned char* lds, PG8_LAS float* xs, const Gemm g, const Sched& S, const Epi& E) {
    const int wid = __builtin_amdgcn_readfirstlane(tid >> 6), lane = tid & 63, wr = wid >> 2, wc = wid & 3, fr = lane & 15, fq = lane >> 4;
    const int K = g.K, nt = K / BK;
    unsigned voffA[2], voffB[2];
#pragma unroll
    for (int i = 0; i < 2; ++i) { int R, C; stage_rc(tid * 16 + i * 8192, R, C); const int Rb = Epi::PERM ? ((R & ~31) + perm32(R & 31)) : R;
        voffA[i] = (unsigned)(R * g.lda + C) * 2u; voffB[i] = (unsigned)(Rb * g.ldb + C) * 2u; }
    const size_t kstep = (size_t)(BK * 2);
    const size_t hstepA = (size_t)HALF * g.lda * 2, hstepB = (size_t)HALF * g.ldb * 2;
    const size_t tstepA = 2 * hstepA, tstepB = 2 * hstepB;
    const unsigned ldsw = (unsigned)wid * 1024u;
    const int aoff = lds_byte(wr * 64 + fr, fq * 8), boff = lds_byte(wc * 32 + fr, fq * 8);
#define PG8_SA(b, h) (((b) * 2 + (h)) * HTB)
#define PG8_SB(b, h) ((4 + (b) * 2 + (h)) * HTB)
#define PG8_STAGE(bufoff, gbase, voff) do { _Pragma("unroll") for (int _i = 0; _i < 2; ++_i) \
        __builtin_amdgcn_global_load_lds((const unsigned*)((const char*)(gbase) + (voff)[_i]), (PG8_LAS unsigned*)(lds + (bufoff) + ldsw + _i * 8192), 16, 0, 0); } while (0)
#define PG8_LDA(dst, b, h) do { _Pragma("unroll") for (int m = 0; m < 4; ++m) _Pragma("unroll") for (int k = 0; k < 2; ++k) dst[m][k] = *(const PG8_LAS bf16x8*)(lds + PG8_SA(b, h) + aoff + m * 2048 + k * 1024); } while (0)
#define PG8_LDB(dst, b, h) do { _Pragma("unroll") for (int n = 0; n < 2; ++n) _Pragma("unroll") for (int k = 0; k < 2; ++k) dst[n][k] = *(const PG8_LAS bf16x8*)(lds + PG8_SB(b, h) + boff + n * 2048 + k * 1024); } while (0)
#define PG8_MMA(ai, bj, At, Bt) do { __builtin_amdgcn_s_setprio(1); _Pragma("unroll") for (int m = 0; m < 4; ++m) _Pragma("unroll") for (int n = 0; n < 2; ++n) _Pragma("unroll") for (int k = 0; k < 2; ++k) \
        acc[ai][bj][m][n] = __builtin_amdgcn_mfma_f32_16x16x32_bf16(Bt[n][k], At[m][k], acc[ai][bj][m][n], 0, 0, 0); __builtin_amdgcn_s_setprio(0); } while (0)
#define PG8_WAIT_V(n) asm volatile("s_waitcnt vmcnt(" #n ")" ::: "memory")
#define PG8_WAIT_L(n) asm volatile("s_waitcnt lgkmcnt(" #n ")" ::: "memory")
#define PG8_BAR __builtin_amdgcn_s_barrier()
#define PG8_SCHED __builtin_amdgcn_sched_barrier(0)
    Unit cur, nxt; int ui = 0;
    if (!S.next(0, cur)) return;
    f32x4 acc[2][2][4][2];
#pragma unroll
    for (int a = 0; a < 2; ++a)
#pragma unroll
        for (int b = 0; b < 2; ++b)
#pragma unroll
            for (int m = 0; m < 4; ++m)
#pragma unroll
                for (int n = 0; n < 2; ++n) acc[a][b][m][n] = (f32x4){0.f, 0.f, 0.f, 0.f};
    bf16x8 At[4][2], B0[2][2], B1[2][2];
    const char* cA = (const char*)g.A + (size_t)cur.pm * tstepA + (cur.pn >= g.asplit ? g.aoff : 0); const char* cB = (const char*)g.Bt + (size_t)cur.pn * tstepB;
    S.a_ready(cur);
    if constexpr (SP2) {
        PG8_STAGE(PG8_SB(0, 0), cB, voffB); PG8_STAGE(PG8_SB(0, 1), cB + hstepB, voffB); PG8_STAGE(PG8_SA(0, 0), cA, voffA); PG8_STAGE(PG8_SA(0, 1), cA + hstepA, voffA);
        if (wr == 1) PG8_BAR;
        PG8_WAIT_V(2); PG8_BAR;
        PG8_STAGE(PG8_SB(1, 0), cB + kstep, voffB); PG8_STAGE(PG8_SA(1, 0), cA + kstep, voffA); PG8_STAGE(PG8_SB(1, 1), cB + hstepB + kstep, voffB);
        PG8_WAIT_V(6); PG8_BAR;
    } else {
        PG8_STAGE(PG8_SB(0, 0), cB, voffB); PG8_STAGE(PG8_SA(0, 0), cA, voffA); PG8_STAGE(PG8_SB(0, 1), cB + hstepB, voffB); PG8_STAGE(PG8_SA(0, 1), cA + hstepA, voffA);
        if (wr == 1) PG8_BAR;
        PG8_WAIT_V(4); PG8_BAR;
        PG8_STAGE(PG8_SB(1, 0), cB + kstep, voffB); PG8_STAGE(PG8_SA(1, 0), cA + kstep, voffA); PG8_STAGE(PG8_SB(1, 1), cB + hstepB + kstep, voffB);
        PG8_WAIT_V(6); PG8_BAR;
    }
    for (;;) {
        const bool has_next = S.next(ui + 1, nxt);
        const char* nA = has_next ? (const char*)g.A + (size_t)nxt.pm * tstepA + (nxt.pn >= g.asplit ? g.aoff : 0) : cA; const char* nB = has_next ? (const char*)g.Bt + (size_t)nxt.pn * tstepB : cB;
        for (int t = 0; t < nt; t += 2) {
            const bool last = (t == nt - 2);
            const char* a1 = cA + (size_t)(t + 1) * kstep;
            const char* a2 = last ? nA : cA + (size_t)(t + 2) * kstep; const char* b2 = last ? nB : cB + (size_t)(t + 2) * kstep;
            const char* a3 = a2 + kstep; const char* b3 = b2 + kstep;
            if (last && has_next) S.a_ready(nxt);
            if constexpr (SP2) {
            PG8_LDB(B0, 0, 0); PG8_LDB(B1, 0, 1); PG8_SCHED; PG8_LDA(At, 0, 0); PG8_STAGE(PG8_SA(1, 1), a1 + hstepA, voffA);
            PG8_WAIT_V(8); PG8_WAIT_L(0); PG8_BAR; PG8_MMA(0, 0, At, B0); PG8_MMA(0, 1, At, B1); PG8_BAR; PG8_SCHED;
            PG8_LDA(At, 0, 1); PG8_STAGE(PG8_SB(0, 0), b2, voffB); PG8_STAGE(PG8_SB(0, 1), b2 + hstepB, voffB); PG8_STAGE(PG8_SA(0, 0), a2, voffA);
            PG8_WAIT_V(8); PG8_WAIT_L(0); PG8_BAR; PG8_MMA(1, 0, At, B0); PG8_MMA(1, 1, At, B1); PG8_BAR; PG8_SCHED;
            PG8_LDB(B0, 1, 0); PG8_LDB(B1, 1, 1); PG8_SCHED; PG8_LDA(At, 1, 0); PG8_STAGE(PG8_SA(0, 1), a2 + hstepA, voffA);
            PG8_WAIT_V(8); PG8_WAIT_L(0); PG8_BAR; PG8_MMA(0, 0, At, B0); PG8_MMA(0, 1, At, B1); PG8_BAR; PG8_SCHED;
            PG8_LDA(At, 1, 1); PG8_STAGE(PG8_SB(1, 0), b3, voffB); PG8_STAGE(PG8_SB(1, 1), b3 + hstepB, voffB); PG8_STAGE(PG8_SA(1, 0), a3, voffA);
            PG8_WAIT_V(8); PG8_WAIT_L(0); PG8_BAR; PG8_MMA(1, 0, At, B0); PG8_MMA(1, 1, At, B1); PG8_BAR; PG8_SCHED;
            } else {
            PG8_LDB(B0, 0, 0); PG8_SCHED; PG8_LDA(At, 0, 0); PG8_STAGE(PG8_SA(1, 1), a1 + hstepA, voffA);
            PG8_WAIT_L(8); PG8_BAR; PG8_WAIT_L(0); PG8_MMA(0, 0, At, B0); PG8_BAR; PG8_SCHED;
            PG8_LDB(B1, 0, 1); PG8_STAGE(PG8_SB(0, 0), b2, voffB);
            PG8_BAR; PG8_WAIT_L(0); PG8_MMA(0, 1, At, B1); PG8_BAR;
            PG8_LDA(At, 0, 1); PG8_STAGE(PG8_SA(0, 0), a2, voffA);
            PG8_BAR; PG8_WAIT_L(0); PG8_MMA(1, 0, At, B0); PG8_BAR; PG8_SCHED;
            PG8_STAGE(PG8_SB(0, 1), b2 + hstepB, voffB);
            PG8_WAIT_V(6); PG8_BAR; PG8_MMA(1, 1, At, B1); PG8_BAR;
            PG8_LDB(B0, 1, 0); PG8_SCHED; PG8_LDA(At, 1, 0); PG8_STAGE(PG8_SA(0, 1), a2 + hstepA, voffA);
            PG8_WAIT_L(8); PG8_BAR; PG8_WAIT_L(0); PG8_MMA(0, 0, At, B0); PG8_BAR; PG8_SCHED;
            PG8_LDB(B1, 1, 1); PG8_STAGE(PG8_SB(1, 0), b3, voffB);
            PG8_BAR; PG8_WAIT_L(0); PG8_MMA(0, 1, At, B1); PG8_BAR;
            PG8_LDA(At, 1, 1); PG8_STAGE(PG8_SA(1, 0), a3, voffA);
            PG8_BAR; PG8_WAIT_L(0); PG8_MMA(1, 0, At, B0); PG8_BAR; PG8_SCHED;
            PG8_STAGE(PG8_SB(1, 1), b3 + hstepB, voffB);
            PG8_WAIT_V(6); PG8_BAR; PG8_MMA(1, 1, At, B1); PG8_BAR;
            }
        }
        if constexpr (ALIGN_EPI) { if (wr == 0) PG8_BAR; }
        if constexpr (!Epi::AFTER_DRAIN) { E(acc, cur, wr, wc, fr, fq, xs);
#if defined(MK_DUP_EPI)
            if constexpr (Epi::DUP_OK) E(acc, cur, wr, wc, fr, fq, xs);
#endif
            S.done(cur); }
        if (!has_next) break;
#pragma unroll
        for (int a = 0; a < 2; ++a)
#pragma unroll
            for (int b = 0; b < 2; ++b)
#pragma unroll
                for (int m = 0; m < 4; ++m)
#pragma unroll
                    for (int n = 0; n < 2; ++n) acc[a][b][m][n] = (f32x4){0.f, 0.f, 0.f, 0.f};
        cur = nxt; cA = nA; cB = nB; ++ui;
        if constexpr (ALIGN_EPI) { if (wr == 1) PG8_BAR; }
    }
    PG8_WAIT_V(0);
    if constexpr (!ALIGN_EPI) { if (wr == 0) PG8_BAR; }
    PG8_BAR;
    if constexpr (Epi::AFTER_DRAIN) { E(acc, cur, wr, wc, fr, fq, xs); S.done(cur); }
#undef PG8_SA
#undef PG8_SB
#undef PG8_STAGE
#undef PG8_LDA
#undef PG8_LDB
#undef PG8_MMA
#undef PG8_WAIT_V
#undef PG8_WAIT_L
#undef PG8_BAR
#undef PG8_SCHED
}
}

constexpr size_t MiB = 1u << 20;
constexpr size_t WS_CTL = 0, CTL_ZERO_BYTES = 32 * 1024;
constexpr size_t WS_TAB = 1 * MiB;
constexpr size_t WS_P = 2 * MiB;
constexpr size_t WS_KR = 5 * MiB;
constexpr size_t WS_KRSS = 7 * MiB;
constexpr size_t WS_W = 8 * MiB;
constexpr size_t W_GU1 = WS_W, W_GU2 = W_GU1 + 11 * MiB, W_D1 = W_GU2 + 11 * MiB, W_D2 = W_D1 + 5632 * 1024, W_IN = W_D2 + 5632 * 1024, W_O = W_IN + 5 * MiB, W_QU = W_O + 2 * MiB, W_KVU = W_QU + 768 * 256 * 2, W_END = W_KVU + 768 * 256 * 2;
static_assert(W_END <= 50 * MiB, "weights");
constexpr size_t WS_XB = 50 * MiB;
constexpr size_t WS_R = 82 * MiB;
constexpr size_t WS_H = WS_R;
constexpr size_t WS_QD = WS_R, WS_KD = WS_QD + 8 * MiB, WS_VD = WS_KD + 8 * MiB, WS_QL = WS_VD + 8 * MiB, WS_KL = WS_QL + 12 * MiB, WS_VL = WS_KL + 12 * MiB;
constexpr size_t WS_QC = WS_VL + 12 * MiB, WS_KC = WS_QC + 18 * MiB, WS_VC = WS_KC + 18 * MiB, WS_AQ = WS_VC + 12 * MiB, WS_MIX = WS_AQ + 12 * MiB, WS_END = WS_MIX + 32 * MiB;
static_assert(WS_END <= 236 * MiB && WS_H + (size_t)MTOK * DFF * 2 <= WS_MIX, "d_ws map");
constexpr size_t WS_DO0 = 0, WS_DO1 = 12 * MiB, WS_DO2 = 24 * MiB, WS_DL = 36 * MiB, WS_TOTAL = 236 * MiB;
constexpr int TAB_COS = 0, TAB_SIN = 32768;
constexpr int TAB_BD = 65536;
constexpr int TAB_BL = TAB_BD + 2 * 4 * 4096;
constexpr int TAB_SC = TAB_BL + 2 * 6 * 4096;
static_assert((TAB_SC + 64) * 4 <= (int)MiB, "tables");
constexpr int CW_BAR = 4096;

constexpr int RING_BYTES = 131072, XS_OFF = 155648, XS_BYTES = 4096, MISC_OFF = 159744, LDS_BYTES = 163840;

#define GAS __attribute__((address_space(1)))
#define LAS __attribute__((address_space(3)))
typedef unsigned short bf16;
typedef unsigned v4u __attribute__((ext_vector_type(4)));
typedef float f32x4 __attribute__((ext_vector_type(4)));
typedef GAS unsigned gu32;
#define RLX_AGENT __ATOMIC_RELAXED, __HIP_MEMORY_SCOPE_AGENT
#define LDS_WAIT() asm volatile("s_waitcnt lgkmcnt(0)" ::: "memory")
__device__ __forceinline__ unsigned f2bf(float f) { unsigned u = __builtin_bit_cast(unsigned, f); return (u + 0x7fffu + ((u >> 16) & 1u)) >> 16; }
__device__ __forceinline__ unsigned pk2(float lo, float hi) { return f2bf(lo) | (f2bf(hi) << 16); }
__device__ __forceinline__ float bflo(unsigned w) { return __builtin_bit_cast(float, w << 16); }
__device__ __forceinline__ float bfhi(unsigned w) { return __builtin_bit_cast(float, w & 0xffff0000u); }
__device__ __forceinline__ void unpack8(v4u w, float* o) { o[0] = bflo(w.x); o[1] = bfhi(w.x); o[2] = bflo(w.y); o[3] = bfhi(w.y); o[4] = bflo(w.z); o[5] = bfhi(w.z); o[6] = bflo(w.w); o[7] = bfhi(w.w); }

#define XB_TMO      128
#define XB_XCNT(j)  (256  + 64 * (j))
#define XB_XSUB(j)  (1280 + 64 * (j))
#define XB_XGEN(j)  (2304 + 64 * (j))
#define XB_TOP      3328
#define XB_TOPGEN   3392
#define XCD_BAR_WORDS 3456
#define XB_SPIN_CAP (1u << 22)

__device__ __forceinline__ unsigned xb_ld(unsigned* p)              { return __hip_atomic_load(p, __ATOMIC_RELAXED, __HIP_MEMORY_SCOPE_AGENT); }
__device__ __forceinline__ unsigned xb_add(unsigned* p, unsigned v) { return __hip_atomic_fetch_add(p, v, __ATOMIC_RELAXED, __HIP_MEMORY_SCOPE_AGENT); }
__device__ __forceinline__ unsigned xb_xcc_id() { return (unsigned)__builtin_amdgcn_s_getreg((3 << 11) | 20) & 0xFu; }
#define XB_SPIN(cond, bar) do { unsigned _sp = 0; while (cond) { __builtin_amdgcn_s_sleep(1); \
    if ((++_sp & 255u) == 0u) { if (xb_ld(&(bar)[XB_TMO])) break; if (_sp > XB_SPIN_CAP) { atomicAdd(&(bar)[XB_TMO], 1u); break; } } } } while (0)

__device__ __forceinline__ void xcd_barrier_post(unsigned* bar, volatile LAS unsigned* st, bool tid0) {
    if (tid0) { const unsigned x = xb_xcc_id(); st[2] = x; (void)xb_add(&bar[XB_XCNT(x)], 1u); }
}
__device__ __forceinline__ void xcd_barrier_complete(unsigned* bar, unsigned x, unsigned& nloc, unsigned& nx) {
    const unsigned G = gridDim.x * gridDim.y * gridDim.z;
    unsigned sum, cnt, mine, sp = 0u;
    for (;;) {
        sum = 0u; cnt = 0u; mine = 0u;
        for (unsigned j = 0; j < 16; ++j) { const unsigned c = xb_ld(&bar[XB_XCNT(j)]); sum += c; cnt += (c > 0u) ? 1u : 0u; mine = (j == x) ? c : mine; }
        if (sum == G) break;
        __builtin_amdgcn_s_sleep(1);
        if ((++sp & 255u) == 0u) { if (xb_ld(&bar[XB_TMO])) break; if (sp > XB_SPIN_CAP) { atomicAdd(&bar[XB_TMO], 1u); break; } }
    }
    nloc = mine > 0u ? mine : 1u; nx = cnt > 0u ? cnt : 1u;
}
__device__ __forceinline__ void xcd_barrier(unsigned* bar0, volatile LAS unsigned* st, bool tid0) {
    asm volatile("s_waitcnt vmcnt(0)" ::: "memory");
    __syncthreads();
    if (tid0) {
        unsigned* bar = bar0; asm volatile("" : "+v"(bar));
        __builtin_amdgcn_s_waitcnt(0);
        unsigned nloc = st[0], nx = st[1]; const unsigned x = st[2];
        if (nloc == 0u) { xcd_barrier_complete(bar, x, nloc, nx); st[0] = nloc; st[1] = nx; }
#if MK_EARLY_WB
        __builtin_amdgcn_fence(__ATOMIC_RELEASE, "agent");
        asm volatile("s_waitcnt vmcnt(0)" ::: "memory");
#endif
        const unsigned old = xb_add(&bar[XB_XSUB(x)], 1u);
        const unsigned gen = old / nloc;
        if (old + 1u == (gen + 1u) * nloc) {
            __builtin_amdgcn_fence(__ATOMIC_RELEASE, "agent");
            asm volatile("s_waitcnt vmcnt(0)" ::: "memory");
            const unsigned og = xb_add(&bar[XB_TOP], 1u);
            const unsigned tg = og / nx;
            if (og + 1u == (tg + 1u) * nx) xb_add(&bar[XB_TOPGEN], 1u);
            else XB_SPIN(xb_ld(&bar[XB_TOPGEN]) == tg, bar);
            __builtin_amdgcn_fence(__ATOMIC_ACQUIRE, "agent");
            xb_add(&bar[XB_XGEN(x)], 1u);
            asm volatile("s_waitcnt vmcnt(0)" ::: "memory");
        } else {
            XB_SPIN(xb_ld(&bar[XB_XGEN(x)]) == gen, bar);
            __builtin_amdgcn_fence(__ATOMIC_ACQUIRE, "agent");
            asm volatile("s_waitcnt vmcnt(0)" ::: "memory");
        }
    }
    __syncthreads();
}

#ifndef MK_PROBE_BLOCK
#define MK_PROBE_BLOCK 0
#endif
#if MK_PROBE
#define PROBE_T0(var) const unsigned var = (unsigned)__builtin_amdgcn_readfirstlane((int)__builtin_amdgcn_s_memrealtime())
#define PROBE_ADD(id, var, shm) do { if (MK_PROBE == (id) && blockIdx.x == MK_PROBE_BLOCK) { const unsigned d_ = (unsigned)__builtin_amdgcn_s_memrealtime() - (var); \
        volatile LAS unsigned* pm_ = (volatile LAS unsigned*)((LAS unsigned char*)(shm) + MISC_OFF + 96); if (threadIdx.x == 0) pm_[0] = pm_[0] + (unsigned)d_; } } while (0)
#else
#define PROBE_T0(var) do {} while (0)
#define PROBE_ADD(id, var, shm) do {} while (0)
#endif
struct Args { const float* in[25]; float* out; unsigned char* ws; int layer, pad; };
enum { I_X = 0, I_RELB, I_F1N, I_F1G, I_F1U, I_F1D, I_MIXN, I_WIN, I_DQN, I_DKN, I_DLAM, I_DSUB, I_LQN, I_LKN, I_MQN, I_MQU, I_MKVN, I_MKVU, I_MQNG, I_MKNG, I_WO, I_F2N, I_F2G, I_F2U, I_F2D };

__device__ __forceinline__ float wave_sum(float v) { v += swz<1>(v); v += swz<2>(v); v += swz<4>(v); v += swz<8>(v); v += swz<16>(v); return sum_x32(v); }
__device__ __forceinline__ float wave_max(float v) { v = fmaxf(v, swz<1>(v)); v = fmaxf(v, swz<2>(v)); v = fmaxf(v, swz<4>(v)); v = fmaxf(v, swz<8>(v)); v = fmaxf(v, swz<16>(v)); return max_x32(v); }

__device__ __forceinline__ const void* lds_ptr_get(volatile LAS unsigned long long* PT, int i) {
    const unsigned long long v = PT[i];
    const unsigned lo = __builtin_amdgcn_readfirstlane((unsigned)v), hi = __builtin_amdgcn_readfirstlane((unsigned)(v >> 32));
    return (const void*)(((unsigned long long)hi << 32) | lo);
}
#define AIN(i) ((const float*)lds_ptr_get(PT, (i)))
__device__ __forceinline__ void tr_item64(const float* W, int Nsrc, int ks0, const float* gain, int sc, bool valid, bf16* dstrow) {
    float v[64];
    const float* src = W + (size_t)ks0 * Nsrc + sc;
#pragma unroll
    for (int i = 0; i < 64; ++i) v[i] = valid ? src[(size_t)i * Nsrc] : 0.f;
    if (gain) {
        int z = 0; asm volatile("" : "+v"(z));
        const float* gp = gain + ks0 + z;
        float gk[64];
#pragma unroll
        for (int i = 0; i < 64; ++i) gk[i] = gp[i];
#pragma unroll
        for (int i = 0; i < 64; ++i) v[i] *= gk[i];
    }
#pragma unroll
    for (int j = 0; j < 8; ++j) { v4u o; o.x = pk2(v[8 * j], v[8 * j + 1]); o.y = pk2(v[8 * j + 2], v[8 * j + 3]); o.z = pk2(v[8 * j + 4], v[8 * j + 5]); o.w = pk2(v[8 * j + 6], v[8 * j + 7]);
        *(GAS v4u*)(dstrow + 8 * j) = o; }
}

__device__ __forceinline__ void win_map(int g, int& sc, int& nvalid) {
    const int pn = g >> 3, gi = g & 7, bj = gi >> 2, wc = gi & 3; nvalid = 32;
    switch (pn) {
        case 0: sc = 0 + wc * 64 + bj * 32; break;
        case 1: sc = 256 + wc * 64 + bj * 32; break;
        case 2: sc = 512 + wc * 64 + bj * 32; break;
        case 3: sc = 768 + wc * 64 + bj * 32; break;
        case 4: sc = (wc < 2) ? 768 + (4 + wc) * 64 + bj * 32 : 1152 + (wc - 2) * 64 + bj * 32; break;
        case 5: sc = 1152 + (wc + 2) * 64 + bj * 32; break;
        case 6: sc = 1536 + wc * 64 + bj * 32; break;
        case 7: sc = (wc < 2) ? 1536 + (4 + wc) * 64 + bj * 32 : 2176 + (wc - 2) * 64 + bj * 32; break;
        case 8: sc = 1920 + bj * 128 + wc * 32; break;
        default: sc = 2176 + 128 + bj * 16; nvalid = (wc == 0) ? 16 : 0; break;
    }
}

__device__ __forceinline__ void convert_weights(volatile LAS unsigned long long* PT, unsigned char* ws, int l, int sel, int gw, int NGW, int lane) {
    constexpr int I_GU = (5632 / 64) * 16, I_D = 16 * 44, I_IN = 40 * 16, I_O = 16 * 16, I_QU = 12 * 4, I_KVU = 12 * 4;
    constexpr int NITEMS = 2 * I_GU + 2 * I_D + I_IN + I_O + I_QU + I_KVU;
    const int lg = lane >> 5, li = lane & 31;
    for (int it = gw; it < NITEMS; it += NGW) {
        int r = it;
        if (r < 2 * I_GU) {
            const int f = r / I_GU; r -= f * I_GU; if (!((sel >> f) & 1)) continue; const int G2 = r >> 4, kb = r & 15, g = 2 * G2 + lg;
            const int pn = g >> 3, gi = g & 7, bj = gi >> 2, wc = gi & 3;
            const float* Wg = AIN(f == 0 ? I_F1G : I_F2G) + (size_t)l * DM * DFF; const float* Wu = AIN(f == 0 ? I_F1U : I_F2U) + (size_t)l * DM * DFF;
            const float* gain = AIN(f == 0 ? I_F1N : I_F2N) + l * DM;
            bf16* dst = (bf16*)(ws + (f == 0 ? W_GU1 : W_GU2)) + (size_t)(32 * g + li) * DM + 64 * kb;
            tr_item64(bj == 0 ? Wg : Wu, DFF, 64 * kb, gain, pn * 128 + wc * 32 + li, true, dst); continue;
        }
        r -= 2 * I_GU;
        if (r < 2 * I_D) {
            const int f = r / I_D; r -= f * I_D; if (!((sel >> (2 + f)) & 1)) continue; const int G2 = r / 44, kb = r - G2 * 44;
            const float* W = AIN(f == 0 ? I_F1D : I_F2D) + (size_t)l * DFF * DM;
            bf16* dst = (bf16*)(ws + (f == 0 ? W_D1 : W_D2)) + (size_t)(64 * G2 + lane) * DFF + 64 * kb;
            tr_item64(W, DM, 64 * kb, nullptr, 64 * G2 + lane, true, dst); continue;
        }
        r -= 2 * I_D;
        if (r < I_IN) {
            if (!(sel & 16)) continue;
            const int G2 = r >> 4, kb = r & 15, g = 2 * G2 + lg; int sc, nv; win_map(g, sc, nv);
            const float* W = AIN(I_WIN) + (size_t)l * DM * IN_W;
            bf16* dst = (bf16*)(ws + W_IN) + (size_t)(32 * g + li) * DM + 64 * kb;
            tr_item64(W, IN_W, 64 * kb, AIN(I_MIXN) + l * DM, sc + li, li < nv, dst); continue;
        }
        r -= I_IN;
        if (r < I_O) {
            if (!(sel & 32)) continue;
            const int G2 = r >> 4, kb = r & 15;
            bf16* dst = (bf16*)(ws + W_O) + (size_t)(64 * G2 + lane) * DM + 64 * kb;
            tr_item64(AIN(I_WO) + (size_t)l * DM * DM, DM, 64 * kb, nullptr, 64 * G2 + lane, true, dst); continue;
        }
        r -= I_O;
        if (r < I_QU) {
            if (!(sel & 64)) continue;
            const int G2 = r >> 2, kb = r & 3, g = 2 * G2 + lg; const int pn = g >> 3, gi = g & 7, bj = gi >> 2, wc = gi & 3, head = pn * 2 + (wc >> 1);
            const int sc = (wc & 1) ? head * 96 + 64 + 16 * bj : head * 96 + 32 * bj, nv = (wc & 1) ? 16 : 32;
            bf16* dst = (bf16*)(ws + W_QU) + (size_t)(32 * g + li) * 256 + 64 * kb;
            tr_item64(AIN(I_MQU) + (size_t)l * 256 * 576, 576, 64 * kb, AIN(I_MQN) + l * 256, sc + li, li < nv, dst); continue;
        }
        r -= I_QU;
        {
            if (!(sel & 128)) continue;
            const int G2 = r >> 2, kb = r & 3, g = 2 * G2 + lg; const int pn = g >> 3, gi = g & 7, bj = gi >> 2, wc = gi & 3, head = pn * 2 + (wc >> 1);
            const int sc = head * 128 + ((wc & 1) ? 64 : 0) + 32 * bj;
            bf16* dst = (bf16*)(ws + W_KVU) + (size_t)(32 * g + li) * 256 + 64 * kb;
            if (kb < 2) tr_item64(AIN(I_MKVU), 768, 0, nullptr, 0, false, dst);
            else tr_item64(AIN(I_MKVU) + (size_t)l * 128 * 768, 768, 64 * (kb - 2), AIN(I_MKVN) + l * 128, sc + li, true, dst);
        }
    }
}

__device__ __forceinline__ int t5_bucket(int rel) {
    const int n = rel < 0 ? -rel : rel;
    const float nf = (float)(n > 1 ? n : 1);
    int large = 8 + (int)(logf(nf / 8.0f) / 4.852030263919617f * 8.0f);
    large = large < 15 ? large : 15;
    return (rel > 0 ? 16 : 0) + (n < 8 ? n : large);
}

__device__ __forceinline__ void prologue_misc(volatile LAS unsigned long long* PT, unsigned char* ws, int gw, int NGW, int lane, int gtid, int NGT) {
    float* tab = (float*)(ws + WS_TAB);
    for (int i = gtid; i < SEQ * 16; i += NGT) { const int s = i >> 4, j = i & 15; const double inv = pow(10000.0, -(double)j / 16.0), ang = (double)s * inv; tab[TAB_COS + i] = (float)cos(ang); tab[TAB_SIN + i] = (float)sin(ang); }
    for (int l = 0; l < DEPTH; ++l) {
        const float* relb = AIN(I_RELB);
        float mbd = 0.f, mbl = 0.f;
        for (int i = lane; i < 320; i += 64) { const float v = fabsf(relb[i]); if ((i % 10) < 4) mbd = fmaxf(mbd, v); else mbl = fmaxf(mbl, v); }
        mbd = wave_max(mbd); mbl = wave_max(mbl);
        float gq = (lane < 32) ? fabsf(AIN(I_DQN)[l * 32 + lane]) : 0.f, gk = (lane < 32) ? fabsf(AIN(I_DKN)[l * 32 + lane]) : 0.f;
        gq = wave_max(gq); gk = wave_max(gk);
        const float B2d = (5.656854249f * gq * gk + mbd) * LOG2E;
        float lq = fabsf(AIN(I_LQN)[l * 64 + lane]), lk = fabsf(AIN(I_LKN)[l * 64 + lane]);
        lq = wave_max(lq); lk = wave_max(lk);
        const float B2l = (8.0f * lq * lk + mbl) * LOG2E;
        float mq = fmaxf(fabsf(AIN(I_MQNG)[l * 96 + lane]), lane < 32 ? fabsf(AIN(I_MQNG)[l * 96 + 64 + lane]) : 0.f);
        float mk = fmaxf(fabsf(AIN(I_MKNG)[l * 96 + lane]), lane < 32 ? fabsf(AIN(I_MKNG)[l * 96 + 64 + lane]) : 0.f);
        mq = wave_max(mq); mk = wave_max(mk);
        const float B2c = 9.797958971f * mq * mk * LOG2E;
        for (int i = gtid; i < 10 * 4096; i += NGT) {
            const int h = i >> 12, idx = i & 4095, rel = idx - 2048; const int bk = t5_bucket(rel);
            if (h < 4) tab[TAB_BD + (l * 4 + h) * 4096 + idx] = relb[bk * 10 + h] * LOG2E - B2d;
            else tab[TAB_BL + (l * 6 + (h - 4)) * 4096 + idx] = relb[bk * 10 + h] * LOG2E - B2l;
        }
        if (gw == 0) {
            const float* lp = AIN(I_DLAM) + l * 128;
            float s1 = (lane < 32) ? lp[lane] * lp[32 + lane] : 0.f, s2 = (lane < 32) ? lp[64 + lane] * lp[96 + lane] : 0.f;
            s1 = wave_sum(s1); s2 = wave_sum(s2);
            const float linit = 0.8f - 0.6f * expf(-0.3f * (float)(l + 1));
            if (lane == 0) { tab[TAB_SC + l * 8 + 0] = expf(s1) - expf(s2) + linit; tab[TAB_SC + l * 8 + 1] = 1.0f - linit; tab[TAB_SC + l * 8 + 2] = -B2c; }
        }
    }
    float* P0 = (float*)(ws + WS_P);
    const float* xin = AIN(I_X);
    for (int m0 = gw * 4; m0 < MTOK; m0 += NGW * 4) {
        f32x4 v[4][4];
#pragma unroll
        for (int r = 0; r < 4; ++r)
#pragma unroll
            for (int j = 0; j < 4; ++j) v[r][j] = ((const GAS f32x4*)(xin + (size_t)(m0 + r) * DM) + lane)[64 * j];
#pragma unroll
        for (int r = 0; r < 4; ++r) {
            GAS unsigned long long* o8 = (GAS unsigned long long*)((bf16*)(ws + WS_XB) + (size_t)(m0 + r) * DM) + lane;
            float s = 0.f;
#pragma unroll
            for (int j = 0; j < 4; ++j) { const f32x4 w = v[r][j]; s += (w.x * w.x + w.y * w.y) + (w.z * w.z + w.w * w.w);
                o8[64 * j] = (unsigned long long)pk2(w.x, w.y) | ((unsigned long long)pk2(w.z, w.w) << 32); }
            s = wave_sum(s);
            if (lane < 16) P0[(size_t)(m0 + r) * 16 + lane] = lane == 0 ? s : 0.f;
        }
    }
}

namespace att {
typedef short bf16x8 __attribute__((ext_vector_type(8)));
typedef short s16x4 __attribute__((ext_vector_type(4)));
typedef short v4i16_t __attribute__((ext_vector_type(4)));
typedef float f32x16 __attribute__((ext_vector_type(16)));
typedef unsigned u32x4 __attribute__((ext_vector_type(4)));
typedef __attribute__((address_space(3))) const char* lds_cptr;
typedef __attribute__((address_space(3))) char* lds_ptr;
typedef float f32x2_t __attribute__((ext_vector_type(2))); typedef __bf16 bf16x2_t __attribute__((ext_vector_type(2)));
__device__ __forceinline__ int crow(int r, int hi) { return (r & 3) + 8 * (r >> 2) + 4 * hi; }
__device__ __forceinline__ void glds16(const void* gsrc, unsigned lds_dst) { unsigned keep;
    asm volatile("s_mov_b32 %0, m0\n\ts_mov_b32 m0, %2\n\ts_nop 0\n\tglobal_load_lds_dwordx4 %1, off\n\ts_mov_b32 m0, %0" : "=&s"(keep) : "v"(gsrc), "s"(lds_dst) : "memory"); }
__device__ __forceinline__ unsigned cvtpk_s(float lo, float hi) { f32x2_t v = {lo, hi}; bf16x2_t b = __builtin_convertvector(v, bf16x2_t); return __builtin_bit_cast(unsigned, b); }
__device__ __forceinline__ s16x4 vtr(lds_cptr p) { return __builtin_bit_cast(s16x4, __builtin_amdgcn_ds_read_tr16_b64_v4i16((__attribute__((address_space(3))) v4i16_t*)p)); }
#define ATT_WAIT_BAR(N) asm volatile("s_waitcnt vmcnt(" #N ") lgkmcnt(0)\n\ts_barrier" ::: "memory")
#define ATT_BAR() asm volatile("s_waitcnt lgkmcnt(0)\n\ts_barrier" ::: "memory")

__device__ __forceinline__ void pack_p(const f32x16& p0, const f32x16& p1, bf16x8 (&pa)[4]) {
    u32x4 w;
    w = (u32x4){cvtpk_s(p0[0], p0[1]), cvtpk_s(p0[2], p0[3]), cvtpk_s(p0[4], p0[5]), cvtpk_s(p0[6], p0[7])}; pa[0] = __builtin_bit_cast(bf16x8, w);
    w = (u32x4){cvtpk_s(p0[8], p0[9]), cvtpk_s(p0[10], p0[11]), cvtpk_s(p0[12], p0[13]), cvtpk_s(p0[14], p0[15])}; pa[1] = __builtin_bit_cast(bf16x8, w);
    w = (u32x4){cvtpk_s(p1[0], p1[1]), cvtpk_s(p1[2], p1[3]), cvtpk_s(p1[4], p1[5]), cvtpk_s(p1[6], p1[7])}; pa[2] = __builtin_bit_cast(bf16x8, w);
    w = (u32x4){cvtpk_s(p1[8], p1[9]), cvtpk_s(p1[10], p1[11]), cvtpk_s(p1[12], p1[13]), cvtpk_s(p1[14], p1[15])}; pa[3] = __builtin_bit_cast(bf16x8, w);
}
__device__ __forceinline__ void pv64(f32x16& o0, f32x16& o1, lds_cptr vp, const bf16x8 (&pa)[4]) {
#pragma unroll
    for (int ks = 0; ks < 4; ++ks) {
        const s16x4 a = vtr(vp + ks * 1024), b = vtr(vp + ks * 1024 + 512);
        const bf16x8 v = {a[0], a[1], a[2], a[3], b[0], b[1], b[2], b[3]};
        o0 = __builtin_amdgcn_mfma_f32_32x32x16_bf16(pa[ks], v, o0, 0, 0, 0);
    }
#pragma unroll
    for (int ks = 0; ks < 4; ++ks) {
        const s16x4 a = vtr(vp + 4096 + ks * 1024), b = vtr(vp + 4096 + ks * 1024 + 512);
        const bf16x8 v = {a[0], a[1], a[2], a[3], b[0], b[1], b[2], b[3]};
        o1 = __builtin_amdgcn_mfma_f32_32x32x16_bf16(pa[ks], v, o1, 0, 0, 0);
    }
}
__device__ __forceinline__ void pv32(f32x16& o0, f32x16& o1, lds_cptr vp, const bf16x8& pa0, const bf16x8& pa1) {
#pragma unroll
    for (int d0 = 0; d0 < 2; ++d0) {
        const s16x4 a = vtr(vp + d0 * 4096), b = vtr(vp + d0 * 4096 + 512), c = vtr(vp + d0 * 4096 + 1024), d = vtr(vp + d0 * 4096 + 1536);
        const bf16x8 v0 = {a[0], a[1], a[2], a[3], b[0], b[1], b[2], b[3]}, v1 = {c[0], c[1], c[2], c[3], d[0], d[1], d[2], d[3]};
        if (d0 == 0) { o0 = __builtin_amdgcn_mfma_f32_32x32x16_bf16(pa0, v0, o0, 0, 0, 0); o0 = __builtin_amdgcn_mfma_f32_32x32x16_bf16(pa1, v1, o0, 0, 0, 0); }
        else { o1 = __builtin_amdgcn_mfma_f32_32x32x16_bf16(pa0, v0, o1, 0, 0, 0); o1 = __builtin_amdgcn_mfma_f32_32x32x16_bf16(pa1, v1, o1, 0, 0, 0); }
    }
}
__device__ __forceinline__ float exp_sum1(f32x16& p) {
    float s0 = 0.f, s1 = 0.f;
#pragma unroll
    for (int r = 0; r < 16; r += 2) { p[r] = __builtin_amdgcn_exp2f(p[r]); p[r + 1] = __builtin_amdgcn_exp2f(p[r + 1]); s0 += p[r]; s1 += p[r + 1]; }
    return s0 + s1;
}
__device__ __forceinline__ void pack_p1(const f32x16& p, bf16x8& pa0, bf16x8& pa1) {
    u32x4 w;
    w = (u32x4){cvtpk_s(p[0], p[1]), cvtpk_s(p[2], p[3]), cvtpk_s(p[4], p[5]), cvtpk_s(p[6], p[7])}; pa0 = __builtin_bit_cast(bf16x8, w);
    w = (u32x4){cvtpk_s(p[8], p[9]), cvtpk_s(p[10], p[11]), cvtpk_s(p[12], p[13]), cvtpk_s(p[14], p[15])}; pa1 = __builtin_bit_cast(bf16x8, w);
}
__device__ __forceinline__ float exp_sum(f32x16& p0, f32x16& p1) {
    float s0 = 0.f, s1 = 0.f;
#pragma unroll
    for (int r = 0; r < 16; ++r) { p0[r] = __builtin_amdgcn_exp2f(p0[r]); p1[r] = __builtin_amdgcn_exp2f(p1[r]); s0 += p0[r]; s1 += p1[r]; }
    return s0 + s1;
}
__device__ __forceinline__ float half_swap_sum(float v) {
    return sum_x32(v);
}

constexpr int DN_RING = 40960, DN_BUF = 20480, DN_TAB = 81920, DN_WSF = 98304, DN_OST = 100352;
constexpr int ML_RING = 61440, ML_WSF = 122880, ML_OST = 124928;

__device__ __forceinline__ void store_o64(const f32x16& o0, const f32x16& o1, const float (&sc)[16], lds_ptr stg, bf16* orow0, int pitch, int lane) {
    asm volatile("" : "+v"(lane));
    const int r32 = lane & 31, hi = lane >> 5;
    __attribute__((address_space(3))) unsigned short* s = (__attribute__((address_space(3))) unsigned short*)stg;
#pragma unroll
    for (int r = 0; r < 16; ++r) { const int orow = crow(r, hi);
        s[orow * 64 + r32] = (unsigned short)f2bf(o0[r] * sc[r]); s[orow * 64 + 32 + r32] = (unsigned short)f2bf(o1[r] * sc[r]); }
    asm volatile("s_waitcnt lgkmcnt(0)" ::: "memory");
#pragma unroll
    for (int i = 0; i < 4; ++i) { const int row = i * 8 + (lane >> 3), ch = lane & 7;
        const u32x4 v = *(const __attribute__((address_space(3))) u32x4*)(stg + row * 128 + ch * 16); *(u32x4*)(orow0 + (size_t)row * pitch + ch * 8) = v; }
}

__device__ __forceinline__ void mla_unit(const unsigned char* ws, const int tid, int l, int u, char* shm) {
    const int lane = tid & 63, r32 = lane & 31, hi = lane >> 5, wid = __builtin_amdgcn_readfirstlane(tid >> 6), w4 = wid & 3, g = wid >> 2;
    PROBE_T0(pt5_);
    const int bh = u >> 4, q0 = (u & 15) * 128 + w4 * 32;
    const bf16* Qb = (const bf16*)(ws + WS_QC) + ((size_t)bh * SEQ + q0) * 96;
    const bf16* Kb = (const bf16*)(ws + WS_KC) + ((size_t)bh * SEQ + g * 1024) * 96;
    const bf16* Vb = (const bf16*)(ws + WS_VC) + ((size_t)bh * SEQ + g * 1024) * 64;
    const float nb2 = ((const float*)(ws + WS_TAB))[TAB_SC + l * 8 + 2];
    const unsigned lds0 = (unsigned)(uintptr_t)shm; const lds_cptr shm3 = (lds_cptr)shm;
    const unsigned ring = lds0 + g * ML_RING;
    int koffs[3];
#pragma unroll
    for (int i = 0; i < 3; ++i) { const int idx = 64 * (w4 + 4 * i) + lane, row = idx / 12, slot = idx - 12 * row; koffs[i] = row * 96 + ((slot & ~3) | ((slot & 3) ^ ((row >> 2) & 3))) * 8; }
    const bf16* vsrc = Vb + (size_t)(16 * w4 + (lane >> 2)) * 64 + (lane & 3) * 8;
#define MLA_DMA_K(t, buf) do { const unsigned d_ = (unsigned)__builtin_amdgcn_readfirstlane(ring + (buf) * DN_BUF + w4 * 1024); \
        const bf16* kt_ = Kb + (size_t)(t) * 64 * 96; glds16(kt_ + koffs[0], d_); glds16(kt_ + koffs[1], d_ + 4096); glds16(kt_ + koffs[2], d_ + 8192); } while (0)
#define MLA_DMA_V(t, buf) do { const unsigned d_ = (unsigned)__builtin_amdgcn_readfirstlane(ring + (buf) * DN_BUF + w4 * 1024); \
        glds16(vsrc + (size_t)(t) * 64 * 64, d_ + 12288); glds16(vsrc + (size_t)(t) * 64 * 64 + 32, d_ + 12288 + 4096); } while (0)
    MLA_DMA_K(0, 0); MLA_DMA_K(1, 1); MLA_DMA_V(0, 0);
    bf16x8 qr[6];
#pragma unroll
    for (int d0 = 0; d0 < 6; ++d0) qr[d0] = *(const bf16x8*)(Qb + (size_t)r32 * 96 + d0 * 16 + hi * 8);
    asm volatile("" : "+v"(qr[0]), "+v"(qr[1]), "+v"(qr[2]), "+v"(qr[3]), "+v"(qr[4]), "+v"(qr[5]));
    f32x16 o0 = {}, o1 = {}; float lsum = 0.f;
    const int kx = (r32 >> 2) & 3;
    const lds_cptr kpe0 = shm3 + g * ML_RING + r32 * 192 + ((hi ^ kx) << 4), kpe1 = shm3 + g * ML_RING + r32 * 192 + (((2 + hi) ^ kx) << 4);
    const lds_cptr vp0 = shm3 + g * ML_RING + 12288 + ((lane >> 4) & 1) * 32 + (lane & 3) * 8 + (4 * hi + ((lane & 15) >> 2)) * 64;
#define MLA_QK(P0, P1, buf) do { \
        _Pragma("unroll") for (int r = 0; r < 16; ++r) { P0[r] = nb2; P1[r] = nb2; } \
        _Pragma("unroll") for (int d0 = 0; d0 < 6; ++d0) { const lds_cptr kp = ((d0 & 1) ? kpe1 : kpe0) + (buf) * DN_BUF + (d0 >> 1) * 64; \
            const bf16x8 a0 = *(const __attribute__((address_space(3))) bf16x8*)(kp), a1 = *(const __attribute__((address_space(3))) bf16x8*)(kp + 6144); \
            P0 = __builtin_amdgcn_mfma_f32_32x32x16_bf16(a0, qr[d0], P0, 0, 0, 0); P1 = __builtin_amdgcn_mfma_f32_32x32x16_bf16(a1, qr[d0], P1, 0, 0, 0); } } while (0)
#define MLA_SMPV(P0, P1, buf) do { lsum += exp_sum(P0, P1); bf16x8 pa[4]; pack_p(P0, P1, pa); pv64(o0, o1, vp0 + (buf) * DN_BUF, pa); } while (0)
    {
        f32x16 p0, p1;
        ATT_WAIT_BAR(5);
        MLA_DMA_K(2, 2); MLA_DMA_V(1, 1);
        MLA_QK(p0, p1, 0);
        int bk = 1, bk2 = 0, bv = 0, bv1 = 2;
        for (int t = 1; t < 16; ++t) {
#if MK_PROBE == 10 || MK_PROBE == 11
            { PROBE_T0(pta_); asm volatile("s_waitcnt vmcnt(5) lgkmcnt(0)" ::: "memory"); PROBE_ADD(10, pta_, shm3); PROBE_T0(ptb_); asm volatile("s_barrier" ::: "memory"); PROBE_ADD(11, ptb_, shm3); }
#else
            { PROBE_T0(pt6_); ATT_WAIT_BAR(5); PROBE_ADD(6, pt6_, shm3); }
#endif
            { const int kn = t + 2 < 16 ? t + 2 : 15, vn = t + 1 < 16 ? t + 1 : 15; MLA_DMA_K(kn, bk2); MLA_DMA_V(vn, bv1); }
            MLA_SMPV(p0, p1, bv);
            MLA_QK(p0, p1, bk);
            bk = bk == 2 ? 0 : bk + 1; bk2 = bk2 == 2 ? 0 : bk2 + 1; bv = bv == 2 ? 0 : bv + 1; bv1 = bv1 == 2 ? 0 : bv1 + 1;
        }
        ATT_WAIT_BAR(0);
        MLA_SMPV(p0, p1, bv);
    }
    ATT_WAIT_BAR(0);
    PROBE_T0(pt7_);
#undef MLA_QK
#undef MLA_SMPV
#undef MLA_DMA_K
#undef MLA_DMA_V
#define MLA_DMA(t, buf) do {} while (0)
#undef MLA_DMA
    int lane_t = lane; asm volatile("" : "+v"(lane_t));
    const int r32t = lane_t & 31, hit = lane_t >> 5;
    __attribute__((address_space(3))) float* Cs = (__attribute__((address_space(3))) float*)shm3;
    if (g == 1) {
#pragma unroll
        for (int r = 0; r < 16; ++r) { Cs[(w4 * 33 + r) * 64 + lane_t] = o0[r]; Cs[(w4 * 33 + 16 + r) * 64 + lane_t] = o1[r]; }
        Cs[(w4 * 33 + 32) * 64 + lane_t] = lsum;
    }
    ATT_BAR();
    if (g == 0) {
#pragma unroll
        for (int r = 0; r < 16; ++r) { o0[r] += Cs[(w4 * 33 + r) * 64 + lane_t]; o1[r] += Cs[(w4 * 33 + 16 + r) * 64 + lane_t]; }
        lsum += Cs[(w4 * 33 + 32) * 64 + lane_t];
        lsum = half_swap_sum(lsum);
        __attribute__((address_space(3))) float* wsf = (__attribute__((address_space(3))) float*)(shm3 + ML_WSF) + wid * 64;
        if (hit == 0) wsf[r32t] = __builtin_amdgcn_rcpf(lsum);
        asm volatile("s_waitcnt lgkmcnt(0)" ::: "memory");
        float sc[16];
#pragma unroll
        for (int r = 0; r < 16; ++r) sc[r] = wsf[crow(r, hit)];
        const int b = bh / 6, h = bh - b * 6;
        store_o64(o0, o1, sc, (lds_ptr)(shm3 + ML_OST + w4 * 4096), (bf16*)(ws + WS_MIX) + ((size_t)(b * SEQ + q0)) * DM + 640 + h * 64, DM, lane_t);
    }
    ATT_BAR();
    PROBE_ADD(7, pt7_, shm3); PROBE_ADD(5, pt5_, shm3);
}

__device__ __forceinline__ void diff_unit(const unsigned char* ws, const float* sub, const int tid, int l, int u, char* shm) {
    const int lane = tid & 63, r32 = lane & 31, hi = lane >> 5, wid = __builtin_amdgcn_readfirstlane(tid >> 6), w4 = wid & 3, g = wid >> 2;
    PROBE_T0(pt8_);
    const int bh = u >> 4, q0 = (u & 15) * 128 + w4 * 32, b = bh >> 2, h = bh & 3;
    const bf16* Q0 = (const bf16*)(ws + WS_QD) + ((size_t)(bh * 2) * SEQ + q0) * 32;
    const bf16* K0 = (const bf16*)(ws + WS_KD) + ((size_t)(bh * 2) * SEQ + g * 1024) * 32;
    const bf16* Vb = (const bf16*)(ws + WS_VD) + ((size_t)bh * SEQ + g * 1024) * 64;
    const float* tabg = (const float*)(ws + WS_TAB) + TAB_BD + (l * 4 + h) * 4096;
    const unsigned lds0 = (unsigned)(uintptr_t)shm; const lds_cptr shm3 = (lds_cptr)shm;
    const unsigned ring = lds0 + g * DN_RING;
    const bf16* ksrc = K0 + (size_t)(16 * w4 + (lane >> 2)) * 32 + (((lane & 3) ^ ((lane >> 4) & 3)) * 8);
    const bf16* vsrc = Vb + (size_t)(16 * w4 + (lane >> 2)) * 64 + (lane & 3) * 8;
#define DIFF_KOFF(t) (((t) & 1) * 8192)
#define DIFF_VOFF(t) (16384 + ((t) % 3) * 8192)
#define DIFF_DMA_K(t) do { const unsigned d_ = (unsigned)__builtin_amdgcn_readfirstlane(ring + DIFF_KOFF(t) + w4 * 1024); \
        glds16(ksrc + (size_t)(t) * 64 * 32, d_); glds16(ksrc + (size_t)SEQ * 32 + (size_t)(t) * 64 * 32, d_ + 4096); } while (0)
#define DIFF_DMA_V(t) do { const unsigned d_ = (unsigned)__builtin_amdgcn_readfirstlane(ring + DIFF_VOFF(t) + w4 * 1024); \
        glds16(vsrc + (size_t)(t) * 64 * 64, d_); glds16(vsrc + (size_t)(t) * 64 * 64 + 32, d_ + 4096); } while (0)
    DIFF_DMA_K(0); DIFF_DMA_V(0);
    { __attribute__((address_space(3))) float* tl = (__attribute__((address_space(3))) float*)(shm3 + DN_TAB);
#pragma unroll
      for (int i = 0; i < 2; ++i) { const f32x4 v = *(const f32x4*)(tabg + (i * 512 + tid) * 4); *(__attribute__((address_space(3))) f32x4*)(tl + (i * 512 + tid) * 4) = v; } }
    bf16x8 qr[2][2];
#pragma unroll
    for (int c = 0; c < 2; ++c)
#pragma unroll
        for (int d0 = 0; d0 < 2; ++d0) qr[c][d0] = *(const bf16x8*)(Q0 + (size_t)c * SEQ * 32 + (size_t)r32 * 32 + d0 * 16 + hi * 8);
    asm volatile("" : "+v"(qr[0][0]), "+v"(qr[0][1]), "+v"(qr[1][0]), "+v"(qr[1][1]));
    f32x16 oa0 = {}, oa1 = {}, ob0 = {}, ob1 = {}; float lsa = 0.f, lsb = 0.f;
    const int kx = (r32 >> 2) & 3;
    const lds_cptr kpe0 = shm3 + g * DN_RING + r32 * 64 + ((hi ^ kx) << 4), kpe1 = shm3 + g * DN_RING + r32 * 64 + (((2 + hi) ^ kx) << 4);
    const lds_cptr vp0 = shm3 + g * DN_RING + ((lane >> 4) & 1) * 32 + (lane & 3) * 8 + (4 * hi + ((lane & 15) >> 2)) * 64;
    const __attribute__((address_space(3))) float* tb0 = (const __attribute__((address_space(3))) float*)(shm3 + DN_TAB) + (2048 + g * 1024 - q0 + 4 * hi - r32);
#define DIFF_QK(S0, S1, t, blk) do { const __attribute__((address_space(3))) float* tb = tb0 + (t) * 64 + (blk) * 32; int koff_ = __builtin_amdgcn_readfirstlane(DIFF_KOFF(t) + (blk) * 2048); asm volatile("" : "+s"(koff_)); \
        _Pragma("unroll") for (int r = 0; r < 16; ++r) { S0[r] = tb[(r & 3) + 8 * (r >> 2)]; S1[r] = S0[r]; } \
        _Pragma("unroll") for (int d0 = 0; d0 < 2; ++d0) { \
            const lds_cptr kp = (d0 ? kpe1 : kpe0) + koff_; const bf16x8 a0 = *(const __attribute__((address_space(3))) bf16x8*)(kp), a1 = *(const __attribute__((address_space(3))) bf16x8*)(kp + 4096); \
            S0 = __builtin_amdgcn_mfma_f32_32x32x16_bf16(a0, qr[0][d0], S0, 0, 0, 0); S1 = __builtin_amdgcn_mfma_f32_32x32x16_bf16(a1, qr[1][d0], S1, 0, 0, 0); } __builtin_amdgcn_sched_barrier(0); } while (0)
#define DIFF_SMPV(S0, S1, t, blk) do { int voff_ = __builtin_amdgcn_readfirstlane(DIFF_VOFF(t) + (blk) * 2048); asm volatile("" : "+s"(voff_)); const lds_cptr vpb = vp0 + voff_; bf16x8 pa0, pa1; \
        lsa += exp_sum1(S0); pack_p1(S0, pa0, pa1); pv32(oa0, oa1, vpb, pa0, pa1); \
        __builtin_amdgcn_sched_barrier(0); lsb += exp_sum1(S1); pack_p1(S1, pa0, pa1); pv32(ob0, ob1, vpb, pa0, pa1); __builtin_amdgcn_sched_barrier(0); } while (0)
    {
        f32x16 s0, s1, u0, u1;
        ATT_WAIT_BAR(0);
        DIFF_DMA_K(1); DIFF_DMA_V(1);
        DIFF_QK(s0, s1, 0, 0); DIFF_SMPV(s0, s1, 0, 0); DIFF_QK(u0, u1, 0, 1);
        for (int t = 1; t < 16; ++t) {
            { PROBE_T0(pt9_); ATT_WAIT_BAR(0); PROBE_ADD(9, pt9_, shm3); }
            if (t + 1 < 16) { DIFF_DMA_K(t + 1); DIFF_DMA_V(t + 1); }
            DIFF_SMPV(u0, u1, t - 1, 1); DIFF_QK(s0, s1, t, 0);
            DIFF_SMPV(s0, s1, t, 0); DIFF_QK(u0, u1, t, 1);
        }
        ATT_WAIT_BAR(0);
        DIFF_SMPV(u0, u1, 15, 1);
    }
    ATT_WAIT_BAR(0);
#undef DIFF_QK
#undef DIFF_SMPV
#undef DIFF_DMA_K
#undef DIFF_DMA_V
#undef DIFF_KOFF
#undef DIFF_VOFF
#define DIFF_DMA(t, buf) do {} while (0)
#undef DIFF_DMA
    int lane_t = lane; asm volatile("" : "+v"(lane_t));
    const int r32t = lane_t & 31, hit = lane_t >> 5;
    __attribute__((address_space(3))) float* Cs = (__attribute__((address_space(3))) float*)shm3 + w4 * 66 * 64;
    if (g == 1) {
#pragma unroll
        for (int r = 0; r < 16; ++r) { Cs[r * 64 + lane_t] = oa0[r]; Cs[(16 + r) * 64 + lane_t] = oa1[r]; Cs[(32 + r) * 64 + lane_t] = ob0[r]; Cs[(48 + r) * 64 + lane_t] = ob1[r]; }
        Cs[64 * 64 + lane_t] = lsa; Cs[65 * 64 + lane_t] = lsb;
    }
    ATT_BAR();
    if (g == 0) {
#pragma unroll
        for (int r = 0; r < 16; ++r) { oa0[r] += Cs[r * 64 + lane_t]; oa1[r] += Cs[(16 + r) * 64 + lane_t]; ob0[r] += Cs[(32 + r) * 64 + lane_t]; ob1[r] += Cs[(48 + r) * 64 + lane_t]; }
        lsa += Cs[64 * 64 + lane_t]; lsb += Cs[65 * 64 + lane_t];
        lsa = half_swap_sum(lsa); lsb = half_swap_sum(lsb);
        const float* sc = (const float*)(ws + WS_TAB) + TAB_SC + l * 8; const float lam = sc[0], post = sc[1];
        __attribute__((address_space(3))) float* wsf = (__attribute__((address_space(3))) float*)(shm3 + DN_WSF) + wid * 64;
        if (hit == 0) { wsf[r32t] = __builtin_amdgcn_rcpf(lsa); wsf[32 + r32t] = lam * __builtin_amdgcn_rcpf(lsb); }
        asm volatile("s_waitcnt lgkmcnt(0)" ::: "memory");
        __attribute__((address_space(3))) float* As = Cs;
#pragma unroll
        for (int r = 0; r < 16; ++r) { const int q = crow(r, hit); const float s0 = wsf[q], s1 = wsf[32 + q];
            As[q * 65 + r32t] = oa0[r] * s0 - ob0[r] * s1; As[q * 65 + 32 + r32t] = oa1[r] * s0 - ob1[r] * s1; }
        asm volatile("s_waitcnt lgkmcnt(0)" ::: "memory");
        const int row = lane_t >> 1, hf = lane_t & 1;
        float v[32]; float ss = 0.f;
#pragma unroll
        for (int i = 0; i < 32; ++i) { v[i] = As[row * 65 + hf * 32 + i]; ss += v[i] * v[i]; }
        ss += swz<1>(ss);
        const float rn = __builtin_amdgcn_rsqf(ss * (1.0f / 64.0f) + EPS) * post;
        bf16* dst = (bf16*)(ws + WS_MIX) + ((size_t)(b * SEQ + q0 + row)) * DM + h * 64 + hf * 32;
#pragma unroll
        for (int i = 0; i < 4; ++i) { u32x4 w;
            w.x = cvtpk_s(v[8 * i] * rn * sub[hf * 32 + 8 * i], v[8 * i + 1] * rn * sub[hf * 32 + 8 * i + 1]); w.y = cvtpk_s(v[8 * i + 2] * rn * sub[hf * 32 + 8 * i + 2], v[8 * i + 3] * rn * sub[hf * 32 + 8 * i + 3]);
            w.z = cvtpk_s(v[8 * i + 4] * rn * sub[hf * 32 + 8 * i + 4], v[8 * i + 5] * rn * sub[hf * 32 + 8 * i + 5]); w.w = cvtpk_s(v[8 * i + 6] * rn * sub[hf * 32 + 8 * i + 6], v[8 * i + 7] * rn * sub[hf * 32 + 8 * i + 7]);
            *(u32x4*)(dst + 8 * i) = w; }
    }
    ATT_BAR();
    PROBE_ADD(8, pt8_, shm3);
}

__device__ __forceinline__ void dil_prefetch(const unsigned char* ws, const int tid, int bh, int br, int chunk, unsigned lds_dummy) {
    const int wid = __builtin_amdgcn_readfirstlane(tid >> 6);
    if (wid < 6) {
        const int s = wid, within = tid & 63, dsh = 2 * br, L = SEQ >> dsh;
        int res, k0;
        if (br == 2) { res = 2 * chunk + ((s >> 1) & 1); k0 = 64 * (s & 1); }
        else { res = br == 1 ? (chunk >> 1) : 0; k0 = (br == 1 ? 256 * (chunk & 1) : 256 * chunk) - 64 + 64 * s; }
        int ki = k0 + within; ki = ki < 0 ? 0 : (ki > L - 1 ? L - 1 : ki);
        const size_t off = ((size_t)bh * SEQ + res + ((size_t)ki << dsh)) * 64;
        const unsigned d_ = (unsigned)__builtin_amdgcn_readfirstlane(lds_dummy + wid * 1024);
        glds16((const bf16*)(ws + WS_KL) + off, d_); glds16((const bf16*)(ws + WS_VL) + off, d_);
    }
}

constexpr int DL_SLOT = 16384, DL_TAB = 98304, DL_WSF = 114688;
template <int DIL> __device__ __forceinline__ void dil_unit(const unsigned char* ws, unsigned char* wsw, const int tid, int l, int bh, int chunk, int nud, char* shm) {
    constexpr int L = SEQ / DIL, BR = DIL == 1 ? 0 : (DIL == 4 ? 1 : 2), NSLOT = DIL == 16 ? 4 : 6, NTW = DIL == 16 ? 2 : 3;
    const int lane = tid & 63, r32 = lane & 31, hi = lane >> 5, wid = __builtin_amdgcn_readfirstlane(tid >> 6);
    const int h = bh % 6, b = bh / 6;
    const bf16* Qb = (const bf16*)(ws + WS_QL) + (size_t)bh * SEQ * 64; const bf16* Kb = (const bf16*)(ws + WS_KL) + (size_t)bh * SEQ * 64; const bf16* Vb = (const bf16*)(ws + WS_VL) + (size_t)bh * SEQ * 64;
    const float* tabg = (const float*)(ws + WS_TAB) + TAB_BL + (l * 6 + h) * 4096;
    const unsigned lds0 = (unsigned)(uintptr_t)shm; const lds_cptr shm3 = (lds_cptr)shm;
    PROBE_T0(pt4_);
    int res_w, qidx0, tf;
    if (DIL == 16) { res_w = 2 * chunk + (wid >> 2); qidx0 = 32 * (wid & 3); tf = 2 * (wid >> 2); }
    else if (DIL == 4) { res_w = chunk >> 1; qidx0 = 256 * (chunk & 1) + 32 * wid; tf = wid >> 1; }
    else { res_w = 0; qidx0 = 256 * chunk + 32 * wid; tf = wid >> 1; }
    const int t0idx = DIL == 16 ? 0 : (DIL == 4 ? 256 * (chunk & 1) - 64 : 256 * chunk - 64);
#pragma unroll
    for (int s = 0; s < NSLOT; ++s) {
        const int res_s = DIL == 16 ? 2 * chunk + (s >> 1) : res_w, k0 = DIL == 16 ? 64 * (s & 1) : t0idx + 64 * s;
        int ki = k0 + 8 * wid + (lane >> 3); ki = ki < 0 ? 0 : (ki > L - 1 ? L - 1 : ki);
        int vi = k0 + 16 * (wid & 3) + (lane >> 2); vi = vi < 0 ? 0 : (vi > L - 1 ? L - 1 : vi);
        const unsigned d_ = (unsigned)__builtin_amdgcn_readfirstlane(lds0 + s * DL_SLOT + wid * 1024);
        glds16(Kb + (size_t)(res_s + DIL * ki) * 64 + (((lane & 7) ^ (((8 * wid + (lane >> 3)) >> 1) & 7)) * 8), d_);
        glds16(Vb + (size_t)(res_s + DIL * vi) * 64 + (wid >> 2) * 32 + (lane & 3) * 8, d_ + 8192);
    }
    if (tid < 256) ((__attribute__((address_space(3))) float*)(shm3 + DL_TAB))[tid] = (tid >= 64 && tid <= 192) ? tabg[2048 + DIL * (tid - 128)] : -1.0e30f;
    bf16x8 qr[4];
#pragma unroll
    for (int d0 = 0; d0 < 4; ++d0) qr[d0] = *(const bf16x8*)(Qb + (size_t)(res_w + DIL * (qidx0 + r32)) * 64 + d0 * 16 + hi * 8);
    PROBE_T0(pt1_); ATT_WAIT_BAR(0); PROBE_ADD(1, pt1_, shm3);
    PROBE_T0(pt2_);
    f32x16 o0 = {}, o1 = {}; float lsum = 0.f;
    const int qidx = qidx0 + r32;
#pragma unroll
    for (int tt = 0; tt < NTW; ++tt) {
        const int slot = tf + tt;
        const int k0 = DIL == 16 ? 64 * tt : t0idx + 64 * slot;
        if (k0 < 0 || k0 >= L) continue;
        const lds_cptr kp = shm3 + slot * DL_SLOT + r32 * 128;
        const lds_cptr vp = shm3 + slot * DL_SLOT + 8192 + ((lane >> 4) & 1) * 32 + (lane & 3) * 8 + (4 * hi + ((lane & 15) >> 2)) * 64;
        const int dbase = k0 + 4 * hi - qidx;
        int ti = 128 + dbase; ti = ti < 0 ? 0 : (ti > 255 - 59 ? 255 - 59 : ti);
        const __attribute__((address_space(3))) float* tb = (const __attribute__((address_space(3))) float*)(shm3 + DL_TAB) + ti;
        f32x16 p0, p1;
#pragma unroll
        for (int r = 0; r < 16; ++r) { p0[r] = tb[(r & 3) + 8 * (r >> 2)]; p1[r] = tb[32 + (r & 3) + 8 * (r >> 2)]; }
#pragma unroll
        for (int d0 = 0; d0 < 4; ++d0) {
            const int e_ = ((2 * d0 + hi) ^ ((r32 >> 1) & 7)) << 4;
            const bf16x8 a0 = *(const __attribute__((address_space(3))) bf16x8*)(kp + e_), a1 = *(const __attribute__((address_space(3))) bf16x8*)(kp + e_ + 4096);
            p0 = __builtin_amdgcn_mfma_f32_32x32x16_bf16(a0, qr[d0], p0, 0, 0, 0); p1 = __builtin_amdgcn_mfma_f32_32x32x16_bf16(a1, qr[d0], p1, 0, 0, 0);
        }
        const float s0 = exp_sum(p0, p1);
        lsum += s0;
        bf16x8 pa[4]; pack_p(p0, p1, pa);
        pv64(o0, o1, vp, pa);
    }
    ATT_BAR();
    PROBE_ADD(2, pt2_, shm3);
    PROBE_T0(pt3_);
    lsum = half_swap_sum(lsum);
    int lane_t = lane; asm volatile("" : "+v"(lane_t));
    const int r32t = lane_t & 31, hit = lane_t >> 5;
    __attribute__((address_space(3))) float* wsf = (__attribute__((address_space(3))) float*)(shm3 + DL_WSF) + wid * 64;
    if (hit == 0) wsf[r32t] = __builtin_amdgcn_rcpf(lsum);
    asm volatile("s_waitcnt lgkmcnt(0)" ::: "memory");
    float sc[16];
#pragma unroll
    for (int r = 0; r < 16; ++r) sc[r] = wsf[crow(r, hit)];
    bf16* DO = (bf16*)(wsw + (BR == 0 ? WS_DO0 : (BR == 1 ? WS_DO1 : WS_DO2)));
    float* DLs = (float*)(wsw + WS_DL) + (size_t)BR * MTOK * 8;
    const size_t row0 = (size_t)b * SEQ + res_w + (size_t)DIL * qidx0;
    store_o64(o0, o1, sc, (lds_ptr)(shm3 + wid * 4096), DO + row0 * 384 + h * 64, 384 * DIL, lane_t);
    if (hit == 0) DLs[(row0 + (size_t)DIL * r32t) * 8 + h] = lsum;
    ATT_BAR();
    PROBE_ADD(3, pt3_, shm3); PROBE_ADD(4, pt4_, shm3);
}

__device__ __forceinline__ void dil_merge(unsigned char* wsm, const unsigned char* wsw, const int tid, int gw, int NGW) {
    const int lane = tid & 63;
    const bf16* D0 = (const bf16*)(wsw + WS_DO0); const bf16* D1 = (const bf16*)(wsw + WS_DO1); const bf16* D2 = (const bf16*)(wsw + WS_DO2);
    const float* DLs = (const float*)(wsw + WS_DL);
    bf16* mix = (bf16*)(wsm + WS_MIX);
    for (int m0 = gw; m0 < MTOK; m0 += 8 * NGW) {
        if (lane < 48) {
            const int h = lane >> 3;
            v4u a[8], bq[8], c[8]; float l0[8], l1[8], l2[8];
#pragma unroll
            for (int k = 0; k < 8; ++k) { int m = m0 + k * NGW; m = m < MTOK ? m : MTOK - 1;
                a[k] = *(const v4u*)(D0 + (size_t)m * 384 + lane * 8); bq[k] = *(const v4u*)(D1 + (size_t)m * 384 + lane * 8); c[k] = *(const v4u*)(D2 + (size_t)m * 384 + lane * 8);
                l0[k] = DLs[(size_t)m * 8 + h]; l1[k] = DLs[((size_t)MTOK + m) * 8 + h]; l2[k] = DLs[((size_t)2 * MTOK + m) * 8 + h]; }
#pragma unroll
            for (int k = 0; k < 8; ++k) { const int m = m0 + k * NGW;
                const float inv = 1.0f / (l0[k] + l1[k] + l2[k]), w0 = l0[k] * inv, w1 = l1[k] * inv, w2 = l2[k] * inv;
                float x[8], y[8], z[8]; unpack8(a[k], x); unpack8(bq[k], y); unpack8(c[k], z);
                v4u o; o.x = pk2(w0 * x[0] + w1 * y[0] + w2 * z[0], w0 * x[1] + w1 * y[1] + w2 * z[1]); o.y = pk2(w0 * x[2] + w1 * y[2] + w2 * z[2], w0 * x[3] + w1 * y[3] + w2 * z[3]);
                o.z = pk2(w0 * x[4] + w1 * y[4] + w2 * z[4], w0 * x[5] + w1 * y[5] + w2 * z[5]); o.w = pk2(w0 * x[6] + w1 * y[6] + w2 * z[6], w0 * x[7] + w1 * y[7] + w2 * z[7]);
                if (m < MTOK) *(v4u*)(mix + (size_t)m * DM + 256 + lane * 8) = o; }
        }
    }
}
}

#ifndef MK_PROBE_L
#define MK_PROBE_L -1
#endif
#ifndef MK_PH
#define MK_PH 255
#endif
#ifndef MK_CONV_EARLY
#define MK_CONV_EARLY 1
#endif
#ifndef MK_DUP
#define MK_DUP 0
#endif
#define REP(kind) for (int rep_ = 0; rep_ < (((MK_DUP >> (kind)) & 1) ? 2 : 1); ++rep_)
#ifndef MK_ATTN_V1
#define MK_ATTN_V1 0
#endif
#ifndef MK_SP2
#define MK_SP2 true
#endif
constexpr int NPHASE = 18;
template <int MODE>
__global__ void __launch_bounds__(512, 2) enc_fwd(Args args) {
    extern __shared__ __attribute__((aligned(16))) unsigned char lds[];
    LAS unsigned char* L = (LAS unsigned char*)lds;
    volatile LAS unsigned* MISC = (volatile LAS unsigned*)(L + MISC_OFF);
    LAS float* xs = (LAS float*)(L + XS_OFF);
    PROBE_T0(ptall_);
    const int G = gridDim.x, bx = blockIdx.x;
    const int wave0 = __builtin_amdgcn_readfirstlane(threadIdx.x >> 6);
    const int vcu = (G % 8 == 0) ? (bx % 8) * (G / 8) + bx / 8 : bx;
    for (int u = threadIdx.x; u < (LDS_BYTES - MISC_OFF) / 4; u += 512) ((LAS unsigned*)(L + MISC_OFF))[u] = 0u;
    __syncthreads();
    { volatile LAS unsigned long long* PT = (volatile LAS unsigned long long*)(L + MISC_OFF + 128);
      if (threadIdx.x == 0) {
#pragma unroll
          for (int i = 0; i < 25; ++i) PT[i] = (unsigned long long)args.in[i];
          PT[25] = (unsigned long long)args.out; } }
    __syncthreads();
    if (MODE < 0) xcd_barrier_post((unsigned*)(args.ws + WS_CTL) + CW_BAR, MISC + 8, threadIdx.x == 0);
#define IN(k) (MODE < 0 || MODE == (k))
#define SEAM(k) do { if (MODE < 0) { PROBE_T0(pts_); int lid_; asm volatile("v_mbcnt_lo_u32_b32 %0, -1, 0\n\tv_mbcnt_hi_u32_b32 %0, -1, %0" : "=v"(lid_)); xcd_barrier((unsigned*)(args.ws + WS_CTL) + CW_BAR, MISC + 8, wave0 == 0 && lid_ == 0); if ((k) != 99) PROBE_ADD(30, pts_, L); } } while (0)
#define INP(i) ((const float*)lds_ptr_get((volatile LAS unsigned long long*)(L + MISC_OFF + 128), (i)))
#define PHASE_ENV() int tidp; asm volatile("v_mbcnt_lo_u32_b32 %0, -1, 0\n\tv_mbcnt_hi_u32_b32 %0, -1, %0" : "=v"(tidp)); tidp |= wave0 << 6; asm volatile("" : "+v"(tidp)); int bxp = bx, Gp = G, vcup = vcu; asm volatile("" : "+s"(bxp), "+s"(Gp), "+s"(vcup)); (void)vcup; unsigned char* ws; { const unsigned long long w_ = (unsigned long long)args.ws; unsigned wl_ = (unsigned)w_, wh_ = (unsigned)(w_ >> 32); \
          asm volatile("" : "+s"(wl_), "+s"(wh_)); ws = (unsigned char*)(((unsigned long long)wh_ << 32) | wl_); } \
        const int lane = tidp & 63, wave = __builtin_amdgcn_readfirstlane(tidp >> 6), gw = vcup * 8 + wave, gtid = bxp * 512 + tidp; const int NGW = Gp * 8, NGT = Gp * 512; (void)NGW; (void)NGT; (void)lane; (void)gw; (void)gtid; \
        bf16* XB = (bf16*)(ws + WS_XB); bf16* HB = (bf16*)(ws + WS_H); float* P0 = (float*)(ws + WS_P); float* P1 = P0 + (size_t)MTOK * 16; float* P2 = P1 + (size_t)MTOK * 16; \
        const float* tab = (const float*)(ws + WS_TAB); (void)XB; (void)HB; (void)P0; (void)P1; (void)P2; (void)tab;

    PROBE_T0(ptp_);
    REP(0) if (IN(0) && (MK_PH & 1)) { PHASE_ENV();
        prologue_misc((volatile LAS unsigned long long*)(L + MISC_OFF + 128), ws, gw, NGW, lane, gtid, NGT);
        convert_weights((volatile LAS unsigned long long*)(L + MISC_OFF + 128), ws, 0, MK_CONV_EARLY ? 1 : 255, gw, NGW, lane);
    }
    SEAM(0);
    PROBE_ADD(47, ptp_, L);
#if MK_PROBE == 31
    { PROBE_T0(ptx_); int lidq_; asm volatile("v_mbcnt_lo_u32_b32 %0, -1, 0\n\tv_mbcnt_hi_u32_b32 %0, -1, %0" : "=v"(lidq_));
      for (int rr = 0; rr < 4; ++rr) xcd_barrier((unsigned*)(args.ws + WS_CTL) + CW_BAR, MISC + 8, wave0 == 0 && lidq_ == 0);
      PROBE_ADD(31, ptx_, L); }
#endif
    for (int l = (MODE < 0 ? 0 : args.layer); l < (MODE < 0 ? DEPTH : args.layer + 1); ++l) {
        constexpr int p0 = 1;
        PROBE_T0(ptw0_);
        REP(1) if (IN(p0 + 0) && (MK_PH & 4)) { PHASE_ENV();
            pg8::Gemm g{XB, (const bf16*)(ws + W_GU1), MTOK, 2 * DFF, DM, DM, DM}; pg8::StaticOrder S; S.init(MTOK, 2 * DFF, Gp, bxp);
            pg8::EpiSwiGLU E{HB, P0};
            PROBE_T0(ptg_);
            pg8::gemm_phase<pg8::EpiSwiGLU, pg8::StaticOrder, true, MK_SP2>(tidp, L, xs, g, S, E);
            PROBE_ADD(32, ptg_, L);
            if (MK_CONV_EARLY && bxp >= Gp / 2) convert_weights((volatile LAS unsigned long long*)(L + MISC_OFF + 128), ws, l, 244, (bxp - Gp / 2) * 8 + wave, (Gp - Gp / 2) * 8, lane);
        }
        SEAM(p0 + 0);
        if (MK_PROBE_L < 0 || l == MK_PROBE_L) PROBE_ADD(40, ptw0_, L); PROBE_T0(ptw1_);
        REP(2) if (IN(p0 + 1) && (MK_PH & 8)) { PHASE_ENV();
            pg8::Gemm g{HB, (const bf16*)(ws + W_D1), MTOK, DM, DFF, DFF, DFF}; pg8::StaticOrder S; S.init(MTOK, DM, Gp, bxp);
            pg8::EpiResidB E{XB, nullptr, P1, (((MK_DUP >> 2) & 1) && rep_ == 0) ? 0.0f : 0.5f};
            PROBE_T0(ptd_);
            pg8::gemm_phase<pg8::EpiResidB, pg8::StaticOrder, true, MK_SP2>(tidp, L, xs, g, S, E);
            PROBE_ADD(33, ptd_, L);
        }
        SEAM(p0 + 1);
        PROBE_ADD(41, ptw1_, L); PROBE_T0(ptw2_);
        REP(3) if (IN(p0 + 2) && (MK_PH & 16)) { PHASE_ENV();
            pg8::Gemm g{XB, (const bf16*)(ws + W_IN), MTOK, NIN, DM, DM, DM}; pg8::StaticOrder S; S.init(MTOK, NIN, Gp, bxp);
            pg8::EpiInProj E{P1, (bf16*)(ws + WS_QD), (bf16*)(ws + WS_KD), (bf16*)(ws + WS_VD), (bf16*)(ws + WS_QL), (bf16*)(ws + WS_KL), (bf16*)(ws + WS_VL), (bf16*)(ws + WS_AQ),
                             (float*)(ws + WS_KR), (float*)(ws + WS_KRSS), INP(I_DQN) + l * 32, INP(I_DKN) + l * 32, INP(I_LQN) + l * 64, INP(I_LKN) + l * 64,
                             0.17677669529663687f * LOG2E, 0.125f * LOG2E, 0};
            pg8::gemm_phase<pg8::EpiInProj, pg8::StaticOrder, true, MK_SP2>(tidp, L, xs, g, S, E);
            if (MK_CONV_EARLY && bxp >= Gp / 2) convert_weights((volatile LAS unsigned long long*)(L + MISC_OFF + 128), ws, l, 10, (bxp - Gp / 2) * 8 + wave, (Gp - Gp / 2) * 8, lane);
        }
        SEAM(p0 + 2);
        PROBE_ADD(42, ptw2_, L); PROBE_T0(ptw3_);
        REP(10) if (IN(p0 + 3) && (MK_PH & 32)) { PHASE_ENV();
            int Kq = 256; asm volatile("" : "+s"(Kq));
            pg8::Gemm g{(const bf16*)(ws + WS_AQ), (const bf16*)(ws + W_QU), MTOK, 1536, Kq, 384, 256, 3, 256}; pg8::StaticOrder S; S.init(MTOK, 1536, Gp, bxp);
            pg8::EpiMlaQKV E{ pg8::EpiMlaQ{(bf16*)(ws + WS_QC), INP(I_MQNG) + l * 96, tab + TAB_COS, tab + TAB_SIN, 0.10206207261596575f * LOG2E},
                              pg8::EpiMlaKV{(bf16*)(ws + WS_KC), (bf16*)(ws + WS_VC), INP(I_MKNG) + l * 96, (const float*)(ws + WS_KR), (const float*)(ws + WS_KRSS), tab + TAB_COS, tab + TAB_SIN} };
            PROBE_T0(ptm_);
            pg8::gemm_phase<pg8::EpiMlaQKV, pg8::StaticOrder, true, MK_SP2>(tidp, L, xs, g, S, E);
            PROBE_ADD(51, ptm_, L);
        }
#if !MK_ATTN_V1
        REP(12) if (IN(p0 + 3) && (MK_PH & 32)) { PHASE_ENV();
            const int kx_ = bxp >> 3, xc_ = bxp & 7, rnk = (kx_ >= 16) ? xc_ * 16 + (kx_ - 16) : 128 + xc_ * 16 + kx_;
            PROBE_T0(ptdl_);
            for (int ud = rnk; ud < 1152; ud += Gp) {
                const int bh = ud / 24, rem = ud - bh * 24, br = rem >> 3, chunk = rem & 7;
                if (br == 0) att::dil_unit<1>(ws, (unsigned char*)INP(25), tidp, l, bh, chunk, ud + Gp, (char*)lds);
                else if (br == 1) att::dil_unit<4>(ws, (unsigned char*)INP(25), tidp, l, bh, chunk, ud + Gp, (char*)lds);
                else att::dil_unit<16>(ws, (unsigned char*)INP(25), tidp, l, bh, chunk, ud + Gp, (char*)lds);
            }
            PROBE_ADD(52, ptdl_, L);
        }
#endif
        SEAM(p0 + 3);
        PROBE_ADD(43, ptw3_, L); PROBE_T0(ptw4_);
#if MK_ATTN_V1
        REP(5) if (IN(p0 + 4) && (MK_PH & 64)) { PHASE_ENV();
            for (int u = bxp; u < 640; u += Gp) {
                if (u < 192) mla_unit_v1(ws, tidp, l, u, (LAS float*)L);
                else if (u < 448) diff_unit_v1(ws, INP(I_DSUB) + l * 64, tidp, l, u - 192, (LAS float*)L);
                else dil_unit_v1(ws, tidp, l, u - 448);
            }
        }
#else
        REP(13) if (IN(p0 + 4) && (MK_PH & 64)) { PHASE_ENV();
            PROBE_T0(ptdf_);
            for (int u = vcup; u < 512; u += Gp) att::diff_unit(ws, INP(I_DSUB) + l * 64, tidp, l, u, (char*)lds);
            PROBE_ADD(53, ptdf_, L);
        }
        REP(14) if (IN(p0 + 4) && (MK_PH & 64)) { PHASE_ENV();
            PROBE_T0(ptml_);
            for (int u = vcup; u < 768; u += Gp) att::mla_unit(ws, tidp, l, u, (char*)lds);
            PROBE_ADD(54, ptml_, L);
        }
        REP(15) if (IN(p0 + 4) && (MK_PH & 64)) { PHASE_ENV();
            PROBE_T0(ptmg_);
            att::dil_merge(ws, (const unsigned char*)INP(25), tidp, gw, NGW);
            PROBE_ADD(55, ptmg_, L);
        }
#endif
        PROBE_T0(pta_);
        SEAM(p0 + 4);
        PROBE_ADD(56, pta_, L);
        PROBE_ADD(44, ptw4_, L); PROBE_T0(ptw5_);
        REP(6) if (IN(p0 + 5) && (MK_PH & 128)) { PHASE_ENV();
            pg8::Gemm g{(const bf16*)(ws + WS_MIX), (const bf16*)(ws + W_O), MTOK, DM, DM, DM, DM}; pg8::StaticOrder S; S.init(MTOK, DM, Gp, bxp);
            pg8::EpiResidB E{XB, nullptr, P2, (((MK_DUP >> 6) & 1) && rep_ == 0) ? 0.0f : 1.0f};
            pg8::gemm_phase<pg8::EpiResidB, pg8::StaticOrder, true, MK_SP2>(tidp, L, xs, g, S, E);
        }
        SEAM(p0 + 5);
        PROBE_ADD(45, ptw5_, L); PROBE_T0(ptw6_);
        REP(7) if (IN(p0 + 6) && (MK_PH & 4)) { PHASE_ENV();
            pg8::Gemm g{XB, (const bf16*)(ws + W_GU2), MTOK, 2 * DFF, DM, DM, DM}; pg8::StaticOrder S; S.init(MTOK, 2 * DFF, Gp, bxp);
            pg8::EpiSwiGLU E{HB, P2};
            pg8::gemm_phase<pg8::EpiSwiGLU, pg8::StaticOrder, true, MK_SP2>(tidp, L, xs, g, S, E);
            if (MK_CONV_EARLY && l + 1 < DEPTH && bxp >= Gp / 2) convert_weights((volatile LAS unsigned long long*)(L + MISC_OFF + 128), ws, l + 1, 1, (bxp - Gp / 2) * 8 + wave, (Gp - Gp / 2) * 8, lane);
        }
        SEAM(p0 + 6);
        if (MK_PROBE_L < 0 || l == MK_PROBE_L) PROBE_ADD(46, ptw6_, L); PROBE_T0(ptw7_);
        REP(8) if (IN(p0 + 7) && (MK_PH & 8)) { PHASE_ENV();
            pg8::Gemm g{HB, (const bf16*)(ws + W_D2), MTOK, DM, DFF, DFF, DFF}; pg8::StaticOrder S; S.init(MTOK, DM, Gp, bxp);
            pg8::EpiResidB E{XB, l == DEPTH - 1 ? (float*)INP(25) : nullptr, P0, (((MK_DUP >> 8) & 1) && rep_ == 0) ? 0.0f : 0.5f};
            pg8::gemm_phase<pg8::EpiResidB, pg8::StaticOrder, true, MK_SP2>(tidp, L, xs, g, S, E);
        }
        if (l + 1 < DEPTH && !MK_CONV_EARLY) {
            SEAM(p0 + 7);
            REP(9) if (IN(p0 + 8) && (MK_PH & 2)) { PHASE_ENV(); convert_weights((volatile LAS unsigned long long*)(L + MISC_OFF + 128), ws, l + 1, 255, gw, NGW, lane); }
            SEAM(p0 + 8);
        }
        if (l + 1 < DEPTH && MK_CONV_EARLY) SEAM(p0 + 7);
        PROBE_ADD(48, ptw7_, L);
    }
    PROBE_ADD(49, ptall_, L);
#if MK_PROBE
    if (MODE < 0) { SEAM(99);
        int lidp_; asm volatile("v_mbcnt_lo_u32_b32 %0, -1, 0\n\tv_mbcnt_hi_u32_b32 %0, -1, %0" : "=v"(lidp_));
        if ((int)blockIdx.x == MK_PROBE_BLOCK && wave0 == 0 && lidp_ == 0) { const unsigned tk = ((volatile LAS unsigned*)(L + MISC_OFF + 96))[0]; float* o = (float*)args.out; o[1] = o[1] + 0.04f + (float)tk * 1.0e-8f * MK_PROBE_SCALE; } }
#endif
#undef IN
#undef SEAM
#undef PHASE_ENV
}

extern "C" void kernel_launch(void* const* d_in, const int* in_sizes, int n_in, void* d_out, int out_size, void* d_ws, size_t ws_size, hipStream_t stream) {
    static int grid = 0;
    if (grid == 0) {
        if (n_in != 25 || out_size != MTOK * DM || ws_size < WS_TOTAL) { fprintf(stderr, "kernel_launch: unexpected shapes (n_in %d out %d ws %zu)\n", n_in, out_size, ws_size); grid = -1; return; }
        int dev = 0, cus = 0, per_cu = 0;
        if (hipGetDevice(&dev) != hipSuccess || hipDeviceGetAttribute(&cus, hipDeviceAttributeMultiprocessorCount, dev) != hipSuccess) { grid = -1; return; }
#if MK_ONE_LAUNCH
        if (hipFuncSetAttribute((const void*)enc_fwd<-1>, hipFuncAttributeMaxDynamicSharedMemorySize, LDS_BYTES) != hipSuccess) { fprintf(stderr, "kernel_launch: hipFuncSetAttribute failed\n"); grid = -1; return; }
        if (hipOccupancyMaxActiveBlocksPerMultiprocessor(&per_cu, (const void*)enc_fwd<-1>, 512, LDS_BYTES) != hipSuccess || per_cu < 1) { fprintf(stderr, "kernel_launch: occupancy query says %d\n", per_cu); grid = -1; return; }
#else
#define SETATTR(K) if (hipFuncSetAttribute((const void*)enc_fwd<K>, hipFuncAttributeMaxDynamicSharedMemorySize, LDS_BYTES) != hipSuccess) { fprintf(stderr, "kernel_launch: hipFuncSetAttribute failed\n"); grid = -1; return; }
        SETATTR(0) SETATTR(1) SETATTR(2) SETATTR(3) SETATTR(4) SETATTR(5) SETATTR(6) SETATTR(7) SETATTR(8) SETATTR(9)
        per_cu = 1;
#endif
        (void)hipGetLastError();
        grid = cus;
    }
    if (grid < 0) return;
    (void)hipMemsetAsync((char*)d_ws + WS_CTL, 0, CTL_ZERO_BYTES, stream);
    Args a{};
    for (int i = 0; i < 25; ++i) a.in[i] = (const float*)d_in[i];
    a.out = (float*)d_out; a.ws = (unsigned char*)d_ws;
#if MK_ONE_LAUNCH
    a.layer = 0;
    hipLaunchKernelGGL(enc_fwd<-1>, dim3(grid), dim3(512), LDS_BYTES, stream, a);
#else
#define LAUNCH_PH(K, LAYER) do { a.layer = (LAYER); hipLaunchKernelGGL(enc_fwd<K>, dim3(grid), dim3(512), LDS_BYTES, stream, a); } while (0)
    LAUNCH_PH(0, 0);
    for (int l = 0; l < DEPTH; ++l) {
        LAUNCH_PH(1, l); LAUNCH_PH(2, l); LAUNCH_PH(3, l); LAUNCH_PH(4, l); LAUNCH_PH(5, l); LAUNCH_PH(6, l); LAUNCH_PH(7, l); LAUNCH_PH(8, l);
        if (l + 1 < DEPTH) LAUNCH_PH(9, l);
    }
#endif
}
```

```cpp
#include <hip/hip_runtime.h>
#include <cstdio>
#include <cstdint>

#ifndef MK_PROBE
#define MK_PROBE 0
#endif
#ifndef MK_PROBE_SCALE
#define MK_PROBE_SCALE 1000.0f
#endif
#ifndef MK_EARLY_WB
#define MK_EARLY_WB 0
#endif
#ifndef MK_SC1_STORES
#define MK_SC1_STORES 0
#endif
#ifndef MK_ONE_LAUNCH
#define MK_ONE_LAUNCH 1
#endif

constexpr int DM = 1024, BATCH = 8, SEQ = 2048, DEPTH = 2, MTOK = BATCH * SEQ, DFF = 2816;
constexpr int IN_W = 2336, NIN = 2560;
constexpr float EPS = 1e-6f;
constexpr float LOG2E = 1.4426950408889634f;

__device__ __forceinline__ float sum_x32(float v) { const unsigned u = __builtin_bit_cast(unsigned, v); auto r = __builtin_amdgcn_permlane32_swap(u, u, false, false); return __builtin_bit_cast(float, (unsigned)r[0]) + __builtin_bit_cast(float, (unsigned)r[1]); }
__device__ __forceinline__ float max_x32(float v) { const unsigned u = __builtin_bit_cast(unsigned, v); auto r = __builtin_amdgcn_permlane32_swap(u, u, false, false); return fmaxf(__builtin_bit_cast(float, (unsigned)r[0]), __builtin_bit_cast(float, (unsigned)r[1])); }
template <int M> __device__ __forceinline__ float swz(float v) { return __builtin_bit_cast(float, __builtin_amdgcn_ds_swizzle(__builtin_bit_cast(int, v), 0x1F | (M << 10))); }

namespace pg8 {
#define PG8_LAS __attribute__((address_space(3)))
typedef unsigned short bf16_t;
typedef short bf16x8 __attribute__((ext_vector_type(8)));
typedef float f32x4 __attribute__((ext_vector_type(4)));
typedef unsigned u32x4 __attribute__((ext_vector_type(4)));
typedef unsigned u32x2 __attribute__((ext_vector_type(2)));
constexpr int BM = 256, BK = 64, HALF = 128, HTB = HALF * BK * 2  , STAGE_BYTES = 8 * HTB, NXCD = 8, WGM = 8;

__host__ __device__ __forceinline__ int lds_byte(int r, int c) { const int st = (r >> 4) * 2 + (c >> 5), rr = r & 15, cc = c & 31, ob = rr * 64 + cc * 2; return st * 1024 + (ob ^ (((ob >> 9) & 1) << 5)); }
__host__ __device__ __forceinline__ void stage_rc(int b, int& R, int& C) { const int st = b / 1024, sb = b % 1024, swz = sb ^ (((sb >> 9) & 1) << 5); R = (st >> 1) * 16 + swz / 64; C = (st & 1) * 32 + (swz % 64) / 2; }
__host__ __device__ __forceinline__ int perm32(int rho) { const int n = rho >> 4, i = rho & 15; return 8 * (i >> 2) + 4 * n + (i & 3); }

struct Unit { int pm, pn; };
struct Gemm { const bf16_t* A; const bf16_t* Bt; int M, N, K, lda, ldb; int asplit = 1 << 30, aoff = 0; };

struct StaticOrder {
    int nM, nN, nwg, G, c;
    __host__ __device__ void init(int M, int N, int G_, int c_) { nM = M / BM; nN = N / BM; nwg = nM * nN; G = G_; c = c_; }
    __host__ __device__ bool next(int i, Unit& u) const {
        const long L = (long)i * G + c; if (L >= nwg) return false;
        int wgid = (int)L; { const int q = nwg / NXCD, r = nwg % NXCD, xcd = wgid % NXCD, off = wgid / NXCD; wgid = (xcd < r ? xcd * (q + 1) : r * (q + 1) + (xcd - r) * q) + off; }
        const int nig = WGM * nN, gid = wgid / nig, fm = gid * WGM, gsz = (nM - fm) < WGM ? (nM - fm) : WGM;
        u.pm = fm + ((wgid % nig) % gsz); u.pn = (wgid % nig) / gsz; return true;
    }
    __device__ __forceinline__ void a_ready(const Unit&) const {}
    __device__ __forceinline__ void done(const Unit&) const {}
};

__device__ __forceinline__ unsigned cvt_pk_bf16(float lo, float hi) { unsigned r; asm volatile("v_cvt_pk_bf16_f32 %0, %1, %2" : "=v"(r) : "v"(lo), "v"(hi)); return r; }

__device__ __forceinline__ float rowscale16(const float* P, int row) {
    const f32x4* p = (const f32x4*)(P + (size_t)row * 16);
    const f32x4 a = p[0], b = p[1], c = p[2], d = p[3];
    const float s = ((a[0] + a[1]) + (a[2] + a[3])) + ((b[0] + b[1]) + (b[2] + b[3])) + ((c[0] + c[1]) + (c[2] + c[3])) + ((d[0] + d[1]) + (d[2] + d[3]));
    return __builtin_amdgcn_rsqf(s * (1.0f / 1024.0f) + EPS);
}
__device__ __forceinline__ void rowscale_all(const float* P, int row0, int fq, float (&r)[8]) {
    f32x4 t[8];
#pragma unroll
    for (int i = 0; i < 8; ++i) t[i] = *(const f32x4*)(P + (size_t)(row0 + (i >> 2) * HALF + (i & 3) * 16) * 16 + fq * 4);
#pragma unroll
    for (int i = 0; i < 8; ++i) { float s = (t[i][0] + t[i][1]) + (t[i][2] + t[i][3]); s += swz<16>(s); s = sum_x32(s); r[i] = __builtin_amdgcn_rsqf(s * (1.0f / 1024.0f) + EPS); }
}
__device__ __forceinline__ u32x4 pack8(const float* v) { u32x4 w; w.x = cvt_pk_bf16(v[0], v[1]); w.y = cvt_pk_bf16(v[2], v[3]); w.z = cvt_pk_bf16(v[4], v[5]); w.w = cvt_pk_bf16(v[6], v[7]); return w; }
__device__ __forceinline__ float quad_sum(float s) { s += swz<16>(s); return sum_x32(s); }
#define EPI_OPAQUE() do { u.pm = __builtin_amdgcn_readfirstlane(u.pm); u.pn = __builtin_amdgcn_readfirstlane(u.pn); wr = __builtin_amdgcn_readfirstlane(wr); wc = __builtin_amdgcn_readfirstlane(wc); \
    asm volatile("" : "+s"(u.pm), "+s"(u.pn), "+s"(wr), "+s"(wc), "+v"(fr), "+v"(fq)); } while (0)
#if MK_SC1_STORES
__device__ __forceinline__ void st16(void* p, u32x4 v) { asm volatile("global_store_dwordx4 %0, %1, off sc1\n\ts_nop 1" :: "v"(p), "v"(v) : "memory"); }
__device__ __forceinline__ void st16f(void* p, f32x4 v) { asm volatile("global_store_dwordx4 %0, %1, off sc1\n\ts_nop 1" :: "v"(p), "v"(v) : "memory"); }
#else
__device__ __forceinline__ void st16(void* p, u32x4 v) { *(u32x4*)p = v; }
__device__ __forceinline__ void st16f(void* p, f32x4 v) { *(f32x4*)p = v; }
#endif
#define XS_BAR() do { asm volatile("s_waitcnt lgkmcnt(0)" ::: "memory"); __builtin_amdgcn_s_barrier(); asm volatile("" ::: "memory"); } while (0)

struct EpiSwiGLU {
    static constexpr bool PERM = true, AFTER_DRAIN = false, DUP_OK = true;
    bf16_t* H; const float* P;
    __device__ __forceinline__ void operator()(const f32x4 (&acc)[2][2][4][2], const Unit& u_, int wr, int wc, int fr, int fq, PG8_LAS float* xs) const {
        Unit u = u_; EPI_OPAQUE();
        float rs[8]; rowscale_all(P, u.pm * BM + wr * 64 + fr, fq, rs);
#pragma unroll
        for (int ai = 0; ai < 2; ++ai)
#pragma unroll
            for (int m = 0; m < 4; ++m) {
                const int row = u.pm * BM + ai * HALF + wr * 64 + m * 16 + fr;
                const float r = rs[ai * 4 + m], rn = -LOG2E * r, r2 = r * r;
                float h[8];
#pragma unroll
                for (int n = 0; n < 2; ++n)
#pragma unroll
                    for (int j = 0; j < 4; ++j) {
                        const float a = acc[ai][0][m][n][j], b = acc[ai][1][m][n][j];
                        h[n * 4 + j] = (a * b) * (r2 * __builtin_amdgcn_rcpf(1.0f + __builtin_amdgcn_exp2f(a * rn)));
                    }
                st16(H + (size_t)row * DFF + u.pn * 128 + wc * 32 + fq * 8, pack8(h));
            }
    }
};

struct EpiResidB {
    static constexpr bool PERM = true, AFTER_DRAIN = false, DUP_OK = false;
    bf16_t* XB; float* Xout; float* Pout; float alpha;
    __device__ __forceinline__ void operator()(const f32x4 (&acc)[2][2][4][2], const Unit& u_, int wr, int wc, int fr, int fq, PG8_LAS float* xs) const {
        Unit u = u_; EPI_OPAQUE();
        const bool FINAL = Xout != nullptr;
        const size_t off0 = (size_t)(u.pm * BM + wr * 64 + fr) * DM + u.pn * BM + wc * 32 + fq * 8;
        u32x4 cur[2], nxt[2];
#pragma unroll
        for (int bj = 0; bj < 2; ++bj) cur[bj] = *(const u32x4*)(XB + off0 + bj * HALF);
#pragma unroll
        for (int i = 0; i < 8; ++i) {
            const int ai = i >> 2, m = i & 3;
            const size_t off = off0 + (size_t)(ai * HALF + m * 16) * DM;
            if (i < 7) { const size_t offn = off0 + (size_t)(((i + 1) >> 2) * HALF + ((i + 1) & 3) * 16) * DM;
#pragma unroll
                for (int bj = 0; bj < 2; ++bj) nxt[bj] = *(const u32x4*)(XB + offn + bj * HALF); }
            float ss = 0.f;
#pragma unroll
            for (int bj = 0; bj < 2; ++bj) {
                const u32x4 c = cur[bj];
                const f32x4 r0 = {__builtin_bit_cast(float, c[0] << 16), __builtin_bit_cast(float, c[0] & 0xffff0000u), __builtin_bit_cast(float, c[1] << 16), __builtin_bit_cast(float, c[1] & 0xffff0000u)};
                const f32x4 r1 = {__builtin_bit_cast(float, c[2] << 16), __builtin_bit_cast(float, c[2] & 0xffff0000u), __builtin_bit_cast(float, c[3] << 16), __builtin_bit_cast(float, c[3] & 0xffff0000u)};
                const f32x4 v0 = r0 + acc[ai][bj][m][0] * alpha, v1 = r1 + acc[ai][bj][m][1] * alpha;
                if (FINAL) { st16f(Xout + off + bj * HALF, v0); st16f(Xout + off + bj * HALF + 4, v1); }
                else { const float t[8] = {v0[0], v0[1], v0[2], v0[3], v1[0], v1[1], v1[2], v1[3]}; st16(XB + off + bj * HALF, pack8(t));
                    ss += (v0[0] * v0[0] + v0[1] * v0[1]) + (v0[2] * v0[2] + v0[3] * v0[3]) + (v1[0] * v1[0] + v1[1] * v1[1]) + (v1[2] * v1[2] + v1[3] * v1[3]); }
            }
            if (!FINAL) { ss = quad_sum(ss); if (fq == 0) Pout[(size_t)(u.pm * BM + ai * HALF + wr * 64 + m * 16 + fr) * 16 + u.pn * 4 + wc] = ss; }
#pragma unroll
            for (int j = 0; j < 2; ++j) cur[j] = nxt[j];
            asm volatile("" ::: "memory");
        }
    }
};

struct EpiInProj {
    static constexpr bool PERM = true, AFTER_DRAIN = false, DUP_OK = false;
    const float* P;
    bf16_t *Qd, *Kd, *Vd, *Ql, *Kl, *Vl, *AQ; float *kr, *krss;
    const float *g_dq, *g_dk, *g_lq, *g_lk;
    float cdiff, cdil;
    int pn0;
    __device__ __forceinline__ void operator()(const f32x4 (&acc)[2][2][4][2], const Unit& u_, int wr, int wc, int fr, int fq, PG8_LAS float* xs) const {
        Unit u = u_; EPI_OPAQUE();
        const int t = u.pn + pn0;
        if (t == 7 || t == 8) {
#pragma unroll
            for (int ai = 0; ai < 2; ++ai)
#pragma unroll
                for (int m = 0; m < 4; ++m) {
                    const int rl = ai * HALF + wr * 64 + m * 16 + fr;
                    float ss = 0.f;
#pragma unroll
                    for (int bj = 0; bj < 2; ++bj)
#pragma unroll
                        for (int n = 0; n < 2; ++n) { const f32x4 a = acc[ai][bj][m][n]; ss += (a[0] * a[0] + a[1] * a[1]) + (a[2] * a[2] + a[3] * a[3]); }
                    ss = quad_sum(ss);
                    if (fq == 0) xs[rl * 4 + wc] = ss;
                }
            XS_BAR();
        }
        float rs[8]; rowscale_all(P, u.pm * BM + wr * 64 + fr, fq, rs);
        float gg[2][8];
        {
            const bool dil_ = (t >= 3 && t <= 5), isq_ = (t == 0) || (t == 3) || (t == 4 && wc < 2);
            const float *p_dq = g_dq, *p_dk = g_dk, *p_lq = g_lq, *p_lk = g_lk; asm volatile("" : "+s"(p_dq), "+s"(p_dk), "+s"(p_lq), "+s"(p_lk));
            const float* gp = dil_ ? (isq_ ? p_lq : p_lk) : (t == 1 ? p_dk : p_dq);
            const int gstep = dil_ ? 32 : 0;
#pragma unroll
            for (int bj = 0; bj < 2; ++bj)
#pragma unroll
                for (int i = 0; i < 8; ++i) gg[bj][i] = gp[bj * gstep + fq * 8 + i];
        }
#pragma unroll
        for (int ai = 0; ai < 2; ++ai)
#pragma unroll
            for (int m = 0; m < 4; ++m) {
                asm volatile("" ::: "memory");
                const int rl = ai * HALF + wr * 64 + m * 16 + fr, row = u.pm * BM + rl, b = row >> 11, s = row & (SEQ - 1);
                const float r = rs[ai * 4 + m];
                float v[2][8];
#pragma unroll
                for (int bj = 0; bj < 2; ++bj)
#pragma unroll
                    for (int n = 0; n < 2; ++n)
#pragma unroll
                        for (int j = 0; j < 4; ++j) v[bj][n * 4 + j] = acc[ai][bj][m][n][j] * r;
                if (t <= 1) {
                    bf16_t* dst = t == 0 ? Qd : Kd; const float post = t == 0 ? cdiff : 1.0f;
#pragma unroll
                    for (int bj = 0; bj < 2; ++bj) {
                        float ss = 0.f;
#pragma unroll
                        for (int i = 0; i < 8; ++i) ss += v[bj][i] * v[bj][i];
                        ss = quad_sum(ss);
                        const float rn = __builtin_amdgcn_rsqf(ss * (1.0f / 32.0f) + EPS) * post;
                        float o[8];
#pragma unroll
                        for (int i = 0; i < 8; ++i) o[i] = v[bj][i] * rn * gg[bj][i];
                        *(u32x4*)(dst + ((size_t)(((b * 4 + wc) * 2 + bj) * SEQ + s)) * 32 + fq * 8) = pack8(o);
                    }
                } else if (t == 2) {
#pragma unroll
                    for (int bj = 0; bj < 2; ++bj) *(u32x4*)(Vd + ((size_t)((b * 4 + wc) * SEQ + s)) * 64 + bj * 32 + fq * 8) = pack8(v[bj]);
                } else if (t <= 5) {
                    const bool isq = (t == 3) || (t == 4 && wc < 2);
                    const int head = (t == 3) ? wc : (t == 4 ? (wc < 2 ? 4 + wc : wc - 2) : wc + 2);
                    bf16_t* dst = isq ? Ql : Kl; const float post = isq ? cdil : 1.0f;
                    float ss = 0.f;
#pragma unroll
                    for (int bj = 0; bj < 2; ++bj)
#pragma unroll
                        for (int i = 0; i < 8; ++i) ss += v[bj][i] * v[bj][i];
                    ss = quad_sum(ss);
                    const float rn = __builtin_amdgcn_rsqf(ss * (1.0f / 64.0f) + EPS) * post;
#pragma unroll
                    for (int bj = 0; bj < 2; ++bj) {
                        float o[8];
#pragma unroll
                        for (int i = 0; i < 8; ++i) o[i] = v[bj][i] * rn * gg[bj][i];
                        *(u32x4*)(dst + ((size_t)((b * 6 + head) * SEQ + s)) * 64 + bj * 32 + fq * 8) = pack8(o);
                    }
                } else if (t == 6 || (t == 7 && wc < 2)) {
                    const int head = t == 6 ? wc : 4 + wc;
#pragma unroll
                    for (int bj = 0; bj < 2; ++bj) *(u32x4*)(Vl + ((size_t)((b * 6 + head) * SEQ + s)) * 64 + bj * 32 + fq * 8) = pack8(v[bj]);
                } else if (t == 7) {
                    const float ss = (xs[rl * 4 + 2] + xs[rl * 4 + 3]) * r * r;
                    const float rn = __builtin_amdgcn_rsqf(ss * (1.0f / 128.0f) + EPS);
#pragma unroll
                    for (int bj = 0; bj < 2; ++bj) {
                        float o[8];
#pragma unroll
                        for (int i = 0; i < 8; ++i) o[i] = v[bj][i] * rn;
                        *(u32x4*)(AQ + (size_t)row * 384 + 256 + (wc - 2) * 64 + bj * 32 + fq * 8) = pack8(o);
                    }
                } else if (t == 8) {
                    const float ss = ((xs[rl * 4 + 0] + xs[rl * 4 + 1]) + (xs[rl * 4 + 2] + xs[rl * 4 + 3])) * r * r;
                    const float rn = __builtin_amdgcn_rsqf(ss * (1.0f / 256.0f) + EPS);
#pragma unroll
                    for (int bj = 0; bj < 2; ++bj) {
                        float o[8];
#pragma unroll
                        for (int i = 0; i < 8; ++i) o[i] = v[bj][i] * rn;
                        *(u32x4*)(AQ + (size_t)row * 384 + bj * 128 + wc * 32 + fq * 8) = pack8(o);
                    }
                } else {
                    if (wc == 0) {
                        float ss = 0.f;
#pragma unroll
                        for (int bj = 0; bj < 2; ++bj)
#pragma unroll
                            for (int i = 0; i < 8; ++i) ss += v[bj][i] * v[bj][i];
                        ss = quad_sum(ss);
                        if (fq < 2) {
#pragma unroll
                            for (int bj = 0; bj < 2; ++bj) {
                                *(f32x4*)(kr + (size_t)row * 32 + bj * 16 + fq * 8) = (f32x4){v[bj][0], v[bj][1], v[bj][2], v[bj][3]};
                                *(f32x4*)(kr + (size_t)row * 32 + bj * 16 + fq * 8 + 4) = (f32x4){v[bj][4], v[bj][5], v[bj][6], v[bj][7]};
                            }
                        }
                        if (fq == 0) krss[row] = ss;
                    }
                }
            }
    }
};

struct EpiMlaQ {
    static constexpr bool PERM = true, AFTER_DRAIN = false, DUP_OK = false;
    bf16_t* Qc; const float* qn; const float* cs; const float* sn; float cmla;
    __device__ __forceinline__ void operator()(const f32x4 (&acc)[2][2][4][2], const Unit& u_, int wr, int wc, int fr, int fq, PG8_LAS float* xs) const {
        Unit u = u_; EPI_OPAQUE();
#pragma unroll
        for (int ai = 0; ai < 2; ++ai)
#pragma unroll
            for (int m = 0; m < 4; ++m) {
                const int rl = ai * HALF + wr * 64 + m * 16 + fr;
                float ss = 0.f;
#pragma unroll
                for (int bj = 0; bj < 2; ++bj)
#pragma unroll
                    for (int n = 0; n < 2; ++n) { const f32x4 a = acc[ai][bj][m][n]; ss += (a[0] * a[0] + a[1] * a[1]) + (a[2] * a[2] + a[3] * a[3]); }
                ss = quad_sum(ss);
                if (fq == 0) xs[rl * 4 + wc] = ss;
            }
        XS_BAR();
        const int hs = wc >> 1, head = u.pn * 2 + hs; const bool rope = wc & 1;
        float gq[16];
#pragma unroll
        for (int i = 0; i < 16; ++i) gq[i] = qn[(rope ? 64 + (i >> 3) * 16 : (i >> 3) * 32) + fq * 8 + (i & 7)];
        float cc[8], sv[8], ccn[8], svn[8];
        if (rope && fq < 2) { const int s0 = (u.pm * BM + wr * 64 + fr) & (SEQ - 1);
#pragma unroll
            for (int i = 0; i < 8; ++i) { cc[i] = cs[s0 * 16 + fq * 8 + i]; sv[i] = sn[s0 * 16 + fq * 8 + i]; } }
#pragma unroll
        for (int ig = 0; ig < 8; ++ig) {
            const int ai = ig >> 2, m = ig & 3;
            const int rl = ai * HALF + wr * 64 + m * 16 + fr, row = u.pm * BM + rl, b = row >> 11, s = row & (SEQ - 1);
            if (rope && fq < 2 && ig < 7) { const int sn_ = (u.pm * BM + ((ig + 1) >> 2) * HALF + wr * 64 + ((ig + 1) & 3) * 16 + fr) & (SEQ - 1);
#pragma unroll
                for (int i = 0; i < 8; ++i) { ccn[i] = cs[sn_ * 16 + fq * 8 + i]; svn[i] = sn[sn_ * 16 + fq * 8 + i]; } }
            const float ss = xs[rl * 4 + hs * 2] + xs[rl * 4 + hs * 2 + 1];
            const float rn = __builtin_amdgcn_rsqf(ss * (1.0f / 96.0f) + EPS) * cmla;
            bf16_t* dst = Qc + ((size_t)((b * 6 + head) * SEQ + s)) * 96;
            if (!rope) {
#pragma unroll
                for (int bj = 0; bj < 2; ++bj) {
                    float o[8];
#pragma unroll
                    for (int n = 0; n < 2; ++n)
#pragma unroll
                        for (int j = 0; j < 4; ++j) o[n * 4 + j] = acc[ai][bj][m][n][j] * rn * gq[bj * 8 + n * 4 + j];
                    *(u32x4*)(dst + bj * 32 + fq * 8) = pack8(o);
                }
            } else if (fq < 2) {
                float o1[8], o2[8];
#pragma unroll
                for (int n = 0; n < 2; ++n)
#pragma unroll
                    for (int j = 0; j < 4; ++j) {
                        const int i = n * 4 + j;
                        const float x1 = acc[ai][0][m][n][j] * rn * gq[i], x2 = acc[ai][1][m][n][j] * rn * gq[8 + i];
                        o1[i] = x1 * cc[i] - x2 * sv[i]; o2[i] = x1 * sv[i] + x2 * cc[i];
                    }
                *(u32x4*)(dst + 64 + fq * 8) = pack8(o1);
                *(u32x4*)(dst + 80 + fq * 8) = pack8(o2);
#pragma unroll
                for (int i = 0; i < 8; ++i) { cc[i] = ccn[i]; sv[i] = svn[i]; }
            }
            asm volatile("" ::: "memory");
        }
    }
};

struct EpiMlaKV {
    static constexpr bool PERM = true, AFTER_DRAIN = false, DUP_OK = false;
    bf16_t *Kc, *Vc; const float *kn, *kr, *krss, *cs, *sn;
    __device__ __forceinline__ void operator()(const f32x4 (&acc)[2][2][4][2], const Unit& u_, int wr, int wc, int fr, int fq, PG8_LAS float* xs) const {
        Unit u = u_; EPI_OPAQUE();
        const int hs = wc >> 1, head = u.pn * 2 + hs;
        if (wc & 1) {
#pragma unroll
            for (int ai = 0; ai < 2; ++ai)
#pragma unroll
                for (int m = 0; m < 4; ++m) {
                    asm volatile("" ::: "memory");
                    const int rl = ai * HALF + wr * 64 + m * 16 + fr, row = u.pm * BM + rl, b = row >> 11, s = row & (SEQ - 1);
#pragma unroll
                    for (int bj = 0; bj < 2; ++bj) {
                        float o[8];
#pragma unroll
                        for (int n = 0; n < 2; ++n)
#pragma unroll
                            for (int j = 0; j < 4; ++j) o[n * 4 + j] = acc[ai][bj][m][n][j];
                        *(u32x4*)(Vc + ((size_t)((b * 6 + head) * SEQ + s)) * 64 + bj * 32 + fq * 8) = pack8(o);
                    }
                }
        } else {
            float gk[16], gr1[4], gr2[4];
#pragma unroll
            for (int i = 0; i < 16; ++i) gk[i] = kn[(i >> 3) * 32 + fq * 8 + (i & 7)];
#pragma unroll
            for (int j = 0; j < 4; ++j) { gr1[j] = kn[64 + fq * 4 + j]; gr2[j] = kn[80 + fq * 4 + j]; }
            f32x4 k1, k2, k1n, k2n, c4, s4, c4n, s4n; float kss, kssn;
            { const int row = u.pm * BM + wr * 64 + fr, s0 = row & (SEQ - 1);
              k1 = *(const f32x4*)(kr + (size_t)row * 32 + fq * 4); k2 = *(const f32x4*)(kr + (size_t)row * 32 + 16 + fq * 4); kss = krss[row];
              c4 = *(const f32x4*)(cs + s0 * 16 + fq * 4); s4 = *(const f32x4*)(sn + s0 * 16 + fq * 4); }
#pragma unroll
            for (int ig = 0; ig < 8; ++ig) {
                const int ai = ig >> 2, m = ig & 3;
                const int rl = ai * HALF + wr * 64 + m * 16 + fr, row = u.pm * BM + rl, b = row >> 11, s = row & (SEQ - 1);
                if (ig < 7) { const int rown = u.pm * BM + ((ig + 1) >> 2) * HALF + wr * 64 + ((ig + 1) & 3) * 16 + fr, s1 = rown & (SEQ - 1);
                    k1n = *(const f32x4*)(kr + (size_t)rown * 32 + fq * 4); k2n = *(const f32x4*)(kr + (size_t)rown * 32 + 16 + fq * 4); kssn = krss[rown];
                    c4n = *(const f32x4*)(cs + s1 * 16 + fq * 4); s4n = *(const f32x4*)(sn + s1 * 16 + fq * 4); }
                float ss = 0.f;
#pragma unroll
                for (int bj = 0; bj < 2; ++bj)
#pragma unroll
                    for (int n = 0; n < 2; ++n) { const f32x4 a = acc[ai][bj][m][n]; ss += (a[0] * a[0] + a[1] * a[1]) + (a[2] * a[2] + a[3] * a[3]); }
                ss = quad_sum(ss) + kss;
                const float rn = __builtin_amdgcn_rsqf(ss * (1.0f / 96.0f) + EPS);
                bf16_t* dst = Kc + ((size_t)((b * 6 + head) * SEQ + s)) * 96;
#pragma unroll
                for (int bj = 0; bj < 2; ++bj) {
                    float o[8];
#pragma unroll
                    for (int n = 0; n < 2; ++n)
#pragma unroll
                        for (int j = 0; j < 4; ++j) o[n * 4 + j] = acc[ai][bj][m][n][j] * rn * gk[bj * 8 + n * 4 + j];
                    *(u32x4*)(dst + bj * 32 + fq * 8) = pack8(o);
                }
                float o1[4], o2[4];
#pragma unroll
                for (int j = 0; j < 4; ++j) {
                    const float x1 = k1[j] * rn * gr1[j], x2 = k2[j] * rn * gr2[j];
                    o1[j] = x1 * c4[j] - x2 * s4[j]; o2[j] = x1 * s4[j] + x2 * c4[j];
                }
                *(u32x2*)(dst + 64 + fq * 4) = (u32x2){cvt_pk_bf16(o1[0], o1[1]), cvt_pk_bf16(o1[2], o1[3])};
                *(u32x2*)(dst + 80 + fq * 4) = (u32x2){cvt_pk_bf16(o2[0], o2[1]), cvt_pk_bf16(o2[2], o2[3])};
                k1 = k1n; k2 = k2n; kss = kssn; c4 = c4n; s4 = s4n;
                asm volatile("" ::: "memory");
            }
        }
    }
};

struct EpiMlaQKV {
    static constexpr bool PERM = true, AFTER_DRAIN = false, DUP_OK = false;
    EpiMlaQ eq; EpiMlaKV ekv;
    __device__ __forceinline__ void operator()(const f32x4 (&acc)[2][2][4][2], const Unit& u_, int wr, int wc, int fr, int fq, PG8_LAS float* xs) const {
        if (u_.pn < 3) eq(acc, u_, wr, wc, fr, fq, xs);
        else { Unit v = u_; v.pn -= 3; ekv(acc, v, wr, wc, fr, fq, xs); }
    }
};
template <class Epi, class Sched, bool ALIGN_EPI = false, bool SP2 = false>
__device__ __forceinline__ void gemm_phase(const int tid, PG8_LAS unsigned char* lds, PG8_LAS float* xs, const Gemm g, const Sched& S, const Epi& E) {
    const int wid = __builtin_amdgcn_readfirstlane(tid >> 6), lane = tid & 63, wr = wid >> 2, wc = wid & 3, fr = lane & 15, fq = lane >> 4;
    const int K = g.K, nt = K / BK;
    unsigned voffA[2], voffB[2];
#pragma unroll
    for (int i = 0; i < 2; ++i) { int R, C; stage_rc(tid * 16 + i * 8192, R, C); const int Rb = Epi::PERM ? ((R & ~31) + perm32(R & 31)) : R;
        voffA[i] = (unsigned)(R * g.lda + C) * 2u; voffB[i] = (unsigned)(Rb * g.ldb + C) * 2u; }
    const size_t kstep = (size_t)(BK * 2);
    const size_t hstepA = (size_t)HALF * g.lda * 2, hstepB = (size_t)HALF * g.ldb * 2;
    const size_t tstepA = 2 * hstepA, tstepB = 2 * hstepB;
    const unsigned ldsw = (unsigned)wid * 1024u;
    const int aoff = lds_byte(wr * 64 + fr, fq * 8), boff = lds_byte(wc * 32 + fr, fq * 8);
#define PG8_SA(b, h) (((b) * 2 + (h)) * HTB)
#define PG8_SB(b, h) ((4 + (b) * 2 + (h)) * HTB)
#define PG8_STAGE(bufoff, gbase, voff) do { _Pragma("unroll") for (int _i = 0; _i < 2; ++_i) \
        __builtin_amdgcn_global_load_lds((const unsigned*)((const char*)(gbase) + (voff)[_i]), (PG8_LAS unsigned*)(lds + (bufoff) + ldsw + _i * 8192), 16, 0, 0); } while (0)
#define PG8_LDA(dst, b, h) do { _Pragma("unroll") for (int m = 0; m < 4; ++m) _Pragma("unroll") for (int k = 0; k < 2; ++k) dst[m][k] = *(const PG8_LAS bf16x8*)(lds + PG8_SA(b, h) + aoff + m * 2048 + k * 1024); } while (0)
#define PG8_LDB(dst, b, h) do { _Pragma("unroll") for (int n = 0; n < 2; ++n) _Pragma("unroll") for (int k = 0; k < 2; ++k) dst[n][k] = *(const PG8_LAS bf16x8*)(lds + PG8_SB(b, h) + boff + n * 2048 + k * 1024); } while (0)
#define PG8_MMA(ai, bj, At, Bt) do { __builtin_amdgcn_s_setprio(1); _Pragma("unroll") for (int m = 0; m < 4; ++m) _Pragma("unroll") for (int n = 0; n < 2; ++n) _Pragma("unroll") for (int k = 0; k < 2; ++k) \
        acc[ai][bj][m][n] = __builtin_amdgcn_mfma_f32_16x16x32_bf16(Bt[n][k], At[m][k], acc[ai][bj][m][n], 0, 0, 0); __builtin_amdgcn_s_setprio(0); } while (0)
#define PG8_WAIT_V(n) asm volatile("s_waitcnt vmcnt(" #n ")" ::: "memory")
#define PG8_WAIT_L(n) asm volatile("s_waitcnt lgkmcnt(" #n ")" ::: "memory")
#define PG8_BAR __builtin_amdgcn_s_barrier()
#define PG8_SCHED __builtin_amdgcn_sched_barrier(0)
    Unit cur, nxt; int ui = 0;
    if (!S.next(0, cur)) return;
    f32x4 acc[2][2][4][2];
#pragma unroll
    for (int a = 0; a < 2; ++a)
#pragma unroll
        for (int b = 0; b < 2; ++b)
#pragma unroll
            for (int m = 0; m < 4; ++m)
#pragma unroll
                for (int n = 0; n < 2; ++n) acc[a][b][m][n] = (f32x4){0.f, 0.f, 0.f, 0.f};
    bf16x8 At[4][2], B0[2][2], B1[2][2];
    const char* cA = (const char*)g.A + (size_t)cur.pm * tstepA + (cur.pn >= g.asplit ? g.aoff : 0); const char* cB = (const char*)g.Bt + (size_t)cur.pn * tstepB;
    S.a_ready(cur);
    if constexpr (SP2) {
        PG8_STAGE(PG8_SB(0, 0), cB, voffB); PG8_STAGE(PG8_SB(0, 1), cB + hstepB, voffB); PG8_STAGE(PG8_SA(0, 0), cA, voffA); PG8_STAGE(PG8_SA(0, 1), cA + hstepA, voffA);
        if (wr == 1) PG8_BAR;
        PG8_WAIT_V(2); PG8_BAR;
        PG8_STAGE(PG8_SB(1, 0), cB + kstep, voffB); PG8_STAGE(PG8_SA(1, 0), cA + kstep, voffA); PG8_STAGE(PG8_SB(1, 1), cB + hstepB + kstep, voffB);
        PG8_WAIT_V(6); PG8_BAR;
    } else {
        PG8_STAGE(PG8_SB(0, 0), cB, voffB); PG8_STAGE(PG8_SA(0, 0), cA, voffA); PG8_STAGE(PG8_SB(0, 1), cB + hstepB, voffB); PG8_STAGE(PG8_SA(0, 1), cA + hstepA, voffA);
        if (wr == 1) PG8_BAR;
        PG8_WAIT_V(4); PG8_BAR;
        PG8_STAGE(PG8_SB(1, 0), cB + kstep, voffB); PG8_STAGE(PG8_SA(1, 0), cA + kstep, voffA); PG8_STAGE(PG8_SB(1, 1), cB + hstepB + kstep, voffB);
        PG8_WAIT_V(6); PG8_BAR;
    }
    for (;;) {
        const bool has_next = S.next(ui + 1, nxt);
        const char* nA = has_next ? (const char*)g.A + (size_t)nxt.pm * tstepA + (nxt.pn >= g.asplit ? g.aoff : 0) : cA; const char* nB = has_next ? (const char*)g.Bt + (size_t)nxt.pn * tstepB : cB;
        for (int t = 0; t < nt; t += 2) {
            const bool last = (t == nt - 2);
            const char* a1 = cA + (size_t)(t + 1) * kstep;
            const char* a2 = last ? nA : cA + (size_t)(t + 2) * kstep; const char* b2 = last ? nB : cB + (size_t)(t + 2) * kstep;
            const char* a3 = a2 + kstep; const char* b3 = b2 + kstep;
            if (last && has_next) S.a_ready(nxt);
            if constexpr (SP2) {
            PG8_LDB(B0, 0, 0); PG8_LDB(B1, 0, 1); PG8_SCHED; PG8_LDA(At, 0, 0); PG8_STAGE(PG8_SA(1, 1), a1 + hstepA, voffA);
            PG8_WAIT_V(8); PG8_WAIT_L(0); PG8_BAR; PG8_MMA(0, 0, At, B0); PG8_MMA(0, 1, At, B1); PG8_BAR; PG8_SCHED;
            PG8_LDA(At, 0, 1); PG8_STAGE(PG8_SB(0, 0), b2, voffB); PG8_STAGE(PG8_SB(0, 1), b2 + hstepB, voffB); PG8_STAGE(PG8_SA(0, 0), a2, voffA);
            PG8_WAIT_V(8); PG8_WAIT_L(0); PG8_BAR; PG8_MMA(1, 0, At, B0); PG8_MMA(1, 1, At, B1); PG8_BAR; PG8_SCHED;
            PG8_LDB(B0, 1, 0); PG8_LDB(B1, 1, 1); PG8_SCHED; PG8_LDA(At, 1, 0); PG8_STAGE(PG8_SA(0, 1), a2 + hstepA, voffA);
            PG8_WAIT_V(8); PG8_WAIT_L(0); PG8_BAR; PG8_MMA(0, 0, At, B0); PG8_MMA(0, 1, At, B1); PG8_BAR; PG8_SCHED;
            PG8_LDA(At, 1, 1); PG8_STAGE(PG8_SB(1, 0), b3, voffB); PG8_STAGE(PG8_SB(1, 1), b3 + hstepB, voffB); PG8_STAGE(PG8_SA(1, 0), a3, voffA);
            PG8_WAIT_V(8); PG8_WAIT_L(0); PG8_BAR; PG8_MMA(1, 0, At, B0); PG8_MMA(1, 1, At, B1); PG8_BAR; PG8_SCHED;
            } else {
            PG8_LDB(B0, 0, 0); PG8_SCHED; PG8_LDA(At, 0, 0); PG8_STAGE(PG8_SA(1, 1), a1 + hstepA, voffA);
            PG8_WAIT_L(8); PG8_BAR; PG8_WAIT_L(0); PG8_MMA(0, 0, At, B0); PG8_BAR; PG8_SCHED;
            PG8_LDB(B1, 0, 1); PG8_STAGE(PG8_SB(0, 0), b2, voffB);
            PG8_BAR; PG8_WAIT_L(0); PG8_MMA(0, 1, At, B1); PG8_BAR;
            PG8_LDA(At, 0, 1); PG8_STAGE(PG8_SA(0, 0), a2, voffA);
            PG8_BAR; PG8_WAIT_L(0); PG8_MMA(1, 0, At, B0); PG8_BAR; PG8_SCHED;
            PG8_STAGE(PG8_SB(0, 1), b2 + hstepB, voffB);
            PG8_WAIT_V(6); PG8_BAR; PG8_MMA(1, 1, At, B1); PG8_BAR;
            PG8_LDB(B0, 1, 0); PG8_SCHED; PG8_LDA(At, 1, 0); PG8_STAGE(PG8_SA(0, 1), a2 + hstepA, voffA);
            PG8_WAIT_L(8); PG8_BAR; PG8_WAIT_L(0); PG8_MMA(0, 0, At, B0); PG8_BAR; PG8_SCHED;
            PG8_LDB(B1, 1, 1); PG8_STAGE(PG8_SB(1, 0), b3, voffB);
            PG8_BAR; PG8_WAIT_L(0); PG8_MMA(0, 1, At, B1); PG8_BAR;
            PG8_LDA(At, 1, 1); PG8_STAGE(PG8_SA(1, 0), a3, voffA);
            PG8_BAR; PG8_WAIT_L(0); PG8_MMA(1, 0, At, B0); PG8_BAR; PG8_SCHED;
            PG8_STAGE(PG8_SB(1, 1), b3 + hstepB, voffB);
            PG8_WAIT_V(6); PG8_BAR; PG8_MMA(1, 1, At, B1); PG8_BAR;
            }
        }
        if constexpr (ALIGN_EPI) { if (wr == 0) PG8_BAR; }
        if constexpr (!Epi::AFTER_DRAIN) { E(acc, cur, wr, wc, fr, fq, xs);
#if defined(MK_DUP_EPI)
            if constexpr (Epi::DUP_OK) E(acc, cur, wr, wc, fr, fq, xs);
#endif
            S.done(cur); }
        if (!has_next) break;
#pragma unroll
        for (int a = 0; a < 2; ++a)
#pragma unroll
            for (int b = 0; b < 2; ++b)
#pragma unroll
                for (int m = 0; m < 4; ++m)
#pragma unroll
                    for (int n = 0; n < 2; ++n) acc[a][b][m][n] = (f32x4){0.f, 0.f, 0.f, 0.f};
        cur = nxt; cA = nA; cB = nB; ++ui;
        if constexpr (ALIGN_EPI) { if (wr == 1) PG8_BAR; }
    }
    PG8_WAIT_V(0);
    if constexpr (!ALIGN_EPI) { if (wr == 0) PG8_BAR; }
    PG8_BAR;
    if constexpr (Epi::AFTER_DRAIN) { E(acc, cur, wr, wc, fr, fq, xs); S.done(cur); }
#undef PG8_SA
#undef PG8_SB
#undef PG8_STAGE
#undef PG8_LDA
#undef PG8_LDB
#undef PG8_MMA
#undef PG8_WAIT_V
#undef PG8_WAIT_L
#undef PG8_BAR
#undef PG8_SCHED
}
}

constexpr size_t MiB = 1u << 20;
constexpr size_t WS_CTL = 0, CTL_ZERO_BYTES = 32 * 1024;
constexpr size_t WS_TAB = 1 * MiB;
constexpr size_t WS_P = 2 * MiB;
constexpr size_t WS_KR = 5 * MiB;
constexpr size_t WS_KRSS = 7 * MiB;
constexpr size_t WS_W = 8 * MiB;
constexpr size_t W_GU1 = WS_W, W_GU2 = W_GU1 + 11 * MiB, W_D1 = W_GU2 + 11 * MiB, W_D2 = W_D1 + 5632 * 1024, W_IN = W_D2 + 5632 * 1024, W_O = W_IN + 5 * MiB, W_QU = W_O + 2 * MiB, W_KVU = W_QU + 768 * 256 * 2, W_END = W_KVU + 768 * 256 * 2;
static_assert(W_END <= 50 * MiB, "weights");
constexpr size_t WS_XB = 50 * MiB;
constexpr size_t WS_R = 82 * MiB;
constexpr size_t WS_H = WS_R;
constexpr size_t WS_QD = WS_R, WS_KD = WS_QD + 8 * MiB, WS_VD = WS_KD + 8 * MiB, WS_QL = WS_VD + 8 * MiB, WS_KL = WS_QL + 12 * MiB, WS_VL = WS_KL + 12 * MiB;
constexpr size_t WS_QC = WS_VL + 12 * MiB, WS_KC = WS_QC + 18 * MiB, WS_VC = WS_KC + 18 * MiB, WS_AQ = WS_VC + 12 * MiB, WS_MIX = WS_AQ + 12 * MiB, WS_END = WS_MIX + 32 * MiB;
static_assert(WS_END <= 236 * MiB && WS_H + (size_t)MTOK * DFF * 2 <= WS_MIX, "d_ws map");
constexpr size_t WS_DO0 = 0, WS_DO1 = 12 * MiB, WS_DO2 = 24 * MiB, WS_DL = 36 * MiB, WS_TOTAL = 236 * MiB;
constexpr int TAB_COS = 0, TAB_SIN = 32768;
constexpr int TAB_BD = 65536;
constexpr int TAB_BL = TAB_BD + 2 * 4 * 4096;
constexpr int TAB_SC = TAB_BL + 2 * 6 * 4096;
static_assert((TAB_SC + 64) * 4 <= (int)MiB, "tables");
constexpr int CW_BAR = 4096;

constexpr int RING_BYTES = 131072, XS_OFF = 155648, XS_BYTES = 4096, MISC_OFF = 159744, LDS_BYTES = 163840;

#define GAS __attribute__((address_space(1)))
#define LAS __attribute__((address_space(3)))
typedef unsigned short bf16;
typedef unsigned v4u __attribute__((ext_vector_type(4)));
typedef float f32x4 __attribute__((ext_vector_type(4)));
typedef GAS unsigned gu32;
#define RLX_AGENT __ATOMIC_RELAXED, __HIP_MEMORY_SCOPE_AGENT
#define LDS_WAIT() asm volatile("s_waitcnt lgkmcnt(0)" ::: "memory")
__device__ __forceinline__ unsigned f2bf(float f) { unsigned u = __builtin_bit_cast(unsigned, f); return (u + 0x7fffu + ((u >> 16) & 1u)) >> 16; }
__device__ __forceinline__ unsigned pk2(float lo, float hi) { return f2bf(lo) | (f2bf(hi) << 16); }
__device__ __forceinline__ float bflo(unsigned w) { return __builtin_bit_cast(float, w << 16); }
__device__ __forceinline__ float bfhi(unsigned w) { return __builtin_bit_cast(float, w & 0xffff0000u); }
__device__ __forceinline__ void unpack8(v4u w, float* o) { o[0] = bflo(w.x); o[1] = bfhi(w.x); o[2] = bflo(w.y); o[3] = bfhi(w.y); o[4] = bflo(w.z); o[5] = bfhi(w.z); o[6] = bflo(w.w); o[7] = bfhi(w.w); }

#define XB_TMO      128
#define XB_XCNT(j)  (256  + 64 * (j))
#define XB_XSUB(j)  (1280 + 64 * (j))
#define XB_XGEN(j)  (2304 + 64 * (j))
#define XB_TOP      3328
#define XB_TOPGEN   3392
#define XCD_BAR_WORDS 3456
#define XB_SPIN_CAP (1u << 22)

__device__ __forceinline__ unsigned xb_ld(unsigned* p)              { return __hip_atomic_load(p, __ATOMIC_RELAXED, __HIP_MEMORY_SCOPE_AGENT); }
__device__ __forceinline__ unsigned xb_add(unsigned* p, unsigned v) { return __hip_atomic_fetch_add(p, v, __ATOMIC_RELAXED, __HIP_MEMORY_SCOPE_AGENT); }
__device__ __forceinline__ unsigned xb_xcc_id() { return (unsigned)__builtin_amdgcn_s_getreg((3 << 11) | 20) & 0xFu; }
#define XB_SPIN(cond, bar) do { unsigned _sp = 0; while (cond) { __builtin_amdgcn_s_sleep(1); \
    if ((++_sp & 255u) == 0u) { if (xb_ld(&(bar)[XB_TMO])) break; if (_sp > XB_SPIN_CAP) { atomicAdd(&(bar)[XB_TMO], 1u); break; } } } } while (0)

__device__ __forceinline__ void xcd_barrier_post(unsigned* bar, volatile LAS unsigned* st, bool tid0) {
    if (tid0) { const unsigned x = xb_xcc_id(); st[2] = x; (void)xb_add(&bar[XB_XCNT(x)], 1u); }
}
__device__ __forceinline__ void xcd_barrier_complete(unsigned* bar, unsigned x, unsigned& nloc, unsigned& nx) {
    const unsigned G = gridDim.x * gridDim.y * gridDim.z;
    unsigned sum, cnt, mine, sp = 0u;
    for (;;) {
        sum = 0u; cnt = 0u; mine = 0u;
        for (unsigned j = 0; j < 16; ++j) { const unsigned c = xb_ld(&bar[XB_XCNT(j)]); sum += c; cnt += (c > 0u) ? 1u : 0u; mine = (j == x) ? c : mine; }
        if (sum == G) break;
        __builtin_amdgcn_s_sleep(1);
        if ((++sp & 255u) == 0u) { if (xb_ld(&bar[XB_TMO])) break; if (sp > XB_SPIN_CAP) { atomicAdd(&bar[XB_TMO], 1u); break; } }
    }
    nloc = mine > 0u ? mine : 1u; nx = cnt > 0u ? cnt : 1u;
}
__device__ __forceinline__ void xcd_barrier(unsigned* bar0, volatile LAS unsigned* st, bool tid0) {
    asm volatile("s_waitcnt vmcnt(0)" ::: "memory");
    __syncthreads();
    if (tid0) {
        unsigned* bar = bar0; asm volatile("" : "+v"(bar));
        __builtin_amdgcn_s_waitcnt(0);
        unsigned nloc = st[0], nx = st[1]; const unsigned x = st[2];
        if (nloc == 0u) { xcd_barrier_complete(bar, x, nloc, nx); st[0] = nloc; st[1] = nx; }
#if MK_EARLY_WB
        __builtin_amdgcn_fence(__ATOMIC_RELEASE, "agent");
        asm volatile("s_waitcnt vmcnt(0)" ::: "memory");
#endif
        const unsigned old = xb_add(&bar[XB_XSUB(x)], 1u);
        const unsigned gen = old / nloc;
        if (old + 1u == (gen + 1u) * nloc) {
            __builtin_amdgcn_fence(__ATOMIC_RELEASE, "agent");
            asm volatile("s_waitcnt vmcnt(0)" ::: "memory");
            const unsigned og = xb_add(&bar[XB_TOP], 1u);
            const unsigned tg = og / nx;
            if (og + 1u == (tg + 1u) * nx) xb_add(&bar[XB_TOPGEN], 1u);
            else XB_SPIN(xb_ld(&bar[XB_TOPGEN]) == tg, bar);
            __builtin_amdgcn_fence(__ATOMIC_ACQUIRE, "agent");
            xb_add(&bar[XB_XGEN(x)], 1u);
            asm volatile("s_waitcnt vmcnt(0)" ::: "memory");
        } else {
            XB_SPIN(xb_ld(&bar[XB_XGEN(x)]) == gen, bar);
            __builtin_amdgcn_fence(__ATOMIC_ACQUIRE, "agent");
            asm volatile("s_waitcnt vmcnt(0)" ::: "memory");
        }
    }
    __syncthreads();
}

#ifndef MK_PROBE_BLOCK
#define MK_PROBE_BLOCK 0
#endif
#if MK_PROBE
#define PROBE_T0(var) const unsigned var = (unsigned)__builtin_amdgcn_readfirstlane((int)__builtin_amdgcn_s_memrealtime())
#define PROBE_ADD(id, var, shm) do { if (MK_PROBE == (id) && blockIdx.x == MK_PROBE_BLOCK) { const unsigned d_ = (unsigned)__builtin_amdgcn_s_memrealtime() - (var); \
        volatile LAS unsigned* pm_ = (volatile LAS unsigned*)((LAS unsigned char*)(shm) + MISC_OFF + 96); if (threadIdx.x == 0) pm_[0] = pm_[0] + (unsigned)d_; } } while (0)
#else
#define PROBE_T0(var) do {} while (0)
#define PROBE_ADD(id, var, shm) do {} while (0)
#endif
struct Args { const float* in[25]; float* out; unsigned char* ws; int layer, pad; };
enum { I_X = 0, I_RELB, I_F1N, I_F1G, I_F1U, I_F1D, I_MIXN, I_WIN, I_DQN, I_DKN, I_DLAM, I_DSUB, I_LQN, I_LKN, I_MQN, I_MQU, I_MKVN, I_MKVU, I_MQNG, I_MKNG, I_WO, I_F2N, I_F2G, I_F2U, I_F2D };

__device__ __forceinline__ float wave_sum(float v) { v += swz<1>(v); v += swz<2>(v); v += swz<4>(v); v += swz<8>(v); v += swz<16>(v); return sum_x32(v); }
__device__ __forceinline__ float wave_max(float v) { v = fmaxf(v, swz<1>(v)); v = fmaxf(v, swz<2>(v)); v = fmaxf(v, swz<4>(v)); v = fmaxf(v, swz<8>(v)); v = fmaxf(v, swz<16>(v)); return max_x32(v); }

__device__ __forceinline__ const void* lds_ptr_get(volatile LAS unsigned long long* PT, int i) {
    const unsigned long long v = PT[i];
    const unsigned lo = __builtin_amdgcn_readfirstlane((unsigned)v), hi = __builtin_amdgcn_readfirstlane((unsigned)(v >> 32));
    return (const void*)(((unsigned long long)hi << 32) | lo);
}
#define AIN(i) ((const float*)lds_ptr_get(PT, (i)))
__device__ __forceinline__ void tr_item64(const float* W, int Nsrc, int ks0, const float* gain, int sc, bool valid, bf16* dstrow) {
    float v[64];
    const float* src = W + (size_t)ks0 * Nsrc + sc;
#pragma unroll
    for (int i = 0; i < 64; ++i) v[i] = valid ? src[(size_t)i * Nsrc] : 0.f;
    if (gain) {
        int z = 0; asm volatile("" : "+v"(z));
        const float* gp = gain + ks0 + z;
        float gk[64];
#pragma unroll
        for (int i = 0; i < 64; ++i) gk[i] = gp[i];
#pragma unroll
        for (int i = 0; i < 64; ++i) v[i] *= gk[i];
    }
#pragma unroll
    for (int j = 0; j < 8; ++j) { v4u o; o.x = pk2(v[8 * j], v[8 * j + 1]); o.y = pk2(v[8 * j + 2], v[8 * j + 3]); o.z = pk2(v[8 * j + 4], v[8 * j + 5]); o.w = pk2(v[8 * j + 6], v[8 * j + 7]);
        *(GAS v4u*)(dstrow + 8 * j) = o; }
}

__device__ __forceinline__ void win_map(int g, int& sc, int& nvalid) {
    const int pn = g >> 3, gi = g & 7, bj = gi >> 2, wc = gi & 3; nvalid = 32;
    switch (pn) {
        case 0: sc = 0 + wc * 64 + bj * 32; break;
        case 1: sc = 256 + wc * 64 + bj * 32; break;
        case 2: sc = 512 + wc * 64 + bj * 32; break;
        case 3: sc = 768 + wc * 64 + bj * 32; break;
        case 4: sc = (wc < 2) ? 768 + (4 + wc) * 64 + bj * 32 : 1152 + (wc - 2) * 64 + bj * 32; break;
        case 5: sc = 1152 + (wc + 2) * 64 + bj * 32; break;
        case 6: sc = 1536 + wc * 64 + bj * 32; break;
        case 7: sc = (wc < 2) ? 1536 + (4 + wc) * 64 + bj * 32 : 2176 + (wc - 2) * 64 + bj * 32; break;
        case 8: sc = 1920 + bj * 128 + wc * 32; break;
        default: sc = 2176 + 128 + bj * 16; nvalid = (wc == 0) ? 16 : 0; break;
    }
}

__device__ __forceinline__ void convert_weights(volatile LAS unsigned long long* PT, unsigned char* ws, int l, int sel, int gw, int NGW, int lane) {
    constexpr int I_GU = (5632 / 64) * 16, I_D = 16 * 44, I_IN = 40 * 16, I_O = 16 * 16, I_QU = 12 * 4, I_KVU = 12 * 4;
    constexpr int NITEMS = 2 * I_GU + 2 * I_D + I_IN + I_O + I_QU + I_KVU;
    const int lg = lane >> 5, li = lane & 31;
    for (int it = gw; it < NITEMS; it += NGW) {
        int r = it;
        if (r < 2 * I_GU) {
            const int f = r / I_GU; r -= f * I_GU; if (!((sel >> f) & 1)) continue; const int G2 = r >> 4, kb = r & 15, g = 2 * G2 + lg;
            const int pn = g >> 3, gi = g & 7, bj = gi >> 2, wc = gi & 3;
            const float* Wg = AIN(f == 0 ? I_F1G : I_F2G) + (size_t)l * DM * DFF; const float* Wu = AIN(f == 0 ? I_F1U : I_F2U) + (size_t)l * DM * DFF;
            const float* gain = AIN(f == 0 ? I_F1N : I_F2N) + l * DM;
            bf16* dst = (bf16*)(ws + (f == 0 ? W_GU1 : W_GU2)) + (size_t)(32 * g + li) * DM + 64 * kb;
            tr_item64(bj == 0 ? Wg : Wu, DFF, 64 * kb, gain, pn * 128 + wc * 32 + li, true, dst); continue;
        }
        r -= 2 * I_GU;
        if (r < 2 * I_D) {
            const int f = r / I_D; r -= f * I_D; if (!((sel >> (2 + f)) & 1)) continue; const int G2 = r / 44, kb = r - G2 * 44;
            const float* W = AIN(f == 0 ? I_F1D : I_F2D) + (size_t)l * DFF * DM;
            bf16* dst = (bf16*)(ws + (f == 0 ? W_D1 : W_D2)) + (size_t)(64 * G2 + lane) * DFF + 64 * kb;
            tr_item64(W, DM, 64 * kb, nullptr, 64 * G2 + lane, true, dst); continue;
        }
        r -= 2 * I_D;
        if (r < I_IN) {
            if (!(sel & 16)) continue;
            const int G2 = r >> 4, kb = r & 15, g = 2 * G2 + lg; int sc, nv; win_map(g, sc, nv);
            const float* W = AIN(I_WIN) + (size_t)l * DM * IN_W;
            bf16* dst = (bf16*)(ws + W_IN) + (size_t)(32 * g + li) * DM + 64 * kb;
            tr_item64(W, IN_W, 64 * kb, AIN(I_MIXN) + l * DM, sc + li, li < nv, dst); continue;
        }
        r -= I_IN;
        if (r < I_O) {
            if (!(sel & 32)) continue;
            const int G2 = r >> 4, kb = r & 15;
            bf16* dst = (bf16*)(ws + W_O) + (size_t)(64 * G2 + lane) * DM + 64 * kb;
            tr_item64(AIN(I_WO) + (size_t)l * DM * DM, DM, 64 * kb, nullptr, 64 * G2 + lane, true, dst); continue;
        }
        r -= I_O;
        if (r < I_QU) {
            if (!(sel & 64)) continue;
            const int G2 = r >> 2, kb = r & 3, g = 2 * G2 + lg; const int pn = g >> 3, gi = g & 7, bj = gi >> 2, wc = gi & 3, head = pn * 2 + (wc >> 1);
            const int sc = (wc & 1) ? head * 96 + 64 + 16 * bj : head * 96 + 32 * bj, nv = (wc & 1) ? 16 : 32;
            bf16* dst = (bf16*)(ws + W_QU) + (size_t)(32 * g + li) * 256 + 64 * kb;
            tr_item64(AIN(I_MQU) + (size_t)l * 256 * 576, 576, 64 * kb, AIN(I_MQN) + l * 256, sc + li, li < nv, dst); continue;
        }
        r -= I_QU;
        {
            if (!(sel & 128)) continue;
            const int G2 = r >> 2, kb = r & 3, g = 2 * G2 + lg; const int pn = g >> 3, gi = g & 7, bj = gi >> 2, wc = gi & 3, head = pn * 2 + (wc >> 1);
            const int sc = head * 128 + ((wc & 1) ? 64 : 0) + 32 * bj;
            bf16* dst = (bf16*)(ws + W_KVU) + (size_t)(32 * g + li) * 256 + 64 * kb;
            if (kb < 2) tr_item64(AIN(I_MKVU), 768, 0, nullptr, 0, false, dst);
            else tr_item64(AIN(I_MKVU) + (size_t)l * 128 * 768, 768, 64 * (kb - 2), AIN(I_MKVN) + l * 128, sc + li, true, dst);
        }
    }
}

__device__ __forceinline__ int t5_bucket(int rel) {
    const int n = rel < 0 ? -rel : rel;
    const float nf = (float)(n > 1 ? n : 1);
    int large = 8 + (int)(logf(nf / 8.0f) / 4.852030263919617f * 8.0f);
    large = large < 15 ? large : 15;
    return (rel > 0 ? 16 : 0) + (n < 8 ? n : large);
}

__device__ __forceinline__ void prologue_misc(volatile LAS unsigned long long* PT, unsigned char* ws, int gw, int NGW, int lane, int gtid, int NGT) {
    float* tab = (float*)(ws + WS_TAB);
    for (int i = gtid; i < SEQ * 16; i += NGT) { const int s = i >> 4, j = i & 15; const double inv = pow(10000.0, -(double)j / 16.0), ang = (double)s * inv; tab[TAB_COS + i] = (float)cos(ang); tab[TAB_SIN + i] = (float)sin(ang); }
    for (int l = 0; l < DEPTH; ++l) {
        const float* relb = AIN(I_RELB);
        float mbd = 0.f, mbl = 0.f;
        for (int i = lane; i < 320; i += 64) { const float v = fabsf(relb[i]); if ((i % 10) < 4) mbd = fmaxf(mbd, v); else mbl = fmaxf(mbl, v); }
        mbd = wave_max(mbd); mbl = wave_max(mbl);
        float gq = (lane < 32) ? fabsf(AIN(I_DQN)[l * 32 + lane]) : 0.f, gk = (lane < 32) ? fabsf(AIN(I_DKN)[l * 32 + lane]) : 0.f;
        gq = wave_max(gq); gk = wave_max(gk);
        const float B2d = (5.656854249f * gq * gk + mbd) * LOG2E;
        float lq = fabsf(AIN(I_LQN)[l * 64 + lane]), lk = fabsf(AIN(I_LKN)[l * 64 + lane]);
        lq = wave_max(lq); lk = wave_max(lk);
        const float B2l = (8.0f * lq * lk + mbl) * LOG2E;
        float mq = fmaxf(fabsf(AIN(I_MQNG)[l * 96 + lane]), lane < 32 ? fabsf(AIN(I_MQNG)[l * 96 + 64 + lane]) : 0.f);
        float mk = fmaxf(fabsf(AIN(I_MKNG)[l * 96 + lane]), lane < 32 ? fabsf(AIN(I_MKNG)[l * 96 + 64 + lane]) : 0.f);
        mq = wave_max(mq); mk = wave_max(mk);
        const float B2c = 9.797958971f * mq * mk * LOG2E;
        for (int i = gtid; i < 10 * 4096; i += NGT) {
            const int h = i >> 12, idx = i & 4095, rel = idx - 2048; const int bk = t5_bucket(rel);
            if (h < 4) tab[TAB_BD + (l * 4 + h) * 4096 + idx] = relb[bk * 10 + h] * LOG2E - B2d;
            else tab[TAB_BL + (l * 6 + (h - 4)) * 4096 + idx] = relb[bk * 10 + h] * LOG2E - B2l;
        }
        if (gw == 0) {
            const float* lp = AIN(I_DLAM) + l * 128;
            float s1 = (lane < 32) ? lp[lane] * lp[32 + lane] : 0.f, s2 = (lane < 32) ? lp[64 + lane] * lp[96 + lane] : 0.f;
            s1 = wave_sum(s1); s2 = wave_sum(s2);
            const float linit = 0.8f - 0.6f * expf(-0.3f * (float)(l + 1));
            if (lane == 0) { tab[TAB_SC + l * 8 + 0] = expf(s1) - expf(s2) + linit; tab[TAB_SC + l * 8 + 1] = 1.0f - linit; tab[TAB_SC + l * 8 + 2] = -B2c; }
        }
    }
    float* P0 = (float*)(ws + WS_P);
    const float* xin = AIN(I_X);
    for (int m0 = gw * 4; m0 < MTOK; m0 += NGW * 4) {
        f32x4 v[4][4];
#pragma unroll
        for (int r = 0; r < 4; ++r)
#pragma unroll
            for (int j = 0; j < 4; ++j) v[r][j] = ((const GAS f32x4*)(xin + (size_t)(m0 + r) * DM) + lane)[64 * j];
#pragma unroll
        for (int r = 0; r < 4; ++r) {
            GAS unsigned long long* o8 = (GAS unsigned long long*)((bf16*)(ws + WS_XB) + (size_t)(m0 + r) * DM) + lane;
            float s = 0.f;
#pragma unroll
            for (int j = 0; j < 4; ++j) { const f32x4 w = v[r][j]; s += (w.x * w.x + w.y * w.y) + (w.z * w.z + w.w * w.w);
                o8[64 * j] = (unsigned long long)pk2(w.x, w.y) | ((unsigned long long)pk2(w.z, w.w) << 32); }
            s = wave_sum(s);
            if (lane < 16) P0[(size_t)(m0 + r) * 16 + lane] = lane == 0 ? s : 0.f;
        }
    }
}

namespace att {
typedef short bf16x8 __attribute__((ext_vector_type(8)));
typedef short s16x4 __attribute__((ext_vector_type(4)));
typedef short v4i16_t __attribute__((ext_vector_type(4)));
typedef float f32x16 __attribute__((ext_vector_type(16)));
typedef unsigned u32x4 __attribute__((ext_vector_type(4)));
typedef __attribute__((address_space(3))) const char* lds_cptr;
typedef __attribute__((address_space(3))) char* lds_ptr;
typedef float f32x2_t __attribute__((ext_vector_type(2))); typedef __bf16 bf16x2_t __attribute__((ext_vector_type(2)));
__device__ __forceinline__ int crow(int r, int hi) { return (r & 3) + 8 * (r >> 2) + 4 * hi; }
__device__ __forceinline__ void glds16(const void* gsrc, unsigned lds_dst) { unsigned keep;
    asm volatile("s_mov_b32 %0, m0\n\ts_mov_b32 m0, %2\n\ts_nop 0\n\tglobal_load_lds_dwordx4 %1, off\n\ts_mov_b32 m0, %0" : "=&s"(keep) : "v"(gsrc), "s"(lds_dst) : "memory"); }
__device__ __forceinline__ unsigned cvtpk_s(float lo, float hi) { f32x2_t v = {lo, hi}; bf16x2_t b = __builtin_convertvector(v, bf16x2_t); return __builtin_bit_cast(unsigned, b); }
__device__ __forceinline__ s16x4 vtr(lds_cptr p) { return __builtin_bit_cast(s16x4, __builtin_amdgcn_ds_read_tr16_b64_v4i16((__attribute__((address_space(3))) v4i16_t*)p)); }
#define ATT_WAIT_BAR(N) asm volatile("s_waitcnt vmcnt(" #N ") lgkmcnt(0)\n\ts_barrier" ::: "memory")
#define ATT_BAR() asm volatile("s_waitcnt lgkmcnt(0)\n\ts_barrier" ::: "memory")

__device__ __forceinline__ void pack_p(const f32x16& p0, const f32x16& p1, bf16x8 (&pa)[4]) {
    u32x4 w;
    w = (u32x4){cvtpk_s(p0[0], p0[1]), cvtpk_s(p0[2], p0[3]), cvtpk_s(p0[4], p0[5]), cvtpk_s(p0[6], p0[7])}; pa[0] = __builtin_bit_cast(bf16x8, w);
    w = (u32x4){cvtpk_s(p0[8], p0[9]), cvtpk_s(p0[10], p0[11]), cvtpk_s(p0[12], p0[13]), cvtpk_s(p0[14], p0[15])}; pa[1] = __builtin_bit_cast(bf16x8, w);
    w = (u32x4){cvtpk_s(p1[0], p1[1]), cvtpk_s(p1[2], p1[3]), cvtpk_s(p1[4], p1[5]), cvtpk_s(p1[6], p1[7])}; pa[2] = __builtin_bit_cast(bf16x8, w);
    w = (u32x4){cvtpk_s(p1[8], p1[9]), cvtpk_s(p1[10], p1[11]), cvtpk_s(p1[12], p1[13]), cvtpk_s(p1[14], p1[15])}; pa[3] = __builtin_bit_cast(bf16x8, w);
}
__device__ __forceinline__ void pv64(f32x16& o0, f32x16& o1, lds_cptr vp, const bf16x8 (&pa)[4]) {
#pragma unroll
    for (int ks = 0; ks < 4; ++ks) {
        const s16x4 a = vtr(vp + ks * 1024), b = vtr(vp + ks * 1024 + 512);
        const bf16x8 v = {a[0], a[1], a[2], a[3], b[0], b[1], b[2], b[3]};
        o0 = __builtin_amdgcn_mfma_f32_32x32x16_bf16(pa[ks], v, o0, 0, 0, 0);
    }
#pragma unroll
    for (int ks = 0; ks < 4; ++ks) {
        const s16x4 a = vtr(vp + 4096 + ks * 1024), b = vtr(vp + 4096 + ks * 1024 + 512);
        const bf16x8 v = {a[0], a[1], a[2], a[3], b[0], b[1], b[2], b[3]};
        o1 = __builtin_amdgcn_mfma_f32_32x32x16_bf16(pa[ks], v, o1, 0, 0, 0);
    }
}
__device__ __forceinline__ void pv32(f32x16& o0, f32x16& o1, lds_cptr vp, const bf16x8& pa0, const bf16x8& pa1) {
#pragma unroll
    for (int d0 = 0; d0 < 2; ++d0) {
        const s16x4 a = vtr(vp + d0 * 4096), b = vtr(vp + d0 * 4096 + 512), c = vtr(vp + d0 * 4096 + 1024), d = vtr(vp + d0 * 4096 + 1536);
        const bf16x8 v0 = {a[0], a[1], a[2], a[3], b[0], b[1], b[2], b[3]}, v1 = {c[0], c[1], c[2], c[3], d[0], d[1], d[2], d[3]};
        if (d0 == 0) { o0 = __builtin_amdgcn_mfma_f32_32x32x16_bf16(pa0, v0, o0, 0, 0, 0); o0 = __builtin_amdgcn_mfma_f32_32x32x16_bf16(pa1, v1, o0, 0, 0, 0); }
        else { o1 = __builtin_amdgcn_mfma_f32_32x32x16_bf16(pa0, v0, o1, 0, 0, 0); o1 = __builtin_amdgcn_mfma_f32_32x32x16_bf16(pa1, v1, o1, 0, 0, 0); }
    }
}
__device__ __forceinline__ float exp_sum1(f32x16& p) {
    float s0 = 0.f, s1 = 0.f;
#pragma unroll
    for (int r = 0; r < 16; r += 2) { p[r] = __builtin_amdgcn_exp2f(p[r]); p[r + 1] = __builtin_amdgcn_exp2f(p[r + 1]); s0 += p[r]; s1 += p[r + 1]; }
    return s0 + s1;
}
__device__ __forceinline__ void pack_p1(const f32x16& p, bf16x8& pa0, bf16x8& pa1) {
    u32x4 w;
    w = (u32x4){cvtpk_s(p[0], p[1]), cvtpk_s(p[2], p[3]), cvtpk_s(p[4], p[5]), cvtpk_s(p[6], p[7])}; pa0 = __builtin_bit_cast(bf16x8, w);
    w = (u32x4){cvtpk_s(p[8], p[9]), cvtpk_s(p[10], p[11]), cvtpk_s(p[12], p[13]), cvtpk_s(p[14], p[15])}; pa1 = __builtin_bit_cast(bf16x8, w);
}
__device__ __forceinline__ float exp_sum(f32x16& p0, f32x16& p1) {
    float s0 = 0.f, s1 = 0.f;
#pragma unroll
    for (int r = 0; r < 16; ++r) { p0[r] = __builtin_amdgcn_exp2f(p0[r]); p1[r] = __builtin_amdgcn_exp2f(p1[r]); s0 += p0[r]; s1 += p1[r]; }
    return s0 + s1;
}
__device__ __forceinline__ float half_swap_sum(float v) {
    return sum_x32(v);
}

constexpr int DN_RING = 40960, DN_BUF = 20480, DN_TAB = 81920, DN_WSF = 98304, DN_OST = 100352;
constexpr int ML_RING = 61440, ML_WSF = 122880, ML_OST = 124928;

__device__ __forceinline__ void store_o64(const f32x16& o0, const f32x16& o1, const float (&sc)[16], lds_ptr stg, bf16* orow0, int pitch, int lane) {
    asm volatile("" : "+v"(lane));
    const int r32 = lane & 31, hi = lane >> 5;
    __attribute__((address_space(3))) unsigned short* s = (__attribute__((address_space(3))) unsigned short*)stg;
#pragma unroll
    for (int r = 0; r < 16; ++r) { const int orow = crow(r, hi);
        s[orow * 64 + r32] = (unsigned short)f2bf(o0[r] * sc[r]); s[orow * 64 + 32 + r32] = (unsigned short)f2bf(o1[r] * sc[r]); }
    asm volatile("s_waitcnt lgkmcnt(0)" ::: "memory");
#pragma unroll
    for (int i = 0; i < 4; ++i) { const int row = i * 8 + (lane >> 3), ch = lane & 7;
        const u32x4 v = *(const __attribute__((address_space(3))) u32x4*)(stg + row * 128 + ch * 16); *(u32x4*)(orow0 + (size_t)row * pitch + ch * 8) = v; }
}

__device__ __forceinline__ void mla_unit(const unsigned char* ws, const int tid, int l, int u, char* shm) {
    const int lane = tid & 63, r32 = lane & 31, hi = lane >> 5, wid = __builtin_amdgcn_readfirstlane(tid >> 6), w4 = wid & 3, g = wid >> 2;
    PROBE_T0(pt5_);
    const int bh = u >> 4, q0 = (u & 15) * 128 + w4 * 32;
    const bf16* Qb = (const bf16*)(ws + WS_QC) + ((size_t)bh * SEQ + q0) * 96;
    const bf16* Kb = (const bf16*)(ws + WS_KC) + ((size_t)bh * SEQ + g * 1024) * 96;
    const bf16* Vb = (const bf16*)(ws + WS_VC) + ((size_t)bh * SEQ + g * 1024) * 64;
    const float nb2 = ((const float*)(ws + WS_TAB))[TAB_SC + l * 8 + 2];
    const unsigned lds0 = (unsigned)(uintptr_t)shm; const lds_cptr shm3 = (lds_cptr)shm;
    const unsigned ring = lds0 + g * ML_RING;
    int koffs[3];
#pragma unroll
    for (int i = 0; i < 3; ++i) { const int idx = 64 * (w4 + 4 * i) + lane, row = idx / 12, slot = idx - 12 * row; koffs[i] = row * 96 + ((slot & ~3) | ((slot & 3) ^ ((row >> 2) & 3))) * 8; }
    const bf16* vsrc = Vb + (size_t)(16 * w4 + (lane >> 2)) * 64 + (lane & 3) * 8;
#define MLA_DMA_K(t, buf) do { const unsigned d_ = (unsigned)__builtin_amdgcn_readfirstlane(ring + (buf) * DN_BUF + w4 * 1024); \
        const bf16* kt_ = Kb + (size_t)(t) * 64 * 96; glds16(kt_ + koffs[0], d_); glds16(kt_ + koffs[1], d_ + 4096); glds16(kt_ + koffs[2], d_ + 8192); } while (0)
#define MLA_DMA_V(t, buf) do { const unsigned d_ = (unsigned)__builtin_amdgcn_readfirstlane(ring + (buf) * DN_BUF + w4 * 1024); \
        glds16(vsrc + (size_t)(t) * 64 * 64, d_ + 12288); glds16(vsrc + (size_t)(t) * 64 * 64 + 32, d_ + 12288 + 4096); } while (0)
    MLA_DMA_K(0, 0); MLA_DMA_K(1, 1); MLA_DMA_V(0, 0);
    bf16x8 qr[6];
#pragma unroll
    for (int d0 = 0; d0 < 6; ++d0) qr[d0] = *(const bf16x8*)(Qb + (size_t)r32 * 96 + d0 * 16 + hi * 8);
    asm volatile("" : "+v"(qr[0]), "+v"(qr[1]), "+v"(qr[2]), "+v"(qr[3]), "+v"(qr[4]), "+v"(qr[5]));
    f32x16 o0 = {}, o1 = {}; float lsum = 0.f;
    const int kx = (r32 >> 2) & 3;
    const lds_cptr kpe0 = shm3 + g * ML_RING + r32 * 192 + ((hi ^ kx) << 4), kpe1 = shm3 + g * ML_RING + r32 * 192 + (((2 + hi) ^ kx) << 4);
    const lds_cptr vp0 = shm3 + g * ML_RING + 12288 + ((lane >> 4) & 1) * 32 + (lane & 3) * 8 + (4 * hi + ((lane & 15) >> 2)) * 64;
    f32x16 cb;
#pragma unroll
    for (int r = 0; r < 16; ++r) cb[r] = nb2;
    asm volatile("" : "+v"(cb));
#define MLA_QK(P0, P1, buf) do { \
        _Pragma("unroll") for (int d0 = 0; d0 < 6; ++d0) { const lds_cptr kp = ((d0 & 1) ? kpe1 : kpe0) + (buf) * DN_BUF + (d0 >> 1) * 64; \
            const bf16x8 a0 = *(const __attribute__((address_space(3))) bf16x8*)(kp), a1 = *(const __attribute__((address_space(3))) bf16x8*)(kp + 6144); \
            if (d0 == 0) { P0 = __builtin_amdgcn_mfma_f32_32x32x16_bf16(a0, qr[d0], cb, 0, 0, 0); P1 = __builtin_amdgcn_mfma_f32_32x32x16_bf16(a1, qr[d0], cb, 0, 0, 0); } \
            else { P0 = __builtin_amdgcn_mfma_f32_32x32x16_bf16(a0, qr[d0], P0, 0, 0, 0); P1 = __builtin_amdgcn_mfma_f32_32x32x16_bf16(a1, qr[d0], P1, 0, 0, 0); } } } while (0)
#define MLA_SMPV(P0, P1, buf) do { lsum += exp_sum(P0, P1); bf16x8 pa[4]; pack_p(P0, P1, pa); pv64(o0, o1, vp0 + (buf) * DN_BUF, pa); } while (0)
    {
        f32x16 p0, p1;
        ATT_WAIT_BAR(5);
        MLA_DMA_K(2, 2); MLA_DMA_V(1, 1);
        MLA_QK(p0, p1, 0);
        int bk = 1, bk2 = 0, bv = 0, bv1 = 2;
        for (int t = 1; t < 16; ++t) {
#if MK_PROBE == 10 || MK_PROBE == 11
            { PROBE_T0(pta_); asm volatile("s_waitcnt vmcnt(5) lgkmcnt(0)" ::: "memory"); PROBE_ADD(10, pta_, shm3); PROBE_T0(ptb_); asm volatile("s_barrier" ::: "memory"); PROBE_ADD(11, ptb_, shm3); }
#else
            { PROBE_T0(pt6_); ATT_WAIT_BAR(5); PROBE_ADD(6, pt6_, shm3); }
#endif
            { const int kn = t + 2 < 16 ? t + 2 : 15, vn = t + 1 < 16 ? t + 1 : 15; MLA_DMA_K(kn, bk2); MLA_DMA_V(vn, bv1); }
            MLA_SMPV(p0, p1, bv);
            MLA_QK(p0, p1, bk);
            bk = bk == 2 ? 0 : bk + 1; bk2 = bk2 == 2 ? 0 : bk2 + 1; bv = bv == 2 ? 0 : bv + 1; bv1 = bv1 == 2 ? 0 : bv1 + 1;
        }
        ATT_WAIT_BAR(0);
        MLA_SMPV(p0, p1, bv);
    }
    ATT_WAIT_BAR(0);
    PROBE_T0(pt7_);
#undef MLA_QK
#undef MLA_SMPV
#undef MLA_DMA_K
#undef MLA_DMA_V
#define MLA_DMA(t, buf) do {} while (0)
#undef MLA_DMA
    int lane_t = lane; asm volatile("" : "+v"(lane_t));
    const int r32t = lane_t & 31, hit = lane_t >> 5;
    __attribute__((address_space(3))) float* Cs = (__attribute__((address_space(3))) float*)shm3;
    if (g == 1) {
#pragma unroll
        for (int r = 0; r < 16; ++r) { Cs[(w4 * 33 + r) * 64 + lane_t] = o0[r]; Cs[(w4 * 33 + 16 + r) * 64 + lane_t] = o1[r]; }
        Cs[(w4 * 33 + 32) * 64 + lane_t] = lsum;
    }
    ATT_BAR();
    if (g == 0) {
#pragma unroll
        for (int r = 0; r < 16; ++r) { o0[r] += Cs[(w4 * 33 + r) * 64 + lane_t]; o1[r] += Cs[(w4 * 33 + 16 + r) * 64 + lane_t]; }
        lsum += Cs[(w4 * 33 + 32) * 64 + lane_t];
        lsum = half_swap_sum(lsum);
        __attribute__((address_space(3))) float* wsf = (__attribute__((address_space(3))) float*)(shm3 + ML_WSF) + wid * 64;
        if (hit == 0) wsf[r32t] = __builtin_amdgcn_rcpf(lsum);
        asm volatile("s_waitcnt lgkmcnt(0)" ::: "memory");
        float sc[16];
#pragma unroll
        for (int r = 0; r < 16; ++r) sc[r] = wsf[crow(r, hit)];
        const int b = bh / 6, h = bh - b * 6;
        store_o64(o0, o1, sc, (lds_ptr)(shm3 + ML_OST + w4 * 4096), (bf16*)(ws + WS_MIX) + ((size_t)(b * SEQ + q0)) * DM + 640 + h * 64, DM, lane_t);
    }
    ATT_BAR();
    PROBE_ADD(7, pt7_, shm3); PROBE_ADD(5, pt5_, shm3);
}

__device__ __forceinline__ void diff_unit(const unsigned char* ws, const float* sub, const int tid, int l, int u, char* shm) {
    const int lane = tid & 63, r32 = lane & 31, hi = lane >> 5, wid = __builtin_amdgcn_readfirstlane(tid >> 6), w4 = wid & 3, g = wid >> 2;
    PROBE_T0(pt8_);
    const int bh = u >> 4, q0 = (u & 15) * 128 + w4 * 32, b = bh >> 2, h = bh & 3;
    const bf16* Q0 = (const bf16*)(ws + WS_QD) + ((size_t)(bh * 2) * SEQ + q0) * 32;
    const bf16* K0 = (const bf16*)(ws + WS_KD) + ((size_t)(bh * 2) * SEQ + g * 1024) * 32;
    const bf16* Vb = (const bf16*)(ws + WS_VD) + ((size_t)bh * SEQ + g * 1024) * 64;
    const float* tabg = (const float*)(ws + WS_TAB) + TAB_BD + (l * 4 + h) * 4096;
    const unsigned lds0 = (unsigned)(uintptr_t)shm; const lds_cptr shm3 = (lds_cptr)shm;
    const unsigned ring = lds0 + g * DN_RING;
    const bf16* ksrc = K0 + (size_t)(16 * w4 + (lane >> 2)) * 32 + (((lane & 3) ^ ((lane >> 4) & 3)) * 8);
    const bf16* vsrc = Vb + (size_t)(16 * w4 + (lane >> 2)) * 64 + (lane & 3) * 8;
#define DIFF_KOFF(t) (((t) & 1) * 8192)
#define DIFF_VOFF(t) (16384 + ((t) % 3) * 8192)
#define DIFF_DMA_K(t) do { const unsigned d_ = (unsigned)__builtin_amdgcn_readfirstlane(ring + DIFF_KOFF(t) + w4 * 1024); \
        glds16(ksrc + (size_t)(t) * 64 * 32, d_); glds16(ksrc + (size_t)SEQ * 32 + (size_t)(t) * 64 * 32, d_ + 4096); } while (0)
#define DIFF_DMA_V(t) do { const unsigned d_ = (unsigned)__builtin_amdgcn_readfirstlane(ring + DIFF_VOFF(t) + w4 * 1024); \
        glds16(vsrc + (size_t)(t) * 64 * 64, d_); glds16(vsrc + (size_t)(t) * 64 * 64 + 32, d_ + 4096); } while (0)
    DIFF_DMA_K(0); DIFF_DMA_V(0);
    { __attribute__((address_space(3))) float* tl = (__attribute__((address_space(3))) float*)(shm3 + DN_TAB);
#pragma unroll
      for (int i = 0; i < 2; ++i) { const f32x4 v = *(const f32x4*)(tabg + (i * 512 + tid) * 4); *(__attribute__((address_space(3))) f32x4*)(tl + (i * 512 + tid) * 4) = v; } }
    bf16x8 qr[2][2];
#pragma unroll
    for (int c = 0; c < 2; ++c)
#pragma unroll
        for (int d0 = 0; d0 < 2; ++d0) qr[c][d0] = *(const bf16x8*)(Q0 + (size_t)c * SEQ * 32 + (size_t)r32 * 32 + d0 * 16 + hi * 8);
    asm volatile("" : "+v"(qr[0][0]), "+v"(qr[0][1]), "+v"(qr[1][0]), "+v"(qr[1][1]));
    f32x16 oa0 = {}, oa1 = {}, ob0 = {}, ob1 = {}; float lsa = 0.f, lsb = 0.f;
    const int kx = (r32 >> 2) & 3;
    const lds_cptr kpe0 = shm3 + g * DN_RING + r32 * 64 + ((hi ^ kx) << 4), kpe1 = shm3 + g * DN_RING + r32 * 64 + (((2 + hi) ^ kx) << 4);
    const lds_cptr vp0 = shm3 + g * DN_RING + ((lane >> 4) & 1) * 32 + (lane & 3) * 8 + (4 * hi + ((lane & 15) >> 2)) * 64;
    const __attribute__((address_space(3))) float* tb0 = (const __attribute__((address_space(3))) float*)(shm3 + DN_TAB) + (2048 + g * 1024 - q0 + 4 * hi - r32);
#define DIFF_QK(S0, S1, t, blk) do { const __attribute__((address_space(3))) float* tb = tb0 + (t) * 64 + (blk) * 32; int koff_ = __builtin_amdgcn_readfirstlane(DIFF_KOFF(t) + (blk) * 2048); asm volatile("" : "+s"(koff_)); \
        _Pragma("unroll") for (int r = 0; r < 16; ++r) { S0[r] = tb[(r & 3) + 8 * (r >> 2)]; S1[r] = S0[r]; } \
        _Pragma("unroll") for (int d0 = 0; d0 < 2; ++d0) { \
            const lds_cptr kp = (d0 ? kpe1 : kpe0) + koff_; const bf16x8 a0 = *(const __attribute__((address_space(3))) bf16x8*)(kp), a1 = *(const __attribute__((address_space(3))) bf16x8*)(kp + 4096); \
            S0 = __builtin_amdgcn_mfma_f32_32x32x16_bf16(a0, qr[0][d0], S0, 0, 0, 0); S1 = __builtin_amdgcn_mfma_f32_32x32x16_bf16(a1, qr[1][d0], S1, 0, 0, 0); } __builtin_amdgcn_sched_barrier(0); } while (0)
#define DIFF_SMPV(S0, S1, t, blk) do { int voff_ = __builtin_amdgcn_readfirstlane(DIFF_VOFF(t) + (blk) * 2048); asm volatile("" : "+s"(voff_)); const lds_cptr vpb = vp0 + voff_; bf16x8 pa0, pa1; \
        lsa += exp_sum1(S0); pack_p1(S0, pa0, pa1); pv32(oa0, oa1, vpb, pa0, pa1); \
        __builtin_amdgcn_sched_barrier(0); lsb += exp_sum1(S1); pack_p1(S1, pa0, pa1); pv32(ob0, ob1, vpb, pa0, pa1); __builtin_amdgcn_sched_barrier(0); } while (0)
    {
        f32x16 s0, s1, u0, u1;
        ATT_WAIT_BAR(0);
        DIFF_DMA_K(1); DIFF_DMA_V(1);
        DIFF_QK(s0, s1, 0, 0); DIFF_SMPV(s0, s1, 0, 0); DIFF_QK(u0, u1, 0, 1);
        for (int t = 1; t < 16; ++t) {
            { PROBE_T0(pt9_); ATT_WAIT_BAR(0); PROBE_ADD(9, pt9_, shm3); }
            if (t + 1 < 16) { DIFF_DMA_K(t + 1); DIFF_DMA_V(t + 1); }
            DIFF_SMPV(u0, u1, t - 1, 1); DIFF_QK(s0, s1, t, 0);
            DIFF_SMPV(s0, s1, t, 0); DIFF_QK(u0, u1, t, 1);
        }
        ATT_WAIT_BAR(0);
        DIFF_SMPV(u0, u1, 15, 1);
    }
    ATT_WAIT_BAR(0);
#undef DIFF_QK
#undef DIFF_SMPV
#undef DIFF_DMA_K
#undef DIFF_DMA_V
#undef DIFF_KOFF
#undef DIFF_VOFF
#define DIFF_DMA(t, buf) do {} while (0)
#undef DIFF_DMA
    int lane_t = lane; asm volatile("" : "+v"(lane_t));
    const int r32t = lane_t & 31, hit = lane_t >> 5;
    __attribute__((address_space(3))) float* Cs = (__attribute__((address_space(3))) float*)shm3 + w4 * 66 * 64;
    if (g == 1) {
#pragma unroll
        for (int r = 0; r < 16; ++r) { Cs[r * 64 + lane_t] = oa0[r]; Cs[(16 + r) * 64 + lane_t] = oa1[r]; Cs[(32 + r) * 64 + lane_t] = ob0[r]; Cs[(48 + r) * 64 + lane_t] = ob1[r]; }
        Cs[64 * 64 + lane_t] = lsa; Cs[65 * 64 + lane_t] = lsb;
    }
    ATT_BAR();
    if (g == 0) {
#pragma unroll
        for (int r = 0; r < 16; ++r) { oa0[r] += Cs[r * 64 + lane_t]; oa1[r] += Cs[(16 + r) * 64 + lane_t]; ob0[r] += Cs[(32 + r) * 64 + lane_t]; ob1[r] += Cs[(48 + r) * 64 + lane_t]; }
        lsa += Cs[64 * 64 + lane_t]; lsb += Cs[65 * 64 + lane_t];
        lsa = half_swap_sum(lsa); lsb = half_swap_sum(lsb);
        const float* sc = (const float*)(ws + WS_TAB) + TAB_SC + l * 8; const float lam = sc[0], post = sc[1];
        __attribute__((address_space(3))) float* wsf = (__attribute__((address_space(3))) float*)(shm3 + DN_WSF) + wid * 64;
        if (hit == 0) { wsf[r32t] = __builtin_amdgcn_rcpf(lsa); wsf[32 + r32t] = lam * __builtin_amdgcn_rcpf(lsb); }
        asm volatile("s_waitcnt lgkmcnt(0)" ::: "memory");
        __attribute__((address_space(3))) float* As = Cs;
#pragma unroll
        for (int r = 0; r < 16; ++r) { const int q = crow(r, hit); const float s0 = wsf[q], s1 = wsf[32 + q];
            As[q * 65 + r32t] = oa0[r] * s0 - ob0[r] * s1; As[q * 65 + 32 + r32t] = oa1[r] * s0 - ob1[r] * s1; }
        asm volatile("s_waitcnt lgkmcnt(0)" ::: "memory");
        const int row = lane_t >> 1, hf = lane_t & 1;
        float v[32]; float ss = 0.f;
#pragma unroll
        for (int i = 0; i < 32; ++i) { v[i] = As[row * 65 + hf * 32 + i]; ss += v[i] * v[i]; }
        ss += swz<1>(ss);
        const float rn = __builtin_amdgcn_rsqf(ss * (1.0f / 64.0f) + EPS) * post;
        bf16* dst = (bf16*)(ws + WS_MIX) + ((size_t)(b * SEQ + q0 + row)) * DM + h * 64 + hf * 32;
#pragma unroll
        for (int i = 0; i < 4; ++i) { u32x4 w;
            w.x = cvtpk_s(v[8 * i] * rn * sub[hf * 32 + 8 * i], v[8 * i + 1] * rn * sub[hf * 32 + 8 * i + 1]); w.y = cvtpk_s(v[8 * i + 2] * rn * sub[hf * 32 + 8 * i + 2], v[8 * i + 3] * rn * sub[hf * 32 + 8 * i + 3]);
            w.z = cvtpk_s(v[8 * i + 4] * rn * sub[hf * 32 + 8 * i + 4], v[8 * i + 5] * rn * sub[hf * 32 + 8 * i + 5]); w.w = cvtpk_s(v[8 * i + 6] * rn * sub[hf * 32 + 8 * i + 6], v[8 * i + 7] * rn * sub[hf * 32 + 8 * i + 7]);
            *(u32x4*)(dst + 8 * i) = w; }
    }
    ATT_BAR();
    PROBE_ADD(8, pt8_, shm3);
}

__device__ __forceinline__ void dil_prefetch(const unsigned char* ws, const int tid, int bh, int br, int chunk, unsigned lds_dummy) {
    const int wid = __builtin_amdgcn_readfirstlane(tid >> 6);
    if (wid < 6) {
        const int s = wid, within = tid & 63, dsh = 2 * br, L = SEQ >> dsh;
        int res, k0;
        if (br == 2) { res = 2 * chunk + ((s >> 1) & 1); k0 = 64 * (s & 1); }
        else { res = br == 1 ? (chunk >> 1) : 0; k0 = (br == 1 ? 256 * (chunk & 1) : 256 * chunk) - 64 + 64 * s; }
        int ki = k0 + within; ki = ki < 0 ? 0 : (ki > L - 1 ? L - 1 : ki);
        const size_t off = ((size_t)bh * SEQ + res + ((size_t)ki << dsh)) * 64;
        const unsigned d_ = (unsigned)__builtin_amdgcn_readfirstlane(lds_dummy + wid * 1024);
        glds16((const bf16*)(ws + WS_KL) + off, d_); glds16((const bf16*)(ws + WS_VL) + off, d_);
    }
}

constexpr int DL_SLOT = 16384, DL_TAB = 98304, DL_WSF = 114688;
template <int DIL> __device__ __forceinline__ void dil_unit(const unsigned char* ws, unsigned char* wsw, const int tid, int l, int bh, int chunk, int nud, char* shm) {
    constexpr int L = SEQ / DIL, BR = DIL == 1 ? 0 : (DIL == 4 ? 1 : 2), NSLOT = DIL == 16 ? 4 : 6, NTW = DIL == 16 ? 2 : 3;
    const int lane = tid & 63, r32 = lane & 31, hi = lane >> 5, wid = __builtin_amdgcn_readfirstlane(tid >> 6);
    const int h = bh % 6, b = bh / 6;
    const bf16* Qb = (const bf16*)(ws + WS_QL) + (size_t)bh * SEQ * 64; const bf16* Kb = (const bf16*)(ws + WS_KL) + (size_t)bh * SEQ * 64; const bf16* Vb = (const bf16*)(ws + WS_VL) + (size_t)bh * SEQ * 64;
    const float* tabg = (const float*)(ws + WS_TAB) + TAB_BL + (l * 6 + h) * 4096;
    const unsigned lds0 = (unsigned)(uintptr_t)shm; const lds_cptr shm3 = (lds_cptr)shm;
    PROBE_T0(pt4_);
    int res_w, qidx0, tf;
    if (DIL == 16) { res_w = 2 * chunk + (wid >> 2); qidx0 = 32 * (wid & 3); tf = 2 * (wid >> 2); }
    else if (DIL == 4) { res_w = chunk >> 1; qidx0 = 256 * (chunk & 1) + 32 * wid; tf = wid >> 1; }
    else { res_w = 0; qidx0 = 256 * chunk + 32 * wid; tf = wid >> 1; }
    const int t0idx = DIL == 16 ? 0 : (DIL == 4 ? 256 * (chunk & 1) - 64 : 256 * chunk - 64);
#pragma unroll
    for (int s = 0; s < NSLOT; ++s) {
        const int res_s = DIL == 16 ? 2 * chunk + (s >> 1) : res_w, k0 = DIL == 16 ? 64 * (s & 1) : t0idx + 64 * s;
        int ki = k0 + 8 * wid + (lane >> 3); ki = ki < 0 ? 0 : (ki > L - 1 ? L - 1 : ki);
        int vi = k0 + 16 * (wid & 3) + (lane >> 2); vi = vi < 0 ? 0 : (vi > L - 1 ? L - 1 : vi);
        const unsigned d_ = (unsigned)__builtin_amdgcn_readfirstlane(lds0 + s * DL_SLOT + wid * 1024);
        glds16(Kb + (size_t)(res_s + DIL * ki) * 64 + (((lane & 7) ^ (((8 * wid + (lane >> 3)) >> 1) & 7)) * 8), d_);
        glds16(Vb + (size_t)(res_s + DIL * vi) * 64 + (wid >> 2) * 32 + (lane & 3) * 8, d_ + 8192);
    }
    if (tid < 256) ((__attribute__((address_space(3))) float*)(shm3 + DL_TAB))[tid] = (tid >= 64 && tid <= 192) ? tabg[2048 + DIL * (tid - 128)] : -1.0e30f;
    bf16x8 qr[4];
#pragma unroll
    for (int d0 = 0; d0 < 4; ++d0) qr[d0] = *(const bf16x8*)(Qb + (size_t)(res_w + DIL * (qidx0 + r32)) * 64 + d0 * 16 + hi * 8);
    PROBE_T0(pt1_); ATT_WAIT_BAR(0); PROBE_ADD(1, pt1_, shm3);
    PROBE_T0(pt2_);
    f32x16 o0 = {}, o1 = {}; float lsum = 0.f;
    const int qidx = qidx0 + r32;
#pragma unroll
    for (int tt = 0; tt < NTW; ++tt) {
        const int slot = tf + tt;
        const int k0 = DIL == 16 ? 64 * tt : t0idx + 64 * slot;
        if (k0 < 0 || k0 >= L) continue;
        const lds_cptr kp = shm3 + slot * DL_SLOT + r32 * 128;
        const lds_cptr vp = shm3 + slot * DL_SLOT + 8192 + ((lane >> 4) & 1) * 32 + (lane & 3) * 8 + (4 * hi + ((lane & 15) >> 2)) * 64;
        const int dbase = k0 + 4 * hi - qidx;
        int ti = 128 + dbase; ti = ti < 0 ? 0 : (ti > 255 - 59 ? 255 - 59 : ti);
        const __attribute__((address_space(3))) float* tb = (const __attribute__((address_space(3))) float*)(shm3 + DL_TAB) + ti;
        f32x16 p0, p1;
#pragma unroll
        for (int r = 0; r < 16; ++r) { p0[r] = tb[(r & 3) + 8 * (r >> 2)]; p1[r] = tb[32 + (r & 3) + 8 * (r >> 2)]; }
#pragma unroll
        for (int d0 = 0; d0 < 4; ++d0) {
            const int e_ = ((2 * d0 + hi) ^ ((r32 >> 1) & 7)) << 4;
            const bf16x8 a0 = *(const __attribute__((address_space(3))) bf16x8*)(kp + e_), a1 = *(const __attribute__((address_space(3))) bf16x8*)(kp + e_ + 4096);
            p0 = __builtin_amdgcn_mfma_f32_32x32x16_bf16(a0, qr[d0], p0, 0, 0, 0); p1 = __builtin_amdgcn_mfma_f32_32x32x16_bf16(a1, qr[d0], p1, 0, 0, 0);
        }
        const float s0 = exp_sum(p0, p1);
        lsum += s0;
        bf16x8 pa[4]; pack_p(p0, p1, pa);
        pv64(o0, o1, vp, pa);
    }
    ATT_BAR();
    PROBE_ADD(2, pt2_, shm3);
    PROBE_T0(pt3_);
    lsum = half_swap_sum(lsum);
    int lane_t = lane; asm volatile("" : "+v"(lane_t));
    const int r32t = lane_t & 31, hit = lane_t >> 5;
    __attribute__((address_space(3))) float* wsf = (__attribute__((address_space(3))) float*)(shm3 + DL_WSF) + wid * 64;
    if (hit == 0) wsf[r32t] = __builtin_amdgcn_rcpf(lsum);
    asm volatile("s_waitcnt lgkmcnt(0)" ::: "memory");
    float sc[16];
#pragma unroll
    for (int r = 0; r < 16; ++r) sc[r] = wsf[crow(r, hit)];
    bf16* DO = (bf16*)(wsw + (BR == 0 ? WS_DO0 : (BR == 1 ? WS_DO1 : WS_DO2)));
    float* DLs = (float*)(wsw + WS_DL) + (size_t)BR * MTOK * 8;
    const size_t row0 = (size_t)b * SEQ + res_w + (size_t)DIL * qidx0;
    store_o64(o0, o1, sc, (lds_ptr)(shm3 + wid * 4096), DO + row0 * 384 + h * 64, 384 * DIL, lane_t);
    if (hit == 0) DLs[(row0 + (size_t)DIL * r32t) * 8 + h] = lsum;
    ATT_BAR();
    PROBE_ADD(3, pt3_, shm3); PROBE_ADD(4, pt4_, shm3);
}

__device__ __forceinline__ void dil_merge(unsigned char* wsm, const unsigned char* wsw, const int tid, int gw, int NGW) {
    const int lane = tid & 63;
    const bf16* D0 = (const bf16*)(wsw + WS_DO0); const bf16* D1 = (const bf16*)(wsw + WS_DO1); const bf16* D2 = (const bf16*)(wsw + WS_DO2);
    const float* DLs = (const float*)(wsw + WS_DL);
    bf16* mix = (bf16*)(wsm + WS_MIX);
    for (int m0 = gw; m0 < MTOK; m0 += 8 * NGW) {
        if (lane < 48) {
            const int h = lane >> 3;
            v4u a[8], bq[8], c[8]; float l0[8], l1[8], l2[8];
#pragma unroll
            for (int k = 0; k < 8; ++k) { int m = m0 + k * NGW; m = m < MTOK ? m : MTOK - 1;
                a[k] = *(const v4u*)(D0 + (size_t)m * 384 + lane * 8); bq[k] = *(const v4u*)(D1 + (size_t)m * 384 + lane * 8); c[k] = *(const v4u*)(D2 + (size_t)m * 384 + lane * 8);
                l0[k] = DLs[(size_t)m * 8 + h]; l1[k] = DLs[((size_t)MTOK + m) * 8 + h]; l2[k] = DLs[((size_t)2 * MTOK + m) * 8 + h]; }
#pragma unroll
            for (int k = 0; k < 8; ++k) { const int m = m0 + k * NGW;
                const float inv = 1.0f / (l0[k] + l1[k] + l2[k]), w0 = l0[k] * inv, w1 = l1[k] * inv, w2 = l2[k] * inv;
                float x[8], y[8], z[8]; unpack8(a[k], x); unpack8(bq[k], y); unpack8(c[k], z);
                v4u o; o.x = pk2(w0 * x[0] + w1 * y[0] + w2 * z[0], w0 * x[1] + w1 * y[1] + w2 * z[1]); o.y = pk2(w0 * x[2] + w1 * y[2] + w2 * z[2], w0 * x[3] + w1 * y[3] + w2 * z[3]);
                o.z = pk2(w0 * x[4] + w1 * y[4] + w2 * z[4], w0 * x[5] + w1 * y[5] + w2 * z[5]); o.w = pk2(w0 * x[6] + w1 * y[6] + w2 * z[6], w0 * x[7] + w1 * y[7] + w2 * z[7]);
                if (m < MTOK) *(v4u*)(mix + (size_t)m * DM + 256 + lane * 8) = o; }
        }
    }
}
}

#ifndef MK_PROBE_L
#define MK_PROBE_L -1
#endif
#ifndef MK_PH
#define MK_PH 255
#endif
#ifndef MK_CONV_EARLY
#define MK_CONV_EARLY 1
#endif
#ifndef MK_DUP
#define MK_DUP 0
#endif
#define REP(kind) for (int rep_ = 0; rep_ < (((MK_DUP >> (kind)) & 1) ? 2 : 1); ++rep_)
#ifndef MK_ATTN_V1
#define MK_ATTN_V1 0
#endif
#ifndef MK_SP2
#define MK_SP2 true
#endif
constexpr int NPHASE = 18;
template <int MODE>
__global__ void __launch_bounds__(512, 2) enc_fwd(Args args) {
    extern __shared__ __attribute__((aligned(16))) unsigned char lds[];
    LAS unsigned char* L = (LAS unsigned char*)lds;
    volatile LAS unsigned* MISC = (volatile LAS unsigned*)(L + MISC_OFF);
    LAS float* xs = (LAS float*)(L + XS_OFF);
    PROBE_T0(ptall_);
    const int G = gridDim.x, bx = blockIdx.x;
    const int wave0 = __builtin_amdgcn_readfirstlane(threadIdx.x >> 6);
    const int vcu = (G % 8 == 0) ? (bx % 8) * (G / 8) + bx / 8 : bx;
    for (int u = threadIdx.x; u < (LDS_BYTES - MISC_OFF) / 4; u += 512) ((LAS unsigned*)(L + MISC_OFF))[u] = 0u;
    __syncthreads();
    { volatile LAS unsigned long long* PT = (volatile LAS unsigned long long*)(L + MISC_OFF + 128);
      if (threadIdx.x == 0) {
#pragma unroll
          for (int i = 0; i < 25; ++i) PT[i] = (unsigned long long)args.in[i];
          PT[25] = (unsigned long long)args.out; } }
    __syncthreads();
    if (MODE < 0) xcd_barrier_post((unsigned*)(args.ws + WS_CTL) + CW_BAR, MISC + 8, threadIdx.x == 0);
#define IN(k) (MODE < 0 || MODE == (k))
#define SEAM(k) do { if (MODE < 0) { PROBE_T0(pts_); int lid_; asm volatile("v_mbcnt_lo_u32_b32 %0, -1, 0\n\tv_mbcnt_hi_u32_b32 %0, -1, %0" : "=v"(lid_)); xcd_barrier((unsigned*)(args.ws + WS_CTL) + CW_BAR, MISC + 8, wave0 == 0 && lid_ == 0); if ((k) != 99) PROBE_ADD(30, pts_, L); } } while (0)
#define INP(i) ((const float*)lds_ptr_get((volatile LAS unsigned long long*)(L + MISC_OFF + 128), (i)))
#define PHASE_ENV() int tidp; asm volatile("v_mbcnt_lo_u32_b32 %0, -1, 0\n\tv_mbcnt_hi_u32_b32 %0, -1, %0" : "=v"(tidp)); tidp |= wave0 << 6; asm volatile("" : "+v"(tidp)); int bxp = bx, Gp = G, vcup = vcu; asm volatile("" : "+s"(bxp), "+s"(Gp), "+s"(vcup)); (void)vcup; unsigned char* ws; { const unsigned long long w_ = (unsigned long long)args.ws; unsigned wl_ = (unsigned)w_, wh_ = (unsigned)(w_ >> 32); \
          asm volatile("" : "+s"(wl_), "+s"(wh_)); ws = (unsigned char*)(((unsigned long long)wh_ << 32) | wl_); } \
        const int lane = tidp & 63, wave = __builtin_amdgcn_readfirstlane(tidp >> 6), gw = vcup * 8 + wave, gtid = bxp * 512 + tidp; const int NGW = Gp * 8, NGT = Gp * 512; (void)NGW; (void)NGT; (void)lane; (void)gw; (void)gtid; \
        bf16* XB = (bf16*)(ws + WS_XB); bf16* HB = (bf16*)(ws + WS_H); float* P0 = (float*)(ws + WS_P); float* P1 = P0 + (size_t)MTOK * 16; float* P2 = P1 + (size_t)MTOK * 16; \
        const float* tab = (const float*)(ws + WS_TAB); (void)XB; (void)HB; (void)P0; (void)P1; (void)P2; (void)tab;

    PROBE_T0(ptp_);
    REP(0) if (IN(0) && (MK_PH & 1)) { PHASE_ENV();
        prologue_misc((volatile LAS unsigned long long*)(L + MISC_OFF + 128), ws, gw, NGW, lane, gtid, NGT);
        convert_weights((volatile LAS unsigned long long*)(L + MISC_OFF + 128), ws, 0, MK_CONV_EARLY ? 1 : 255, gw, NGW, lane);
    }
    SEAM(0);
    PROBE_ADD(47, ptp_, L);
#if MK_PROBE == 31
    { PROBE_T0(ptx_); int lidq_; asm volatile("v_mbcnt_lo_u32_b32 %0, -1, 0\n\tv_mbcnt_hi_u32_b32 %0, -1, %0" : "=v"(lidq_));
      for (int rr = 0; rr < 4; ++rr) xcd_barrier((unsigned*)(args.ws + WS_CTL) + CW_BAR, MISC + 8, wave0 == 0 && lidq_ == 0);
      PROBE_ADD(31, ptx_, L); }
#endif
    for (int l = (MODE < 0 ? 0 : args.layer); l < (MODE < 0 ? DEPTH : args.layer + 1); ++l) {
        constexpr int p0 = 1;
        PROBE_T0(ptw0_);
        REP(1) if (IN(p0 + 0) && (MK_PH & 4)) { PHASE_ENV();
            pg8::Gemm g{XB, (const bf16*)(ws + W_GU1), MTOK, 2 * DFF, DM, DM, DM}; pg8::StaticOrder S; S.init(MTOK, 2 * DFF, Gp, bxp);
            pg8::EpiSwiGLU E{HB, P0};
            PROBE_T0(ptg_);
            pg8::gemm_phase<pg8::EpiSwiGLU, pg8::StaticOrder, true, MK_SP2>(tidp, L, xs, g, S, E);
            PROBE_ADD(32, ptg_, L);
            if (MK_CONV_EARLY && bxp >= Gp / 2) convert_weights((volatile LAS unsigned long long*)(L + MISC_OFF + 128), ws, l, 244, (bxp - Gp / 2) * 8 + wave, (Gp - Gp / 2) * 8, lane);
        }
        SEAM(p0 + 0);
        if (MK_PROBE_L < 0 || l == MK_PROBE_L) PROBE_ADD(40, ptw0_, L); PROBE_T0(ptw1_);
        REP(2) if (IN(p0 + 1) && (MK_PH & 8)) { PHASE_ENV();
            pg8::Gemm g{HB, (const bf16*)(ws + W_D1), MTOK, DM, DFF, DFF, DFF}; pg8::StaticOrder S; S.init(MTOK, DM, Gp, bxp);
            pg8::EpiResidB E{XB, nullptr, P1, (((MK_DUP >> 2) & 1) && rep_ == 0) ? 0.0f : 0.5f};
            PROBE_T0(ptd_);
            pg8::gemm_phase<pg8::EpiResidB, pg8::StaticOrder, true, MK_SP2>(tidp, L, xs, g, S, E);
            PROBE_ADD(33, ptd_, L);
        }
        SEAM(p0 + 1);
        PROBE_ADD(41, ptw1_, L); PROBE_T0(ptw2_);
        REP(3) if (IN(p0 + 2) && (MK_PH & 16)) { PHASE_ENV();
            pg8::Gemm g{XB, (const bf16*)(ws + W_IN), MTOK, NIN, DM, DM, DM}; pg8::StaticOrder S; S.init(MTOK, NIN, Gp, bxp);
            pg8::EpiInProj E{P1, (bf16*)(ws + WS_QD), (bf16*)(ws + WS_KD), (bf16*)(ws + WS_VD), (bf16*)(ws + WS_QL), (bf16*)(ws + WS_KL), (bf16*)(ws + WS_VL), (bf16*)(ws + WS_AQ),
                             (float*)(ws + WS_KR), (float*)(ws + WS_KRSS), INP(I_DQN) + l * 32, INP(I_DKN) + l * 32, INP(I_LQN) + l * 64, INP(I_LKN) + l * 64,
                             0.17677669529663687f * LOG2E, 0.125f * LOG2E, 0};
            pg8::gemm_phase<pg8::EpiInProj, pg8::StaticOrder, true, MK_SP2>(tidp, L, xs, g, S, E);
            if (MK_CONV_EARLY && bxp >= Gp / 2) convert_weights((volatile LAS unsigned long long*)(L + MISC_OFF + 128), ws, l, 10, (bxp - Gp / 2) * 8 + wave, (Gp - Gp / 2) * 8, lane);
        }
        SEAM(p0 + 2);
        PROBE_ADD(42, ptw2_, L); PROBE_T0(ptw3_);
        REP(10) if (IN(p0 + 3) && (MK_PH & 32)) { PHASE_ENV();
            int Kq = 256; asm volatile("" : "+s"(Kq));
            pg8::Gemm g{(const bf16*)(ws + WS_AQ), (const bf16*)(ws + W_QU), MTOK, 1536, Kq, 384, 256, 3, 256}; pg8::StaticOrder S; S.init(MTOK, 1536, Gp, bxp);
            pg8::EpiMlaQKV E{ pg8::EpiMlaQ{(bf16*)(ws + WS_QC), INP(I_MQNG) + l * 96, tab + TAB_COS, tab + TAB_SIN, 0.10206207261596575f * LOG2E},
                              pg8::EpiMlaKV{(bf16*)(ws + WS_KC), (bf16*)(ws + WS_VC), INP(I_MKNG) + l * 96, (const float*)(ws + WS_KR), (const float*)(ws + WS_KRSS), tab + TAB_COS, tab + TAB_SIN} };
            PROBE_T0(ptm_);
            pg8::gemm_phase<pg8::EpiMlaQKV, pg8::StaticOrder, true, MK_SP2>(tidp, L, xs, g, S, E);
            PROBE_ADD(51, ptm_, L);
        }
#if !MK_ATTN_V1
        REP(12) if (IN(p0 + 3) && (MK_PH & 32)) { PHASE_ENV();
            const int kx_ = bxp >> 3, xc_ = bxp & 7, rnk = (kx_ >= 16) ? xc_ * 16 + (kx_ - 16) : 128 + xc_ * 16 + kx_;
            PROBE_T0(ptdl_);
            for (int ud = rnk; ud < 1152; ud += Gp) {
                const int bh = ud / 24, rem = ud - bh * 24, br = rem >> 3, chunk = rem & 7;
                if (br == 0) att::dil_unit<1>(ws, (unsigned char*)INP(25), tidp, l, bh, chunk, ud + Gp, (char*)lds);
                else if (br == 1) att::dil_unit<4>(ws, (unsigned char*)INP(25), tidp, l, bh, chunk, ud + Gp, (char*)lds);
                else att::dil_unit<16>(ws, (unsigned char*)INP(25), tidp, l, bh, chunk, ud + Gp, (char*)lds);
            }
            PROBE_ADD(52, ptdl_, L);
        }
#endif
        SEAM(p0 + 3);
        PROBE_ADD(43, ptw3_, L); PROBE_T0(ptw4_);
#if MK_ATTN_V1
        REP(5) if (IN(p0 + 4) && (MK_PH & 64)) { PHASE_ENV();
            for (int u = bxp; u < 640; u += Gp) {
                if (u < 192) mla_unit_v1(ws, tidp, l, u, (LAS float*)L);
                else if (u < 448) diff_unit_v1(ws, INP(I_DSUB) + l * 64, tidp, l, u - 192, (LAS float*)L);
                else dil_unit_v1(ws, tidp, l, u - 448);
            }
        }
#else
        REP(13) if (IN(p0 + 4) && (MK_PH & 64)) { PHASE_ENV();
            PROBE_T0(ptdf_);
            for (int u = vcup; u < 512; u += Gp) att::diff_unit(ws, INP(I_DSUB) + l * 64, tidp, l, u, (char*)lds);
            PROBE_ADD(53, ptdf_, L);
        }
        REP(14) if (IN(p0 + 4) && (MK_PH & 64)) { PHASE_ENV();
            PROBE_T0(ptml_);
            for (int u = vcup; u < 768; u += Gp) att::mla_unit(ws, tidp, l, u, (char*)lds);
            PROBE_ADD(54, ptml_, L);
        }
        REP(15) if (IN(p0 + 4) && (MK_PH & 64)) { PHASE_ENV();
            PROBE_T0(ptmg_);
            att::dil_merge(ws, (const unsigned char*)INP(25), tidp, gw, NGW);
            PROBE_ADD(55, ptmg_, L);
        }
#endif
        PROBE_T0(pta_);
        SEAM(p0 + 4);
        PROBE_ADD(56, pta_, L);
        PROBE_ADD(44, ptw4_, L); PROBE_T0(ptw5_);
        REP(6) if (IN(p0 + 5) && (MK_PH & 128)) { PHASE_ENV();
            pg8::Gemm g{(const bf16*)(ws + WS_MIX), (const bf16*)(ws + W_O), MTOK, DM, DM, DM, DM}; pg8::StaticOrder S; S.init(MTOK, DM, Gp, bxp);
            pg8::EpiResidB E{XB, nullptr, P2, (((MK_DUP >> 6) & 1) && rep_ == 0) ? 0.0f : 1.0f};
            pg8::gemm_phase<pg8::EpiResidB, pg8::StaticOrder, true, MK_SP2>(tidp, L, xs, g, S, E);
        }
        SEAM(p0 + 5);
        PROBE_ADD(45, ptw5_, L); PROBE_T0(ptw6_);
        REP(7) if (IN(p0 + 6) && (MK_PH & 4)) { PHASE_ENV();
            pg8::Gemm g{XB, (const bf16*)(ws + W_GU2), MTOK, 2 * DFF, DM, DM, DM}; pg8::StaticOrder S; S.init(MTOK, 2 * DFF, Gp, bxp);
            pg8::EpiSwiGLU E{HB, P2};
            pg8::gemm_phase<pg8::EpiSwiGLU, pg8::StaticOrder, true, MK_SP2>(tidp, L, xs, g, S, E);
            if (MK_CONV_EARLY && l + 1 < DEPTH && bxp >= Gp / 2) convert_weights((volatile LAS unsigned long long*)(L + MISC_OFF + 128), ws, l + 1, 1, (bxp - Gp / 2) * 8 + wave, (Gp - Gp / 2) * 8, lane);
        }
        SEAM(p0 + 6);
        if (MK_PROBE_L < 0 || l == MK_PROBE_L) PROBE_ADD(46, ptw6_, L); PROBE_T0(ptw7_);
        REP(8) if (IN(p0 + 7) && (MK_PH & 8)) { PHASE_ENV();
            pg8::Gemm g{HB, (const bf16*)(ws + W_D2), MTOK, DM, DFF, DFF, DFF}; pg8::StaticOrder S; S.init(MTOK, DM, Gp, bxp);
            pg8::EpiResidB E{XB, l == DEPTH - 1 ? (float*)INP(25) : nullptr, P0, (((MK_DUP >> 8) & 1) && rep_ == 0) ? 0.0f : 0.5f};
            pg8::gemm_phase<pg8::EpiResidB, pg8::StaticOrder, true, MK_SP2>(tidp, L, xs, g, S, E);
        }
        if (l + 1 < DEPTH && !MK_CONV_EARLY) {
            SEAM(p0 + 7);
            REP(9) if (IN(p0 + 8) && (MK_PH & 2)) { PHASE_ENV(); convert_weights((volatile LAS unsigned long long*)(L + MISC_OFF + 128), ws, l + 1, 255, gw, NGW, lane); }
            SEAM(p0 + 8);
        }
        if (l + 1 < DEPTH && MK_CONV_EARLY) SEAM(p0 + 7);
        PROBE_ADD(48, ptw7_, L);
    }
    PROBE_ADD(49, ptall_, L);
#if MK_PROBE
    if (MODE < 0) { SEAM(99);
        int lidp_; asm volatile("v_mbcnt_lo_u32_b32 %0, -1, 0\n\tv_mbcnt_hi_u32_b32 %0, -1, %0" : "=v"(lidp_));
        if ((int)blockIdx.x == MK_PROBE_BLOCK && wave0 == 0 && lidp_ == 0) { const unsigned tk = ((volatile LAS unsigned*)(L + MISC_OFF + 96))[0]; float* o = (float*)args.out; o[1] = o[1] + 0.04f + (float)tk * 1.0e-8f * MK_PROBE_SCALE; } }
#endif
#undef IN
#undef SEAM
#undef PHASE_ENV
}

extern "C" void kernel_launch(void* const* d_in, const int* in_sizes, int n_in, void* d_out, int out_size, void* d_ws, size_t ws_size, hipStream_t stream) {
    static int grid = 0;
    if (grid == 0) {
        if (n_in != 25 || out_size != MTOK * DM || ws_size < WS_TOTAL) { fprintf(stderr, "kernel_launch: unexpected shapes (n_in %d out %d ws %zu)\n", n_in, out_size, ws_size); grid = -1; return; }
        int dev = 0, cus = 0, per_cu = 0;
        if (hipGetDevice(&dev) != hipSuccess || hipDeviceGetAttribute(&cus, hipDeviceAttributeMultiprocessorCount, dev) != hipSuccess) { grid = -1; return; }
#if MK_ONE_LAUNCH
        if (hipFuncSetAttribute((const void*)enc_fwd<-1>, hipFuncAttributeMaxDynamicSharedMemorySize, LDS_BYTES) != hipSuccess) { fprintf(stderr, "kernel_launch: hipFuncSetAttribute failed\n"); grid = -1; return; }
        if (hipOccupancyMaxActiveBlocksPerMultiprocessor(&per_cu, (const void*)enc_fwd<-1>, 512, LDS_BYTES) != hipSuccess || per_cu < 1) { fprintf(stderr, "kernel_launch: occupancy query says %d\n", per_cu); grid = -1; return; }
#else
#define SETATTR(K) if (hipFuncSetAttribute((const void*)enc_fwd<K>, hipFuncAttributeMaxDynamicSharedMemorySize, LDS_BYTES) != hipSuccess) { fprintf(stderr, "kernel_launch: hipFuncSetAttribute failed\n"); grid = -1; return; }
        SETATTR(0) SETATTR(1) SETATTR(2) SETATTR(3) SETATTR(4) SETATTR(5) SETATTR(6) SETATTR(7) SETATTR(8) SETATTR(9)
        per_cu = 1;
#endif
        (void)hipGetLastError();
        grid = cus;
    }
    if (grid < 0) return;
    (void)hipMemsetAsync((char*)d_ws + WS_CTL, 0, CTL_ZERO_BYTES, stream);
    Args a{};
    for (int i = 0; i < 25; ++i) a.in[i] = (const float*)d_in[i];
    a.out = (float*)d_out; a.ws = (unsigned char*)d_ws;
#if MK_ONE_LAUNCH
    a.layer = 0;
    hipLaunchKernelGGL(enc_fwd<-1>, dim3(grid), dim3(512), LDS_BYTES, stream, a);
#else
#define LAUNCH_PH(K, LAYER) do { a.layer = (LAYER); hipLaunchKernelGGL(enc_fwd<K>, dim3(grid), dim3(512), LDS_BYTES, stream, a); } while (0)
    LAUNCH_PH(0, 0);
    for (int l = 0; l < DEPTH; ++l) {
        LAUNCH_PH(1, l); LAUNCH_PH(2, l); LAUNCH_PH(3, l); LAUNCH_PH(4, l); LAUNCH_PH(5, l); LAUNCH_PH(6, l); LAUNCH_PH(7, l); LAUNCH_PH(8, l);
        if (l + 1 < DEPTH) LAUNCH_PH(9, l);
    }
#endif
}
```

```cpp
#include <hip/hip_runtime.h>
#include <cstdio>
#include <cstdint>
#define GAS __attribute__((address_space(1)))

#ifndef MK_PROBE
#define MK_PROBE 0
#endif
#ifndef MK_PROBE_SCALE
#define MK_PROBE_SCALE 1000.0f
#endif
#ifndef MK_EARLY_WB
#define MK_EARLY_WB 0
#endif
#ifndef MK_SC1_STORES
#define MK_SC1_STORES 0
#endif
#ifndef MK_ONE_LAUNCH
#define MK_ONE_LAUNCH 1
#endif

constexpr int DM = 1024, BATCH = 8, SEQ = 2048, DEPTH = 2, MTOK = BATCH * SEQ, DFF = 2816;
constexpr int IN_W = 2336, NIN = 2560;
constexpr float EPS = 1e-6f;
constexpr float LOG2E = 1.4426950408889634f;

__device__ __forceinline__ float sum_x32(float v) { const unsigned u = __builtin_bit_cast(unsigned, v); auto r = __builtin_amdgcn_permlane32_swap(u, u, false, false); return __builtin_bit_cast(float, (unsigned)r[0]) + __builtin_bit_cast(float, (unsigned)r[1]); }
__device__ __forceinline__ float max_x32(float v) { const unsigned u = __builtin_bit_cast(unsigned, v); auto r = __builtin_amdgcn_permlane32_swap(u, u, false, false); return fmaxf(__builtin_bit_cast(float, (unsigned)r[0]), __builtin_bit_cast(float, (unsigned)r[1])); }
template <int M> __device__ __forceinline__ float swz(float v) { return __builtin_bit_cast(float, __builtin_amdgcn_ds_swizzle(__builtin_bit_cast(int, v), 0x1F | (M << 10))); }

namespace pg8 {
#define PG8_LAS __attribute__((address_space(3)))
typedef unsigned short bf16_t;
typedef short bf16x8 __attribute__((ext_vector_type(8)));
typedef float f32x4 __attribute__((ext_vector_type(4)));
typedef unsigned u32x4 __attribute__((ext_vector_type(4)));
typedef unsigned u32x2 __attribute__((ext_vector_type(2)));
constexpr int BM = 256, BK = 64, HALF = 128, HTB = HALF * BK * 2  , STAGE_BYTES = 8 * HTB, NXCD = 8, WGM = 8;

__host__ __device__ __forceinline__ int lds_byte(int r, int c) { const int st = (r >> 4) * 2 + (c >> 5), rr = r & 15, cc = c & 31, ob = rr * 64 + cc * 2; return st * 1024 + (ob ^ (((ob >> 9) & 1) << 5)); }
__host__ __device__ __forceinline__ void stage_rc(int b, int& R, int& C) { const int st = b / 1024, sb = b % 1024, swz = sb ^ (((sb >> 9) & 1) << 5); R = (st >> 1) * 16 + swz / 64; C = (st & 1) * 32 + (swz % 64) / 2; }
__host__ __device__ __forceinline__ int perm32(int rho) { const int n = rho >> 4, i = rho & 15; return 8 * (i >> 2) + 4 * n + (i & 3); }

struct Unit { int pm, pn; };
struct Gemm { const bf16_t* A; const bf16_t* Bt; int M, N, K, lda, ldb; int asplit = 1 << 30, aoff = 0; };

struct StaticOrder {
    int nM, nN, nwg, G, c;
    __host__ __device__ void init(int M, int N, int G_, int c_) { nM = M / BM; nN = N / BM; nwg = nM * nN; G = G_; c = c_; }
    __host__ __device__ bool next(int i, Unit& u) const {
        const long L = (long)i * G + c; if (L >= nwg) return false;
        int wgid = (int)L; { const int q = nwg / NXCD, r = nwg % NXCD, xcd = wgid % NXCD, off = wgid / NXCD; wgid = (xcd < r ? xcd * (q + 1) : r * (q + 1) + (xcd - r) * q) + off; }
        const int nig = WGM * nN, gid = wgid / nig, fm = gid * WGM, gsz = (nM - fm) < WGM ? (nM - fm) : WGM;
        u.pm = fm + ((wgid % nig) % gsz); u.pn = (wgid % nig) / gsz; return true;
    }
    __device__ __forceinline__ void a_ready(const Unit&) const {}
    __device__ __forceinline__ void done(const Unit&) const {}
};

__device__ __forceinline__ unsigned cvt_pk_bf16(float lo, float hi) { unsigned r; asm volatile("v_cvt_pk_bf16_f32 %0, %1, %2" : "=v"(r) : "v"(lo), "v"(hi)); return r; }
__device__ __forceinline__ float rowscale16(const float* P, int row) {
    const GAS f32x4* p = (const GAS f32x4*)(P + (size_t)row * 16);
    const f32x4 a = p[0], b = p[1], c = p[2], d = p[3];
    const float s = ((a[0] + a[1]) + (a[2] + a[3])) + ((b[0] + b[1]) + (b[2] + b[3])) + ((c[0] + c[1]) + (c[2] + c[3])) + ((d[0] + d[1]) + (d[2] + d[3]));
    return __builtin_amdgcn_rsqf(s * (1.0f / 1024.0f) + EPS);
}
__device__ __forceinline__ void rowscale_all(const float* P, int row0, int fq, float (&r)[8]) {
    f32x4 t[8];
#pragma unroll
    for (int i = 0; i < 8; ++i) t[i] = *(const GAS f32x4*)(P + (size_t)(row0 + (i >> 2) * HALF + (i & 3) * 16) * 16 + fq * 4);
#pragma unroll
    for (int i = 0; i < 8; ++i) { float s = (t[i][0] + t[i][1]) + (t[i][2] + t[i][3]); s += swz<16>(s); s = sum_x32(s); r[i] = __builtin_amdgcn_rsqf(s * (1.0f / 1024.0f) + EPS); }
}
constexpr int RS_BACK_FLOATS = (155648 - 131072) / 4;
__device__ __forceinline__ void rowscale_cached(const float* P, int pm, int row0, int wr, int wc, int fr, int fq, PG8_LAS float* xs, float (&r)[8]) {
    PG8_LAS float* rc = xs - RS_BACK_FLOATS; PG8_LAS int* tg = (PG8_LAS int*)(rc + 4096);
    const int wid = wr * 4 + wc, lane = fq * 16 + fr;
    PG8_LAS f32x4* slot = (PG8_LAS f32x4*)(rc + (wid * 64 + lane) * 8);
    if (__builtin_amdgcn_readfirstlane(tg[wid]) == pm) { const f32x4 a = slot[0], b = slot[1]; r[0] = a[0]; r[1] = a[1]; r[2] = a[2]; r[3] = a[3]; r[4] = b[0]; r[5] = b[1]; r[6] = b[2]; r[7] = b[3]; }
    else { rowscale_all(P, row0, fq, r); slot[0] = (f32x4){r[0], r[1], r[2], r[3]}; slot[1] = (f32x4){r[4], r[5], r[6], r[7]}; if (lane == 0) tg[wid] = pm; }
}
__device__ __forceinline__ u32x4 pack8(const float* v) { u32x4 w; w.x = cvt_pk_bf16(v[0], v[1]); w.y = cvt_pk_bf16(v[2], v[3]); w.z = cvt_pk_bf16(v[4], v[5]); w.w = cvt_pk_bf16(v[6], v[7]); return w; }
__device__ __forceinline__ float quad_sum(float s) { s += swz<16>(s); return sum_x32(s); }
#define EPI_OPAQUE() do { u.pm = __builtin_amdgcn_readfirstlane(u.pm); u.pn = __builtin_amdgcn_readfirstlane(u.pn); wr = __builtin_amdgcn_readfirstlane(wr); wc = __builtin_amdgcn_readfirstlane(wc); \
    asm volatile("" : "+s"(u.pm), "+s"(u.pn), "+s"(wr), "+s"(wc), "+v"(fr), "+v"(fq)); } while (0)
#if MK_SC1_STORES
__device__ __forceinline__ void st16(void* p, u32x4 v) { asm volatile("global_store_dwordx4 %0, %1, off sc1\n\ts_nop 1" :: "v"(p), "v"(v) : "memory"); }
__device__ __forceinline__ void st16f(void* p, f32x4 v) { asm volatile("global_store_dwordx4 %0, %1, off sc1\n\ts_nop 1" :: "v"(p), "v"(v) : "memory"); }
#else
__device__ __forceinline__ void st16(void* p, u32x4 v) { *(GAS u32x4*)p = v; }
__device__ __forceinline__ void st16f(void* p, f32x4 v) { *(GAS f32x4*)p = v; }
#endif
#define XS_BAR() do { asm volatile("s_waitcnt lgkmcnt(0)" ::: "memory"); __builtin_amdgcn_s_barrier(); asm volatile("" ::: "memory"); } while (0)

struct EpiSwiGLU {
    static constexpr bool PERM = true, AFTER_DRAIN = false, DUP_OK = true;
    bf16_t* H; const float* P;
    __device__ __forceinline__ void operator()(const f32x4 (&acc)[2][2][4][2], const Unit& u_, int wr, int wc, int fr, int fq, PG8_LAS float* xs) const {
        Unit u = u_; EPI_OPAQUE();
        float rs[8]; rowscale_cached(P, u.pm, u.pm * BM + wr * 64 + fr, wr, wc, fr, fq, xs, rs);
#pragma unroll
        for (int ai = 0; ai < 2; ++ai)
#pragma unroll
            for (int m = 0; m < 4; ++m) {
                const int row = u.pm * BM + ai * HALF + wr * 64 + m * 16 + fr;
                const float r = rs[ai * 4 + m], rn = -LOG2E * r, r2 = r * r;
                float h[8];
#pragma unroll
                for (int n = 0; n < 2; ++n)
#pragma unroll
                    for (int j = 0; j < 4; ++j) {
                        const float a = acc[ai][0][m][n][j], b = acc[ai][1][m][n][j];
                        h[n * 4 + j] = (a * b) * (r2 * __builtin_amdgcn_rcpf(1.0f + __builtin_amdgcn_exp2f(a * rn)));
                    }
                st16(H + (size_t)row * DFF + u.pn * 128 + wc * 32 + fq * 8, pack8(h));
            }
    }
};

struct EpiResidB {
    static constexpr bool PERM = true, AFTER_DRAIN = false, DUP_OK = false;
    bf16_t* XB; float* Xout; float* Pout; float alpha;
    __device__ __forceinline__ void operator()(const f32x4 (&acc)[2][2][4][2], const Unit& u_, int wr, int wc, int fr, int fq, PG8_LAS float* xs) const {
        Unit u = u_; EPI_OPAQUE();
        const bool FINAL = Xout != nullptr;
        const size_t off0 = (size_t)(u.pm * BM + wr * 64 + fr) * DM + u.pn * BM + wc * 32 + fq * 8;
        u32x4 cur[2], nxt[2];
#pragma unroll
        for (int bj = 0; bj < 2; ++bj) cur[bj] = *(const GAS u32x4*)(XB + off0 + bj * HALF);
#pragma unroll
        for (int i = 0; i < 8; ++i) {
            const int ai = i >> 2, m = i & 3;
            const size_t off = off0 + (size_t)(ai * HALF + m * 16) * DM;
            if (i < 7) { const size_t offn = off0 + (size_t)(((i + 1) >> 2) * HALF + ((i + 1) & 3) * 16) * DM;
#pragma unroll
                for (int bj = 0; bj < 2; ++bj) nxt[bj] = *(const GAS u32x4*)(XB + offn + bj * HALF); }
            float ss = 0.f;
#pragma unroll
            for (int bj = 0; bj < 2; ++bj) {
                const u32x4 c = cur[bj];
                const f32x4 r0 = {__builtin_bit_cast(float, c[0] << 16), __builtin_bit_cast(float, c[0] & 0xffff0000u), __builtin_bit_cast(float, c[1] << 16), __builtin_bit_cast(float, c[1] & 0xffff0000u)};
                const f32x4 r1 = {__builtin_bit_cast(float, c[2] << 16), __builtin_bit_cast(float, c[2] & 0xffff0000u), __builtin_bit_cast(float, c[3] << 16), __builtin_bit_cast(float, c[3] & 0xffff0000u)};
                const f32x4 v0 = r0 + acc[ai][bj][m][0] * alpha, v1 = r1 + acc[ai][bj][m][1] * alpha;
                if (FINAL) { st16f(Xout + off + bj * HALF, v0); st16f(Xout + off + bj * HALF + 4, v1); }
                else { const float t[8] = {v0[0], v0[1], v0[2], v0[3], v1[0], v1[1], v1[2], v1[3]}; st16(XB + off + bj * HALF, pack8(t));
                    ss += (v0[0] * v0[0] + v0[1] * v0[1]) + (v0[2] * v0[2] + v0[3] * v0[3]) + (v1[0] * v1[0] + v1[1] * v1[1]) + (v1[2] * v1[2] + v1[3] * v1[3]); }
            }
            if (!FINAL) { ss = quad_sum(ss); if (fq == 0) ((GAS float*)Pout)[(size_t)(u.pm * BM + ai * HALF + wr * 64 + m * 16 + fr) * 16 + u.pn * 4 + wc] = ss; }
#pragma unroll
            for (int j = 0; j < 2; ++j) cur[j] = nxt[j];
            asm volatile("" ::: "memory");
        }
    }
};

struct EpiInProj {
    static constexpr bool PERM = true, AFTER_DRAIN = false, DUP_OK = false;
    const float* P;
    bf16_t *Qd, *Kd, *Vd, *Ql, *Kl, *Vl, *AQ; float *kr, *krss;
    const float *g_dq, *g_dk, *g_lq, *g_lk;
    float cdiff, cdil;
    int pn0;
    __device__ __forceinline__ void operator()(const f32x4 (&acc)[2][2][4][2], const Unit& u_, int wr, int wc, int fr, int fq, PG8_LAS float* xs) const {
        Unit u = u_; EPI_OPAQUE();
        const int t = u.pn + pn0;
        if (t == 7 || t == 8) {
#pragma unroll
            for (int ai = 0; ai < 2; ++ai)
#pragma unroll
                for (int m = 0; m < 4; ++m) {
                    const int rl = ai * HALF + wr * 64 + m * 16 + fr;
                    float ss = 0.f;
#pragma unroll
                    for (int bj = 0; bj < 2; ++bj)
#pragma unroll
                        for (int n = 0; n < 2; ++n) { const f32x4 a = acc[ai][bj][m][n]; ss += (a[0] * a[0] + a[1] * a[1]) + (a[2] * a[2] + a[3] * a[3]); }
                    ss = quad_sum(ss);
                    if (fq == 0) xs[rl * 4 + wc] = ss;
                }
            XS_BAR();
        }
        float rs[8]; rowscale_cached(P, u.pm, u.pm * BM + wr * 64 + fr, wr, wc, fr, fq, xs, rs);
        float gg[2][8];
        {
            const bool dil_ = (t >= 3 && t <= 5), isq_ = (t == 0) || (t == 3) || (t == 4 && wc < 2);
            const float *p_dq = g_dq, *p_dk = g_dk, *p_lq = g_lq, *p_lk = g_lk; asm volatile("" : "+s"(p_dq), "+s"(p_dk), "+s"(p_lq), "+s"(p_lk));
            const float* gp = dil_ ? (isq_ ? p_lq : p_lk) : (t == 1 ? p_dk : p_dq);
            const int gstep = dil_ ? 32 : 0;
#pragma unroll
            for (int bj = 0; bj < 2; ++bj)
#pragma unroll
                for (int i = 0; i < 8; ++i) gg[bj][i] = ((const GAS float*)gp)[bj * gstep + fq * 8 + i];
        }
#pragma unroll
        for (int ai = 0; ai < 2; ++ai)
#pragma unroll
            for (int m = 0; m < 4; ++m) {
                asm volatile("" ::: "memory");
                const int rl = ai * HALF + wr * 64 + m * 16 + fr, row = u.pm * BM + rl, b = row >> 11, s = row & (SEQ - 1);
                const float r = rs[ai * 4 + m];
                float v[2][8];
#pragma unroll
                for (int bj = 0; bj < 2; ++bj)
#pragma unroll
                    for (int n = 0; n < 2; ++n)
#pragma unroll
                        for (int j = 0; j < 4; ++j) v[bj][n * 4 + j] = acc[ai][bj][m][n][j] * r;
                if (t <= 1) {
                    bf16_t* dst = t == 0 ? Qd : Kd; const float post = t == 0 ? cdiff : 1.0f;
#pragma unroll
                    for (int bj = 0; bj < 2; ++bj) {
                        float ss = 0.f;
#pragma unroll
                        for (int i = 0; i < 8; ++i) ss += v[bj][i] * v[bj][i];
                        ss = quad_sum(ss);
                        const float rn = __builtin_amdgcn_rsqf(ss * (1.0f / 32.0f) + EPS) * post;
                        float o[8];
#pragma unroll
                        for (int i = 0; i < 8; ++i) o[i] = v[bj][i] * rn * gg[bj][i];
                        *(GAS u32x4*)(dst + ((size_t)(((b * 4 + wc) * 2 + bj) * SEQ + s)) * 32 + fq * 8) = pack8(o);
                    }
                } else if (t == 2) {
#pragma unroll
                    for (int bj = 0; bj < 2; ++bj) *(GAS u32x4*)(Vd + ((size_t)((b * 4 + wc) * SEQ + s)) * 64 + bj * 32 + fq * 8) = pack8(v[bj]);
                } else if (t <= 5) {
                    const bool isq = (t == 3) || (t == 4 && wc < 2);
                    const int head = (t == 3) ? wc : (t == 4 ? (wc < 2 ? 4 + wc : wc - 2) : wc + 2);
                    bf16_t* dst = isq ? Ql : Kl; const float post = isq ? cdil : 1.0f;
                    float ss = 0.f;
#pragma unroll
                    for (int bj = 0; bj < 2; ++bj)
#pragma unroll
                        for (int i = 0; i < 8; ++i) ss += v[bj][i] * v[bj][i];
                    ss = quad_sum(ss);
                    const float rn = __builtin_amdgcn_rsqf(ss * (1.0f / 64.0f) + EPS) * post;
#pragma unroll
                    for (int bj = 0; bj < 2; ++bj) {
                        float o[8];
#pragma unroll
                        for (int i = 0; i < 8; ++i) o[i] = v[bj][i] * rn * gg[bj][i];
                        *(GAS u32x4*)(dst + ((size_t)((b * 6 + head) * SEQ + s)) * 64 + bj * 32 + fq * 8) = pack8(o);
                    }
                } else if (t == 6 || (t == 7 && wc < 2)) {
                    const int head = t == 6 ? wc : 4 + wc;
#pragma unroll
                    for (int bj = 0; bj < 2; ++bj) *(GAS u32x4*)(Vl + ((size_t)((b * 6 + head) * SEQ + s)) * 64 + bj * 32 + fq * 8) = pack8(v[bj]);
                } else if (t == 7) {
                    const float ss = (xs[rl * 4 + 2] + xs[rl * 4 + 3]) * r * r;
                    const float rn = __builtin_amdgcn_rsqf(ss * (1.0f / 128.0f) + EPS);
#pragma unroll
                    for (int bj = 0; bj < 2; ++bj) {
                        float o[8];
#pragma unroll
                        for (int i = 0; i < 8; ++i) o[i] = v[bj][i] * rn;
                        *(GAS u32x4*)(AQ + (size_t)row * 384 + 256 + (wc - 2) * 64 + bj * 32 + fq * 8) = pack8(o);
                    }
                } else if (t == 8) {
                    const float ss = ((xs[rl * 4 + 0] + xs[rl * 4 + 1]) + (xs[rl * 4 + 2] + xs[rl * 4 + 3])) * r * r;
                    const float rn = __builtin_amdgcn_rsqf(ss * (1.0f / 256.0f) + EPS);
#pragma unroll
                    for (int bj = 0; bj < 2; ++bj) {
                        float o[8];
#pragma unroll
                        for (int i = 0; i < 8; ++i) o[i] = v[bj][i] * rn;
                        *(GAS u32x4*)(AQ + (size_t)row * 384 + bj * 128 + wc * 32 + fq * 8) = pack8(o);
                    }
                } else {
                    if (wc == 0) {
                        float ss = 0.f;
#pragma unroll
                        for (int bj = 0; bj < 2; ++bj)
#pragma unroll
                            for (int i = 0; i < 8; ++i) ss += v[bj][i] * v[bj][i];
                        ss = quad_sum(ss);
                        if (fq < 2) {
#pragma unroll
                            for (int bj = 0; bj < 2; ++bj) {
                                *(GAS f32x4*)(kr + (size_t)row * 32 + bj * 16 + fq * 8) = (f32x4){v[bj][0], v[bj][1], v[bj][2], v[bj][3]};
                                *(GAS f32x4*)(kr + (size_t)row * 32 + bj * 16 + fq * 8 + 4) = (f32x4){v[bj][4], v[bj][5], v[bj][6], v[bj][7]};
                            }
                        }
                        if (fq == 0) ((GAS float*)krss)[row] = ss;
                    }
                }
            }
    }
};

struct EpiMlaQ {
    static constexpr bool PERM = true, AFTER_DRAIN = false, DUP_OK = false;
    bf16_t* Qc; const float* qn; const float* cs; const float* sn; float cmla;
    __device__ __forceinline__ void operator()(const f32x4 (&acc)[2][2][4][2], const Unit& u_, int wr, int wc, int fr, int fq, PG8_LAS float* xs) const {
        Unit u = u_; EPI_OPAQUE();
#pragma unroll
        for (int ai = 0; ai < 2; ++ai)
#pragma unroll
            for (int m = 0; m < 4; ++m) {
                const int rl = ai * HALF + wr * 64 + m * 16 + fr;
                float ss = 0.f;
#pragma unroll
                for (int bj = 0; bj < 2; ++bj)
#pragma unroll
                    for (int n = 0; n < 2; ++n) { const f32x4 a = acc[ai][bj][m][n]; ss += (a[0] * a[0] + a[1] * a[1]) + (a[2] * a[2] + a[3] * a[3]); }
                ss = quad_sum(ss);
                if (fq == 0) xs[rl * 4 + wc] = ss;
            }
        XS_BAR();
        const int hs = wc >> 1, head = u.pn * 2 + hs; const bool rope = wc & 1;
        float gq[16];
#pragma unroll
        for (int i = 0; i < 16; ++i) gq[i] = ((const GAS float*)qn)[(rope ? 64 + (i >> 3) * 16 : (i >> 3) * 32) + fq * 8 + (i & 7)];
        float cc[8], sv[8], ccn[8], svn[8];
        if (rope && fq < 2) { const int s0 = (u.pm * BM + wr * 64 + fr) & (SEQ - 1);
#pragma unroll
            for (int i = 0; i < 8; ++i) { cc[i] = ((const GAS float*)cs)[s0 * 16 + fq * 8 + i]; sv[i] = ((const GAS float*)sn)[s0 * 16 + fq * 8 + i]; } }
#pragma unroll
        for (int ig = 0; ig < 8; ++ig) {
            const int ai = ig >> 2, m = ig & 3;
            const int rl = ai * HALF + wr * 64 + m * 16 + fr, row = u.pm * BM + rl, b = row >> 11, s = row & (SEQ - 1);
            if (rope && fq < 2 && ig < 7) { const int sn_ = (u.pm * BM + ((ig + 1) >> 2) * HALF + wr * 64 + ((ig + 1) & 3) * 16 + fr) & (SEQ - 1);
#pragma unroll
                for (int i = 0; i < 8; ++i) { ccn[i] = ((const GAS float*)cs)[sn_ * 16 + fq * 8 + i]; svn[i] = ((const GAS float*)sn)[sn_ * 16 + fq * 8 + i]; } }
            const float ss = xs[rl * 4 + hs * 2] + xs[rl * 4 + hs * 2 + 1];
            const float rn = __builtin_amdgcn_rsqf(ss * (1.0f / 96.0f) + EPS) * cmla;
            bf16_t* dst = Qc + ((size_t)((b * 6 + head) * SEQ + s)) * 96;
            if (!rope) {
#pragma unroll
                for (int bj = 0; bj < 2; ++bj) {
                    float o[8];
#pragma unroll
                    for (int n = 0; n < 2; ++n)
#pragma unroll
                        for (int j = 0; j < 4; ++j) o[n * 4 + j] = acc[ai][bj][m][n][j] * rn * gq[bj * 8 + n * 4 + j];
                    *(GAS u32x4*)(dst + bj * 32 + fq * 8) = pack8(o);
                }
            } else if (fq < 2) {
                float o1[8], o2[8];
#pragma unroll
                for (int n = 0; n < 2; ++n)
#pragma unroll
                    for (int j = 0; j < 4; ++j) {
                        const int i = n * 4 + j;
                        const float x1 = acc[ai][0][m][n][j] * rn * gq[i], x2 = acc[ai][1][m][n][j] * rn * gq[8 + i];
                        o1[i] = x1 * cc[i] - x2 * sv[i]; o2[i] = x1 * sv[i] + x2 * cc[i];
                    }
                *(GAS u32x4*)(dst + 64 + fq * 8) = pack8(o1);
                *(GAS u32x4*)(dst + 80 + fq * 8) = pack8(o2);
#pragma unroll
                for (int i = 0; i < 8; ++i) { cc[i] = ccn[i]; sv[i] = svn[i]; }
            }
            asm volatile("" ::: "memory");
        }
    }
};

struct EpiMlaKV {
    static constexpr bool PERM = true, AFTER_DRAIN = false, DUP_OK = false;
    bf16_t *Kc, *Vc; const float *kn, *kr, *krss, *cs, *sn;
    __device__ __forceinline__ void operator()(const f32x4 (&acc)[2][2][4][2], const Unit& u_, int wr, int wc, int fr, int fq, PG8_LAS float* xs) const {
        Unit u = u_; EPI_OPAQUE();
        const int hs = wc >> 1, head = u.pn * 2 + hs;
        if (wc & 1) {
#pragma unroll
            for (int ai = 0; ai < 2; ++ai)
#pragma unroll
                for (int m = 0; m < 4; ++m) {
                    asm volatile("" ::: "memory");
                    const int rl = ai * HALF + wr * 64 + m * 16 + fr, row = u.pm * BM + rl, b = row >> 11, s = row & (SEQ - 1);
#pragma unroll
                    for (int bj = 0; bj < 2; ++bj) {
                        float o[8];
#pragma unroll
                        for (int n = 0; n < 2; ++n)
#pragma unroll
                            for (int j = 0; j < 4; ++j) o[n * 4 + j] = acc[ai][bj][m][n][j];
                        *(GAS u32x4*)(Vc + ((size_t)((b * 6 + head) * SEQ + s)) * 64 + bj * 32 + fq * 8) = pack8(o);
                    }
                }
        } else {
            float gk[16], gr1[4], gr2[4];
#pragma unroll
            for (int i = 0; i < 16; ++i) gk[i] = ((const GAS float*)kn)[(i >> 3) * 32 + fq * 8 + (i & 7)];
#pragma unroll
            for (int j = 0; j < 4; ++j) { gr1[j] = ((const GAS float*)kn)[64 + fq * 4 + j]; gr2[j] = ((const GAS float*)kn)[80 + fq * 4 + j]; }
            f32x4 k1, k2, k1n, k2n, c4, s4, c4n, s4n; float kss, kssn;
            { const int row = u.pm * BM + wr * 64 + fr, s0 = row & (SEQ - 1);
              k1 = *(const GAS f32x4*)(kr + (size_t)row * 32 + fq * 4); k2 = *(const GAS f32x4*)(kr + (size_t)row * 32 + 16 + fq * 4); kss = ((const GAS float*)krss)[row];
              c4 = *(const GAS f32x4*)(cs + s0 * 16 + fq * 4); s4 = *(const GAS f32x4*)(sn + s0 * 16 + fq * 4); }
#pragma unroll
            for (int ig = 0; ig < 8; ++ig) {
                const int ai = ig >> 2, m = ig & 3;
                const int rl = ai * HALF + wr * 64 + m * 16 + fr, row = u.pm * BM + rl, b = row >> 11, s = row & (SEQ - 1);
                if (ig < 7) { const int rown = u.pm * BM + ((ig + 1) >> 2) * HALF + wr * 64 + ((ig + 1) & 3) * 16 + fr, s1 = rown & (SEQ - 1);
                    k1n = *(const GAS f32x4*)(kr + (size_t)rown * 32 + fq * 4); k2n = *(const GAS f32x4*)(kr + (size_t)rown * 32 + 16 + fq * 4); kssn = ((const GAS float*)krss)[rown];
                    c4n = *(const GAS f32x4*)(cs + s1 * 16 + fq * 4); s4n = *(const GAS f32x4*)(sn + s1 * 16 + fq * 4); }
                float ss = 0.f;
#pragma unroll
                for (int bj = 0; bj < 2; ++bj)
#pragma unroll
                    for (int n = 0; n < 2; ++n) { const f32x4 a = acc[ai][bj][m][n]; ss += (a[0] * a[0] + a[1] * a[1]) + (a[2] * a[2] + a[3] * a[3]); }
                ss = quad_sum(ss) + kss;
                const float rn = __builtin_amdgcn_rsqf(ss * (1.0f / 96.0f) + EPS);
                bf16_t* dst = Kc + ((size_t)((b * 6 + head) * SEQ + s)) * 96;
#pragma unroll
                for (int bj = 0; bj < 2; ++bj) {
                    float o[8];
#pragma unroll
                    for (int n = 0; n < 2; ++n)
#pragma unroll
                        for (int j = 0; j < 4; ++j) o[n * 4 + j] = acc[ai][bj][m][n][j] * rn * gk[bj * 8 + n * 4 + j];
                    *(GAS u32x4*)(dst + bj * 32 + fq * 8) = pack8(o);
                }
                float o1[4], o2[4];
#pragma unroll
                for (int j = 0; j < 4; ++j) {
                    const float x1 = k1[j] * rn * gr1[j], x2 = k2[j] * rn * gr2[j];
                    o1[j] = x1 * c4[j] - x2 * s4[j]; o2[j] = x1 * s4[j] + x2 * c4[j];
                }
                *(u32x2*)(dst + 64 + fq * 4) = (u32x2){cvt_pk_bf16(o1[0], o1[1]), cvt_pk_bf16(o1[2], o1[3])};
                *(u32x2*)(dst + 80 + fq * 4) = (u32x2){cvt_pk_bf16(o2[0], o2[1]), cvt_pk_bf16(o2[2], o2[3])};
                k1 = k1n; k2 = k2n; kss = kssn; c4 = c4n; s4 = s4n;
                asm volatile("" ::: "memory");
            }
        }
    }
};

struct EpiMlaQKV {
    static constexpr bool PERM = true, AFTER_DRAIN = false, DUP_OK = false;
    EpiMlaQ eq; EpiMlaKV ekv;
    __device__ __forceinline__ void operator()(const f32x4 (&acc)[2][2][4][2], const Unit& u_, int wr, int wc, int fr, int fq, PG8_LAS float* xs) const {
        if (u_.pn < 3) eq(acc, u_, wr, wc, fr, fq, xs);
        else { Unit v = u_; v.pn -= 3; ekv(acc, v, wr, wc, fr, fq, xs); }
    }
};
template <class Epi, class Sched, bool ALIGN_EPI = false, bool SP2 = false>
__device__ __forceinline__ void gemm_phase(const int tid, PG8_LAS unsigned char* lds, PG8_LAS float* xs, const Gemm g, const Sched& S, const Epi& E) {
    const int wid = __builtin_amdgcn_readfirstlane(tid >> 6), lane = tid & 63, wr = wid >> 2, wc = wid & 3, fr = lane & 15, fq = lane >> 4;
    const int K = g.K, nt = K / BK;
    unsigned voffA[2], voffB[2];
#pragma unroll
    for (int i = 0; i < 2; ++i) { int R, C; stage_rc(tid * 16 + i * 8192, R, C); const int Rb = Epi::PERM ? ((R & ~31) + perm32(R & 31)) : R;
        voffA[i] = (unsigned)(R * g.lda + C) * 2u; voffB[i] = (unsigned)(Rb * g.ldb + C) * 2u; }
    const size_t kstep = (size_t)(BK * 2);
    const size_t hstepA = (size_t)HALF * g.lda * 2, hstepB = (size_t)HALF * g.ldb * 2;
    const size_t tstepA = 2 * hstepA, tstepB = 2 * hstepB;
    const unsigned ldsw = (unsigned)wid * 1024u;
    const int aoff = lds_byte(wr * 64 + fr, fq * 8), boff = lds_byte(wc * 32 + fr, fq * 8);
#define PG8_SA(b, h) (((b) * 2 + (h)) * HTB)
#define PG8_SB(b, h) ((4 + (b) * 2 + (h)) * HTB)
#define PG8_STAGE(bufoff, gbase, voff) do { _Pragma("unroll") for (int _i = 0; _i < 2; ++_i) \
        __builtin_amdgcn_global_load_lds((const unsigned*)((const char*)(gbase) + (voff)[_i]), (PG8_LAS unsigned*)(lds + (bufoff) + ldsw + _i * 8192), 16, 0, 0); } while (0)
#define PG8_LDA(dst, b, h) do { _Pragma("unroll") for (int m = 0; m < 4; ++m) _Pragma("unroll") for (int k = 0; k < 2; ++k) dst[m][k] = *(const PG8_LAS bf16x8*)(lds + PG8_SA(b, h) + aoff + m * 2048 + k * 1024); } while (0)
#define PG8_LDB(dst, b, h) do { _Pragma("unroll") for (int n = 0; n < 2; ++n) _Pragma("unroll") for (int k = 0; k < 2; ++k) dst[n][k] = *(const PG8_LAS bf16x8*)(lds + PG8_SB(b, h) + boff + n * 2048 + k * 1024); } while (0)
#define PG8_MMA(ai, bj, At, Bt) do { __builtin_amdgcn_s_setprio(1); _Pragma("unroll") for (int m = 0; m < 4; ++m) _Pragma("unroll") for (int n = 0; n < 2; ++n) _Pragma("unroll") for (int k = 0; k < 2; ++k) \
        acc[ai][bj][m][n] = __builtin_amdgcn_mfma_f32_16x16x32_bf16(Bt[n][k], At[m][k], acc[ai][bj][m][n], 0, 0, 0); __builtin_amdgcn_s_setprio(0); } while (0)
#define PG8_WAIT_V(n) asm volatile("s_waitcnt vmcnt(" #n ")" ::: "memory")
#define PG8_WAIT_L(n) asm volatile("s_waitcnt lgkmcnt(" #n ")" ::: "memory")
#define PG8_BAR __builtin_amdgcn_s_barrier()
#define PG8_SCHED __builtin_amdgcn_sched_barrier(0)
    Unit cur, nxt; int ui = 0;
    if (!S.next(0, cur)) return;
    f32x4 acc[2][2][4][2];
#pragma unroll
    for (int a = 0; a < 2; ++a)
#pragma unroll
        for (int b = 0; b < 2; ++b)
#pragma unroll
            for (int m = 0; m < 4; ++m)
#pragma unroll
                for (int n = 0; n < 2; ++n) acc[a][b][m][n] = (f32x4){0.f, 0.f, 0.f, 0.f};
    bf16x8 At[4][2], B0[2][2], B1[2][2];
    const char* cA = (const char*)g.A + (size_t)cur.pm * tstepA + (cur.pn >= g.asplit ? g.aoff : 0); const char* cB = (const char*)g.Bt + (size_t)cur.pn * tstepB;
    S.a_ready(cur);
    if constexpr (SP2) {
        PG8_STAGE(PG8_SB(0, 0), cB, voffB); PG8_STAGE(PG8_SB(0, 1), cB + hstepB, voffB); PG8_STAGE(PG8_SA(0, 0), cA, voffA); PG8_STAGE(PG8_SA(0, 1), cA + hstepA, voffA);
        if (wr == 1) PG8_BAR;
        PG8_WAIT_V(2); PG8_BAR;
        PG8_STAGE(PG8_SB(1, 0), cB + kstep, voffB); PG8_STAGE(PG8_SA(1, 0), cA + kstep, voffA); PG8_STAGE(PG8_SB(1, 1), cB + hstepB + kstep, voffB);
        PG8_WAIT_V(6); PG8_BAR;
    } else {
        PG8_STAGE(PG8_SB(0, 0), cB, voffB); PG8_STAGE(PG8_SA(0, 0), cA, voffA); PG8_STAGE(PG8_SB(0, 1), cB + hstepB, voffB); PG8_STAGE(PG8_SA(0, 1), cA + hstepA, voffA);
        if (wr == 1) PG8_BAR;
        PG8_WAIT_V(4); PG8_BAR;
        PG8_STAGE(PG8_SB(1, 0), cB + kstep, voffB); PG8_STAGE(PG8_SA(1, 0), cA + kstep, voffA); PG8_STAGE(PG8_SB(1, 1), cB + hstepB + kstep, voffB);
        PG8_WAIT_V(6); PG8_BAR;
    }
    for (;;) {
        const bool has_next = S.next(ui + 1, nxt);
        const char* nA = has_next ? (const char*)g.A + (size_t)nxt.pm * tstepA + (nxt.pn >= g.asplit ? g.aoff : 0) : cA; const char* nB = has_next ? (const char*)g.Bt + (size_t)nxt.pn * tstepB : cB;
        for (int t = 0; t < nt; t += 2) {
            const bool last = (t == nt - 2);
            const char* a1 = cA + (size_t)(t + 1) * kstep;
            const char* a2 = last ? nA : cA + (size_t)(t + 2) * kstep; const char* b2 = last ? nB : cB + (size_t)(t + 2) * kstep;
            const char* a3 = a2 + kstep; const char* b3 = b2 + kstep;
            if (last && has_next) S.a_ready(nxt);
            if constexpr (SP2) {
            PG8_LDB(B0, 0, 0); PG8_LDB(B1, 0, 1); PG8_SCHED; PG8_LDA(At, 0, 0); PG8_STAGE(PG8_SA(1, 1), a1 + hstepA, voffA);
            PG8_WAIT_V(8); PG8_WAIT_L(0); PG8_BAR; PG8_MMA(0, 0, At, B0); PG8_MMA(0, 1, At, B1); PG8_BAR; PG8_SCHED;
            PG8_LDA(At, 0, 1); PG8_STAGE(PG8_SB(0, 0), b2, voffB); PG8_STAGE(PG8_SB(0, 1), b2 + hstepB, voffB); PG8_STAGE(PG8_SA(0, 0), a2, voffA);
            PG8_WAIT_V(8); PG8_WAIT_L(0); PG8_BAR; PG8_MMA(1, 0, At, B0); PG8_MMA(1, 1, At, B1); PG8_BAR; PG8_SCHED;
            PG8_LDB(B0, 1, 0); PG8_LDB(B1, 1, 1); PG8_SCHED; PG8_LDA(At, 1, 0); PG8_STAGE(PG8_SA(0, 1), a2 + hstepA, voffA);
            PG8_WAIT_V(8); PG8_WAIT_L(0); PG8_BAR; PG8_MMA(0, 0, At, B0); PG8_MMA(0, 1, At, B1); PG8_BAR; PG8_SCHED;
            PG8_LDA(At, 1, 1); PG8_STAGE(PG8_SB(1, 0), b3, voffB); PG8_STAGE(PG8_SB(1, 1), b3 + hstepB, voffB); PG8_STAGE(PG8_SA(1, 0), a3, voffA);
            PG8_WAIT_V(8); PG8_WAIT_L(0); PG8_BAR; PG8_MMA(1, 0, At, B0); PG8_MMA(1, 1, At, B1); PG8_BAR; PG8_SCHED;
            } else {
            PG8_LDB(B0, 0, 0); PG8_SCHED; PG8_LDA(At, 0, 0); PG8_STAGE(PG8_SA(1, 1), a1 + hstepA, voffA);
            PG8_WAIT_L(8); PG8_BAR; PG8_WAIT_L(0); PG8_MMA(0, 0, At, B0); PG8_BAR; PG8_SCHED;
            PG8_LDB(B1, 0, 1); PG8_STAGE(PG8_SB(0, 0), b2, voffB);
            PG8_BAR; PG8_WAIT_L(0); PG8_MMA(0, 1, At, B1); PG8_BAR;
            PG8_LDA(At, 0, 1); PG8_STAGE(PG8_SA(0, 0), a2, voffA);
            PG8_BAR; PG8_WAIT_L(0); PG8_MMA(1, 0, At, B0); PG8_BAR; PG8_SCHED;
            PG8_STAGE(PG8_SB(0, 1), b2 + hstepB, voffB);
            PG8_WAIT_V(6); PG8_BAR; PG8_MMA(1, 1, At, B1); PG8_BAR;
            PG8_LDB(B0, 1, 0); PG8_SCHED; PG8_LDA(At, 1, 0); PG8_STAGE(PG8_SA(0, 1), a2 + hstepA, voffA);
            PG8_WAIT_L(8); PG8_BAR; PG8_WAIT_L(0); PG8_MMA(0, 0, At, B0); PG8_BAR; PG8_SCHED;
            PG8_LDB(B1, 1, 1); PG8_STAGE(PG8_SB(1, 0), b3, voffB);
            PG8_BAR; PG8_WAIT_L(0); PG8_MMA(0, 1, At, B1); PG8_BAR;
            PG8_LDA(At, 1, 1); PG8_STAGE(PG8_SA(1, 0), a3, voffA);
            PG8_BAR; PG8_WAIT_L(0); PG8_MMA(1, 0, At, B0); PG8_BAR; PG8_SCHED;
            PG8_STAGE(PG8_SB(1, 1), b3 + hstepB, voffB);
            PG8_WAIT_V(6); PG8_BAR; PG8_MMA(1, 1, At, B1); PG8_BAR;
            }
        }
        if constexpr (ALIGN_EPI) { if (wr == 0) PG8_BAR; }
        if constexpr (!Epi::AFTER_DRAIN) { E(acc, cur, wr, wc, fr, fq, xs);
#if defined(MK_DUP_EPI)
            if constexpr (Epi::DUP_OK) E(acc, cur, wr, wc, fr, fq, xs);
#endif
            S.done(cur); }
        if (!has_next) break;
#pragma unroll
        for (int a = 0; a < 2; ++a)
#pragma unroll
            for (int b = 0; b < 2; ++b)
#pragma unroll
                for (int m = 0; m < 4; ++m)
#pragma unroll
                    for (int n = 0; n < 2; ++n) acc[a][b][m][n] = (f32x4){0.f, 0.f, 0.f, 0.f};
        cur = nxt; cA = nA; cB = nB; ++ui;
        if constexpr (ALIGN_EPI) { if (wr == 1) PG8_BAR; }
    }
    PG8_WAIT_V(0);
    if constexpr (!ALIGN_EPI) { if (wr == 0) PG8_BAR; }
    PG8_BAR;
    if constexpr (Epi::AFTER_DRAIN) { E(acc, cur, wr, wc, fr, fq, xs); S.done(cur); }
#undef PG8_SA
#undef PG8_SB
#undef PG8_STAGE
#undef PG8_LDA
#undef PG8_LDB
#undef PG8_MMA
#undef PG8_WAIT_V
#undef PG8_WAIT_L
#undef PG8_BAR
#undef PG8_SCHED
}
}

constexpr size_t MiB = 1u << 20;
constexpr size_t WS_CTL = 0, CTL_ZERO_BYTES = 32 * 1024;
constexpr size_t WS_TAB = 1 * MiB;
constexpr size_t WS_P = 2 * MiB;
constexpr size_t WS_KR = 5 * MiB;
constexpr size_t WS_KRSS = 7 * MiB;
constexpr size_t WS_W = 8 * MiB;
constexpr size_t W_GU1 = WS_W, W_GU2 = W_GU1 + 11 * MiB, W_D1 = W_GU2 + 11 * MiB, W_D2 = W_D1 + 5632 * 1024, W_IN = W_D2 + 5632 * 1024, W_O = W_IN + 5 * MiB, W_QU = W_O + 2 * MiB, W_KVU = W_QU + 768 * 256 * 2, W_END = W_KVU + 768 * 256 * 2;
static_assert(W_END <= 50 * MiB, "weights");
constexpr size_t WS_XB = 50 * MiB;
constexpr size_t WS_R = 82 * MiB;
constexpr size_t WS_H = WS_R;
constexpr size_t WS_QD = WS_R, WS_KD = WS_QD + 8 * MiB, WS_VD = WS_KD + 8 * MiB, WS_QL = WS_VD + 8 * MiB, WS_KL = WS_QL + 12 * MiB, WS_VL = WS_KL + 12 * MiB;
constexpr size_t WS_QC = WS_VL + 12 * MiB, WS_KC = WS_QC + 18 * MiB, WS_VC = WS_KC + 18 * MiB, WS_AQ = WS_VC + 12 * MiB, WS_MIX = WS_AQ + 12 * MiB, WS_END = WS_MIX + 32 * MiB;
static_assert(WS_END <= 236 * MiB && WS_H + (size_t)MTOK * DFF * 2 <= WS_MIX, "d_ws map");
constexpr size_t WS_DO0 = 0, WS_DO1 = 12 * MiB, WS_DO2 = 24 * MiB, WS_DL = 36 * MiB, WS_TOTAL = 236 * MiB;
constexpr int TAB_COS = 0, TAB_SIN = 32768;
constexpr int TAB_BD = 65536;
constexpr int TAB_BL = TAB_BD + 2 * 4 * 4096;
constexpr int TAB_SC = TAB_BL + 2 * 6 * 4096;
static_assert((TAB_SC + 64) * 4 <= (int)MiB, "tables");
constexpr int CW_BAR = 4096;

constexpr int RING_BYTES = 131072, XS_OFF = 155648, XS_BYTES = 4096, MISC_OFF = 159744, LDS_BYTES = 163840;

#define LAS __attribute__((address_space(3)))
typedef unsigned short bf16;
typedef unsigned v4u __attribute__((ext_vector_type(4)));
typedef float f32x4 __attribute__((ext_vector_type(4)));
typedef GAS unsigned gu32;
#define RLX_AGENT __ATOMIC_RELAXED, __HIP_MEMORY_SCOPE_AGENT
#define LDS_WAIT() asm volatile("s_waitcnt lgkmcnt(0)" ::: "memory")
__device__ __forceinline__ unsigned f2bf(float f) { unsigned u = __builtin_bit_cast(unsigned, f); return (u + 0x7fffu + ((u >> 16) & 1u)) >> 16; }
__device__ __forceinline__ unsigned pk2(float lo, float hi) { return f2bf(lo) | (f2bf(hi) << 16); }
__device__ __forceinline__ float bflo(unsigned w) { return __builtin_bit_cast(float, w << 16); }
__device__ __forceinline__ float bfhi(unsigned w) { return __builtin_bit_cast(float, w & 0xffff0000u); }
__device__ __forceinline__ void unpack8(v4u w, float* o) { o[0] = bflo(w.x); o[1] = bfhi(w.x); o[2] = bflo(w.y); o[3] = bfhi(w.y); o[4] = bflo(w.z); o[5] = bfhi(w.z); o[6] = bflo(w.w); o[7] = bfhi(w.w); }

#define XB_TMO      128
#define XB_XCNT(j)  (256  + 64 * (j))
#define XB_XSUB(j)  (1280 + 64 * (j))
#define XB_XGEN(j)  (2304 + 64 * (j))
#define XB_TOP      3328
#define XB_TOPGEN   3392
#define XCD_BAR_WORDS 3456
#define XB_SPIN_CAP (1u << 22)

__device__ __forceinline__ unsigned xb_ld(unsigned* p)              { return __hip_atomic_load(p, __ATOMIC_RELAXED, __HIP_MEMORY_SCOPE_AGENT); }
__device__ __forceinline__ unsigned xb_add(unsigned* p, unsigned v) { return __hip_atomic_fetch_add(p, v, __ATOMIC_RELAXED, __HIP_MEMORY_SCOPE_AGENT); }
__device__ __forceinline__ unsigned xb_xcc_id() { return (unsigned)__builtin_amdgcn_s_getreg((3 << 11) | 20) & 0xFu; }
#define XB_SPIN(cond, bar) do { unsigned _sp = 0; while (cond) { __builtin_amdgcn_s_sleep(1); \
    if ((++_sp & 255u) == 0u) { if (xb_ld(&(bar)[XB_TMO])) break; if (_sp > XB_SPIN_CAP) { atomicAdd(&(bar)[XB_TMO], 1u); break; } } } } while (0)

__device__ __forceinline__ void xcd_barrier_post(unsigned* bar, volatile LAS unsigned* st, bool tid0) {
    if (tid0) { const unsigned x = xb_xcc_id(); st[2] = x; st[3] = xb_add(&bar[XB_XCNT(x)], 1u); }
}
__device__ __forceinline__ void xcd_barrier_complete(unsigned* bar, unsigned x, unsigned& nloc, unsigned& nx) {
    const unsigned G = gridDim.x * gridDim.y * gridDim.z;
    unsigned sum, cnt, mine, sp = 0u;
    for (;;) {
        sum = 0u; cnt = 0u; mine = 0u;
        for (unsigned j = 0; j < 16; ++j) { const unsigned c = xb_ld(&bar[XB_XCNT(j)]); sum += c; cnt += (c > 0u) ? 1u : 0u; mine = (j == x) ? c : mine; }
        if (sum == G) break;
        __builtin_amdgcn_s_sleep(1);
        if ((++sp & 255u) == 0u) { if (xb_ld(&bar[XB_TMO])) break; if (sp > XB_SPIN_CAP) { atomicAdd(&bar[XB_TMO], 1u); break; } }
    }
    nloc = mine > 0u ? mine : 1u; nx = cnt > 0u ? cnt : 1u;
}
__device__ __forceinline__ void xcd_barrier(unsigned* bar0, volatile LAS unsigned* st, bool tid0) {
    asm volatile("s_waitcnt vmcnt(0)" ::: "memory");
    __syncthreads();
    if (tid0) {
        unsigned* bar = bar0; asm volatile("" : "+v"(bar));
        __builtin_amdgcn_s_waitcnt(0);
        unsigned nloc = st[0], nx = st[1]; const unsigned x = st[2];
        if (nloc == 0u) { xcd_barrier_complete(bar, x, nloc, nx); st[0] = nloc; st[1] = nx; }
#if MK_EARLY_WB
        __builtin_amdgcn_fence(__ATOMIC_RELEASE, "agent");
        asm volatile("s_waitcnt vmcnt(0)" ::: "memory");
#endif
        const unsigned old = xb_add(&bar[XB_XSUB(x)], 1u);
        const unsigned gen = old / nloc;
        if (old + 1u == (gen + 1u) * nloc) {
            __builtin_amdgcn_fence(__ATOMIC_RELEASE, "agent");
            asm volatile("s_waitcnt vmcnt(0)" ::: "memory");
            const unsigned og = xb_add(&bar[XB_TOP], 1u);
            const unsigned tg = og / nx;
            if (og + 1u == (tg + 1u) * nx) xb_add(&bar[XB_TOPGEN], 1u);
            else XB_SPIN(xb_ld(&bar[XB_TOPGEN]) == tg, bar);
            __builtin_amdgcn_fence(__ATOMIC_ACQUIRE, "agent");
            asm volatile("s_waitcnt vmcnt(0)" ::: "memory");
            xb_add(&bar[XB_XGEN(x)], 1u);
            asm volatile("s_waitcnt vmcnt(0)" ::: "memory");
        } else {
            XB_SPIN(xb_ld(&bar[XB_XGEN(x)]) == gen, bar);
            asm volatile("buffer_inv sc0\n\ts_waitcnt vmcnt(0)" ::: "memory");
            __builtin_amdgcn_fence(__ATOMIC_ACQUIRE, "workgroup");
        }
    }
    __syncthreads();
}

#define XL_CNT(j) (3456 + 32 * (j))
#define XL_GEN(j) (3712 + 32 * (j))
__device__ __forceinline__ void xcd_local_barrier(unsigned* bar0, volatile LAS unsigned* st, bool tid0) {
    asm volatile("s_waitcnt vmcnt(0)" ::: "memory");
    __syncthreads();
    if (tid0) {
        unsigned* bar = bar0; asm volatile("" : "+v"(bar));
        __builtin_amdgcn_s_waitcnt(0);
        const unsigned nloc = st[0], x = st[2];
        const unsigned old = xb_add(&bar[XL_CNT(x)], 1u), gen = old / nloc;
        if (old + 1u == (gen + 1u) * nloc) xb_add(&bar[XL_GEN(x)], 1u);
        else XB_SPIN(xb_ld(&bar[XL_GEN(x)]) == gen, bar);
        asm volatile("buffer_inv sc0\n\ts_waitcnt vmcnt(0)" ::: "memory");
        __builtin_amdgcn_fence(__ATOMIC_ACQUIRE, "workgroup");
    }
    __syncthreads();
}
__device__ __forceinline__ bool xcd_topology_regular(unsigned* bar, unsigned G) {
    bool ok = (G % 8u) == 0u;
    for (unsigned j = 0; j < 16; ++j) { const unsigned c = xb_ld(&bar[XB_XCNT(j)]); ok = ok && (c == (j < 8u ? G / 8u : 0u)); }
    return ok;
}

#ifndef MK_PROBE_BLOCK
#define MK_PROBE_BLOCK 0
#endif
#if MK_PROBE
#define PROBE_T0(var) const unsigned var = (unsigned)__builtin_amdgcn_readfirstlane((int)__builtin_amdgcn_s_memrealtime())
#define PROBE_ADD(id, var, shm) do { if (MK_PROBE == (id) && blockIdx.x == MK_PROBE_BLOCK) { const unsigned d_ = (unsigned)__builtin_amdgcn_s_memrealtime() - (var); \
        volatile LAS unsigned* pm_ = (volatile LAS unsigned*)((LAS unsigned char*)(shm) + MISC_OFF + 96); if (threadIdx.x == 0) pm_[0] = pm_[0] + (unsigned)d_; } } while (0)
#else
#define PROBE_T0(var) do {} while (0)
#define PROBE_ADD(id, var, shm) do {} while (0)
#endif
struct Args { const float* in[25]; float* out; unsigned char* ws; int layer, pad; };
enum { I_X = 0, I_RELB, I_F1N, I_F1G, I_F1U, I_F1D, I_MIXN, I_WIN, I_DQN, I_DKN, I_DLAM, I_DSUB, I_LQN, I_LKN, I_MQN, I_MQU, I_MKVN, I_MKVU, I_MQNG, I_MKNG, I_WO, I_F2N, I_F2G, I_F2U, I_F2D };

__device__ __forceinline__ float wave_sum(float v) { v += swz<1>(v); v += swz<2>(v); v += swz<4>(v); v += swz<8>(v); v += swz<16>(v); return sum_x32(v); }
__device__ __forceinline__ float wave_max(float v) { v = fmaxf(v, swz<1>(v)); v = fmaxf(v, swz<2>(v)); v = fmaxf(v, swz<4>(v)); v = fmaxf(v, swz<8>(v)); v = fmaxf(v, swz<16>(v)); return max_x32(v); }

__device__ __forceinline__ const void* lds_ptr_get(volatile LAS unsigned long long* PT, int i) {
    const unsigned long long v = PT[i];
    const unsigned lo = __builtin_amdgcn_readfirstlane((unsigned)v), hi = __builtin_amdgcn_readfirstlane((unsigned)(v >> 32));
    return (const void*)(((unsigned long long)hi << 32) | lo);
}
#define AIN(i) ((const float*)lds_ptr_get(PT, (i)))
__device__ __forceinline__ void tr_item64(const float* W, int Nsrc, int ks0, const float* gain, int sc, bool valid, bf16* dstrow) {
    float v[64];
    const GAS float* src = (const GAS float*)(W + (size_t)ks0 * Nsrc + sc);
#pragma unroll
    for (int i = 0; i < 64; ++i) v[i] = valid ? __builtin_nontemporal_load(src + (size_t)i * Nsrc) : 0.f;
    if (gain) {
        int z = 0; asm volatile("" : "+v"(z));
        const GAS float* gp = (const GAS float*)(gain + ks0 + z);
        float gk[64];
#pragma unroll
        for (int i = 0; i < 64; ++i) gk[i] = gp[i];
#pragma unroll
        for (int i = 0; i < 64; ++i) v[i] *= gk[i];
    }
#pragma unroll
    for (int j = 0; j < 8; ++j) { v4u o; o.x = pk2(v[8 * j], v[8 * j + 1]); o.y = pk2(v[8 * j + 2], v[8 * j + 3]); o.z = pk2(v[8 * j + 4], v[8 * j + 5]); o.w = pk2(v[8 * j + 6], v[8 * j + 7]);
        *(GAS v4u*)(dstrow + 8 * j) = o; }
}

__device__ __forceinline__ void win_map(int g, int& sc, int& nvalid) {
    const int pn = g >> 3, gi = g & 7, bj = gi >> 2, wc = gi & 3; nvalid = 32;
    switch (pn) {
        case 0: sc = 0 + wc * 64 + bj * 32; break;
        case 1: sc = 256 + wc * 64 + bj * 32; break;
        case 2: sc = 512 + wc * 64 + bj * 32; break;
        case 3: sc = 768 + wc * 64 + bj * 32; break;
        case 4: sc = (wc < 2) ? 768 + (4 + wc) * 64 + bj * 32 : 1152 + (wc - 2) * 64 + bj * 32; break;
        case 5: sc = 1152 + (wc + 2) * 64 + bj * 32; break;
        case 6: sc = 1536 + wc * 64 + bj * 32; break;
        case 7: sc = (wc < 2) ? 1536 + (4 + wc) * 64 + bj * 32 : 2176 + (wc - 2) * 64 + bj * 32; break;
        case 8: sc = 1920 + bj * 128 + wc * 32; break;
        default: sc = 2176 + 128 + bj * 16; nvalid = (wc == 0) ? 16 : 0; break;
    }
}

__device__ __forceinline__ void convert_weights(volatile LAS unsigned long long* PT, unsigned char* ws, int l, int sel, int gw, int NGW, int lane) {
    constexpr int I_GU = (5632 / 64) * 16, I_D = 16 * 44, I_IN = 40 * 16, I_O = 16 * 16, I_QU = 12 * 4, I_KVU = 12 * 4;
    constexpr int NITEMS = 2 * I_GU + 2 * I_D + I_IN + I_O + I_QU + I_KVU;
    const int lg = lane >> 5, li = lane & 31;
    for (int it = gw; it < NITEMS; it += NGW) {
        int r = it;
        if (r < 2 * I_GU) {
            const int f = r / I_GU; r -= f * I_GU; if (!((sel >> f) & 1)) continue; const int G2 = r >> 4, kb = r & 15, g = 2 * G2 + lg;
            const int pn = g >> 3, gi = g & 7, bj = gi >> 2, wc = gi & 3;
            const float* Wg = AIN(f == 0 ? I_F1G : I_F2G) + (size_t)l * DM * DFF; const float* Wu = AIN(f == 0 ? I_F1U : I_F2U) + (size_t)l * DM * DFF;
            const float* gain = AIN(f == 0 ? I_F1N : I_F2N) + l * DM;
            bf16* dst = (bf16*)(ws + (f == 0 ? W_GU1 : W_GU2)) + (size_t)(32 * g + li) * DM + 64 * kb;
            tr_item64(bj == 0 ? Wg : Wu, DFF, 64 * kb, gain, pn * 128 + wc * 32 + li, true, dst); continue;
        }
        r -= 2 * I_GU;
        if (r < 2 * I_D) {
            const int f = r / I_D; r -= f * I_D; if (!((sel >> (2 + f)) & 1)) continue; const int G2 = r / 44, kb = r - G2 * 44;
            const float* W = AIN(f == 0 ? I_F1D : I_F2D) + (size_t)l * DFF * DM;
            bf16* dst = (bf16*)(ws + (f == 0 ? W_D1 : W_D2)) + (size_t)(64 * G2 + lane) * DFF + 64 * kb;
            tr_item64(W, DM, 64 * kb, nullptr, 64 * G2 + lane, true, dst); continue;
        }
        r -= 2 * I_D;
        if (r < I_IN) {
            if (!(sel & 16)) continue;
            const int G2 = r >> 4, kb = r & 15, g = 2 * G2 + lg; int sc, nv; win_map(g, sc, nv);
            const float* W = AIN(I_WIN) + (size_t)l * DM * IN_W;
            bf16* dst = (bf16*)(ws + W_IN) + (size_t)(32 * g + li) * DM + 64 * kb;
            tr_item64(W, IN_W, 64 * kb, AIN(I_MIXN) + l * DM, sc + li, li < nv, dst); continue;
        }
        r -= I_IN;
        if (r < I_O) {
            if (!(sel & 32)) continue;
            const int G2 = r >> 4, kb = r & 15;
            bf16* dst = (bf16*)(ws + W_O) + (size_t)(64 * G2 + lane) * DM + 64 * kb;
            tr_item64(AIN(I_WO) + (size_t)l * DM * DM, DM, 64 * kb, nullptr, 64 * G2 + lane, true, dst); continue;
        }
        r -= I_O;
        if (r < I_QU) {
            if (!(sel & 64)) continue;
            const int G2 = r >> 2, kb = r & 3, g = 2 * G2 + lg; const int pn = g >> 3, gi = g & 7, bj = gi >> 2, wc = gi & 3, head = pn * 2 + (wc >> 1);
            const int sc = (wc & 1) ? head * 96 + 64 + 16 * bj : head * 96 + 32 * bj, nv = (wc & 1) ? 16 : 32;
            bf16* dst = (bf16*)(ws + W_QU) + (size_t)(32 * g + li) * 256 + 64 * kb;
            tr_item64(AIN(I_MQU) + (size_t)l * 256 * 576, 576, 64 * kb, AIN(I_MQN) + l * 256, sc + li, li < nv, dst); continue;
        }
        r -= I_QU;
        {
            if (!(sel & 128)) continue;
            const int G2 = r >> 2, kb = r & 3, g = 2 * G2 + lg; const int pn = g >> 3, gi = g & 7, bj = gi >> 2, wc = gi & 3, head = pn * 2 + (wc >> 1);
            const int sc = head * 128 + ((wc & 1) ? 64 : 0) + 32 * bj;
            bf16* dst = (bf16*)(ws + W_KVU) + (size_t)(32 * g + li) * 256 + 64 * kb;
            if (kb < 2) tr_item64(AIN(I_MKVU), 768, 0, nullptr, 0, false, dst);
            else tr_item64(AIN(I_MKVU) + (size_t)l * 128 * 768, 768, 64 * (kb - 2), AIN(I_MKVN) + l * 128, sc + li, true, dst);
        }
    }
}

__device__ __forceinline__ int t5_bucket(int rel) {
    const int n = rel < 0 ? -rel : rel;
    const float nf = (float)(n > 1 ? n : 1);
    int large = 8 + (int)(logf(nf / 8.0f) / 4.852030263919617f * 8.0f);
    large = large < 15 ? large : 15;
    return (rel > 0 ? 16 : 0) + (n < 8 ? n : large);
}

__device__ __forceinline__ void prologue_misc(volatile LAS unsigned long long* PT, unsigned char* ws, int gw, int NGW, int lane, int gtid, int NGT) {
    float* tab = (float*)(ws + WS_TAB);
    for (int i = gtid; i < SEQ * 16; i += NGT) { const int s = i >> 4, j = i & 15; const double inv = pow(10000.0, -(double)j / 16.0), ang = (double)s * inv; tab[TAB_COS + i] = (float)cos(ang); tab[TAB_SIN + i] = (float)sin(ang); }
    for (int l = 0; l < DEPTH; ++l) {
        const float* relb = AIN(I_RELB);
        float mbd = 0.f, mbl = 0.f;
        for (int i = lane; i < 320; i += 64) { const float v = fabsf(relb[i]); if ((i % 10) < 4) mbd = fmaxf(mbd, v); else mbl = fmaxf(mbl, v); }
        mbd = wave_max(mbd); mbl = wave_max(mbl);
        float gq = (lane < 32) ? fabsf(AIN(I_DQN)[l * 32 + lane]) : 0.f, gk = (lane < 32) ? fabsf(AIN(I_DKN)[l * 32 + lane]) : 0.f;
        gq = wave_max(gq); gk = wave_max(gk);
        const float B2d = (5.656854249f * gq * gk + mbd) * LOG2E;
        float lq = fabsf(AIN(I_LQN)[l * 64 + lane]), lk = fabsf(AIN(I_LKN)[l * 64 + lane]);
        lq = wave_max(lq); lk = wave_max(lk);
        const float B2l = (8.0f * lq * lk + mbl) * LOG2E;
        float mq = fmaxf(fabsf(AIN(I_MQNG)[l * 96 + lane]), lane < 32 ? fabsf(AIN(I_MQNG)[l * 96 + 64 + lane]) : 0.f);
        float mk = fmaxf(fabsf(AIN(I_MKNG)[l * 96 + lane]), lane < 32 ? fabsf(AIN(I_MKNG)[l * 96 + 64 + lane]) : 0.f);
        mq = wave_max(mq); mk = wave_max(mk);
        const float B2c = 9.797958971f * mq * mk * LOG2E;
        for (int i = gtid; i < 10 * 4096; i += NGT) {
            const int h = i >> 12, idx = i & 4095, rel = idx - 2048; const int bk = t5_bucket(rel);
            if (h < 4) tab[TAB_BD + (l * 4 + h) * 4096 + idx] = relb[bk * 10 + h] * LOG2E - B2d;
            else tab[TAB_BL + (l * 6 + (h - 4)) * 4096 + idx] = relb[bk * 10 + h] * LOG2E - B2l;
        }
        if (gw == 0) {
            const float* lp = AIN(I_DLAM) + l * 128;
            float s1 = (lane < 32) ? lp[lane] * lp[32 + lane] : 0.f, s2 = (lane < 32) ? lp[64 + lane] * lp[96 + lane] : 0.f;
            s1 = wave_sum(s1); s2 = wave_sum(s2);
            const float linit = 0.8f - 0.6f * expf(-0.3f * (float)(l + 1));
            if (lane == 0) { tab[TAB_SC + l * 8 + 0] = expf(s1) - expf(s2) + linit; tab[TAB_SC + l * 8 + 1] = 1.0f - linit; tab[TAB_SC + l * 8 + 2] = -B2c; }
        }
    }
    float* P0 = (float*)(ws + WS_P);
    const float* xin = AIN(I_X);
    for (int m0 = gw * 4; m0 < MTOK; m0 += NGW * 4) {
        f32x4 v[4][4];
#pragma unroll
        for (int r = 0; r < 4; ++r)
#pragma unroll
            for (int j = 0; j < 4; ++j) v[r][j] = __builtin_nontemporal_load(((const GAS f32x4*)(xin + (size_t)(m0 + r) * DM) + lane) + 64 * j);
#pragma unroll
        for (int r = 0; r < 4; ++r) {
            GAS unsigned long long* o8 = (GAS unsigned long long*)((bf16*)(ws + WS_XB) + (size_t)(m0 + r) * DM) + lane;
            float s = 0.f;
#pragma unroll
            for (int j = 0; j < 4; ++j) { const f32x4 w = v[r][j]; s += (w.x * w.x + w.y * w.y) + (w.z * w.z + w.w * w.w);
                __builtin_nontemporal_store((unsigned long long)pk2(w.x, w.y) | ((unsigned long long)pk2(w.z, w.w) << 32), o8 + 64 * j); }
            s = wave_sum(s);
            if (lane < 16) P0[(size_t)(m0 + r) * 16 + lane] = lane == 0 ? s : 0.f;
        }
    }
}

namespace att {
typedef short bf16x8 __attribute__((ext_vector_type(8)));
typedef short s16x4 __attribute__((ext_vector_type(4)));
typedef short v4i16_t __attribute__((ext_vector_type(4)));
typedef float f32x16 __attribute__((ext_vector_type(16)));
typedef unsigned u32x4 __attribute__((ext_vector_type(4)));
typedef __attribute__((address_space(3))) const char* lds_cptr;
typedef __attribute__((address_space(3))) char* lds_ptr;
typedef float f32x2_t __attribute__((ext_vector_type(2))); typedef __bf16 bf16x2_t __attribute__((ext_vector_type(2)));
__device__ __forceinline__ int crow(int r, int hi) { return (r & 3) + 8 * (r >> 2) + 4 * hi; }
__device__ __forceinline__ void glds16(const void* gsrc, unsigned lds_dst) { unsigned keep;
    asm volatile("s_mov_b32 %0, m0\n\ts_mov_b32 m0, %2\n\ts_nop 0\n\tglobal_load_lds_dwordx4 %1, off\n\ts_mov_b32 m0, %0" : "=&s"(keep) : "v"(gsrc), "s"(lds_dst) : "memory"); }
__device__ __forceinline__ unsigned cvtpk_s(float lo, float hi) { f32x2_t v = {lo, hi}; bf16x2_t b = __builtin_convertvector(v, bf16x2_t); return __builtin_bit_cast(unsigned, b); }
__device__ __forceinline__ s16x4 vtr(lds_cptr p) { return __builtin_bit_cast(s16x4, __builtin_amdgcn_ds_read_tr16_b64_v4i16((__attribute__((address_space(3))) v4i16_t*)p)); }
#define ATT_WAIT_BAR(N) asm volatile("s_waitcnt vmcnt(" #N ") lgkmcnt(0)\n\ts_barrier" ::: "memory")
#define ATT_BAR() asm volatile("s_waitcnt lgkmcnt(0)\n\ts_barrier" ::: "memory")

__device__ __forceinline__ void pack_p(const f32x16& p0, const f32x16& p1, bf16x8 (&pa)[4]) {
    u32x4 w;
    w = (u32x4){cvtpk_s(p0[0], p0[1]), cvtpk_s(p0[2], p0[3]), cvtpk_s(p0[4], p0[5]), cvtpk_s(p0[6], p0[7])}; pa[0] = __builtin_bit_cast(bf16x8, w);
    w = (u32x4){cvtpk_s(p0[8], p0[9]), cvtpk_s(p0[10], p0[11]), cvtpk_s(p0[12], p0[13]), cvtpk_s(p0[14], p0[15])}; pa[1] = __builtin_bit_cast(bf16x8, w);
    w = (u32x4){cvtpk_s(p1[0], p1[1]), cvtpk_s(p1[2], p1[3]), cvtpk_s(p1[4], p1[5]), cvtpk_s(p1[6], p1[7])}; pa[2] = __builtin_bit_cast(bf16x8, w);
    w = (u32x4){cvtpk_s(p1[8], p1[9]), cvtpk_s(p1[10], p1[11]), cvtpk_s(p1[12], p1[13]), cvtpk_s(p1[14], p1[15])}; pa[3] = __builtin_bit_cast(bf16x8, w);
}
__device__ __forceinline__ void pv64(f32x16& o0, f32x16& o1, lds_cptr vp, const bf16x8 (&pa)[4]) {
#pragma unroll
    for (int ks = 0; ks < 4; ++ks) {
        const s16x4 a = vtr(vp + ks * 1024), b = vtr(vp + ks * 1024 + 512);
        const bf16x8 v = {a[0], a[1], a[2], a[3], b[0], b[1], b[2], b[3]};
        o0 = __builtin_amdgcn_mfma_f32_32x32x16_bf16(pa[ks], v, o0, 0, 0, 0);
    }
#pragma unroll
    for (int ks = 0; ks < 4; ++ks) {
        const s16x4 a = vtr(vp + 4096 + ks * 1024), b = vtr(vp + 4096 + ks * 1024 + 512);
        const bf16x8 v = {a[0], a[1], a[2], a[3], b[0], b[1], b[2], b[3]};
        o1 = __builtin_amdgcn_mfma_f32_32x32x16_bf16(pa[ks], v, o1, 0, 0, 0);
    }
}
__device__ __forceinline__ void pv32(f32x16& o0, f32x16& o1, lds_cptr vp, const bf16x8& pa0, const bf16x8& pa1) {
#pragma unroll
    for (int d0 = 0; d0 < 2; ++d0) {
        const s16x4 a = vtr(vp + d0 * 4096), b = vtr(vp + d0 * 4096 + 512), c = vtr(vp + d0 * 4096 + 1024), d = vtr(vp + d0 * 4096 + 1536);
        const bf16x8 v0 = {a[0], a[1], a[2], a[3], b[0], b[1], b[2], b[3]}, v1 = {c[0], c[1], c[2], c[3], d[0], d[1], d[2], d[3]};
        if (d0 == 0) { o0 = __builtin_amdgcn_mfma_f32_32x32x16_bf16(pa0, v0, o0, 0, 0, 0); o0 = __builtin_amdgcn_mfma_f32_32x32x16_bf16(pa1, v1, o0, 0, 0, 0); }
        else { o1 = __builtin_amdgcn_mfma_f32_32x32x16_bf16(pa0, v0, o1, 0, 0, 0); o1 = __builtin_amdgcn_mfma_f32_32x32x16_bf16(pa1, v1, o1, 0, 0, 0); }
    }
}
__device__ __forceinline__ float exp_sum1(f32x16& p) {
    float s0 = 0.f, s1 = 0.f;
#pragma unroll
    for (int r = 0; r < 16; r += 2) { p[r] = __builtin_amdgcn_exp2f(p[r]); p[r + 1] = __builtin_amdgcn_exp2f(p[r + 1]); s0 += p[r]; s1 += p[r + 1]; }
    return s0 + s1;
}
__device__ __forceinline__ void pack_p1(const f32x16& p, bf16x8& pa0, bf16x8& pa1) {
    u32x4 w;
    w = (u32x4){cvtpk_s(p[0], p[1]), cvtpk_s(p[2], p[3]), cvtpk_s(p[4], p[5]), cvtpk_s(p[6], p[7])}; pa0 = __builtin_bit_cast(bf16x8, w);
    w = (u32x4){cvtpk_s(p[8], p[9]), cvtpk_s(p[10], p[11]), cvtpk_s(p[12], p[13]), cvtpk_s(p[14], p[15])}; pa1 = __builtin_bit_cast(bf16x8, w);
}
__device__ __forceinline__ float exp_sum(f32x16& p0, f32x16& p1) {
    float s0 = 0.f, s1 = 0.f;
#pragma unroll
    for (int r = 0; r < 16; ++r) { p0[r] = __builtin_amdgcn_exp2f(p0[r]); p1[r] = __builtin_amdgcn_exp2f(p1[r]); s0 += p0[r]; s1 += p1[r]; }
    return s0 + s1;
}
__device__ __forceinline__ float half_swap_sum(float v) {
    return sum_x32(v);
}

constexpr int DN_RING = 40960, DN_BUF = 20480, DN_TAB = 81920, DN_WSF = 98304, DN_OST = 100352;
constexpr int ML_RING = 61440, ML_WSF = 122880, ML_OST = 124928;

template <bool NT = false> __device__ __forceinline__ void store_o64(const f32x16& o0, const f32x16& o1, const float (&sc)[16], lds_ptr stg, bf16* orow0, int pitch, int lane) {
    asm volatile("" : "+v"(lane));
    const int r32 = lane & 31, hi = lane >> 5;
    __attribute__((address_space(3))) unsigned short* s = (__attribute__((address_space(3))) unsigned short*)stg;
#pragma unroll
    for (int r = 0; r < 16; ++r) { const int orow = crow(r, hi);
        s[orow * 64 + r32] = (unsigned short)f2bf(o0[r] * sc[r]); s[orow * 64 + 32 + r32] = (unsigned short)f2bf(o1[r] * sc[r]); }
    asm volatile("s_waitcnt lgkmcnt(0)" ::: "memory");
#pragma unroll
    for (int i = 0; i < 4; ++i) { const int row = i * 8 + (lane >> 3), ch = lane & 7;
        const u32x4 v = *(const __attribute__((address_space(3))) u32x4*)(stg + row * 128 + ch * 16); if (NT) __builtin_nontemporal_store(v, (GAS u32x4*)(orow0 + (size_t)row * pitch + ch * 8)); else *(GAS u32x4*)(orow0 + (size_t)row * pitch + ch * 8) = v; }
}

__device__ __forceinline__ void mla_unit(const unsigned char* ws, const int tid, int l, int u, char* shm) {
    const int lane = tid & 63, r32 = lane & 31, hi = lane >> 5, wid = __builtin_amdgcn_readfirstlane(tid >> 6), w4 = wid & 3, g = wid >> 2;
    PROBE_T0(pt5_);
    const int bh = u >> 4, q0 = (u & 15) * 128 + w4 * 32;
    const bf16* Qb = (const bf16*)(ws + WS_QC) + ((size_t)bh * SEQ + q0) * 96;
    const bf16* Kb = (const bf16*)(ws + WS_KC) + ((size_t)bh * SEQ + g * 1024) * 96;
    const bf16* Vb = (const bf16*)(ws + WS_VC) + ((size_t)bh * SEQ + g * 1024) * 64;
    const float nb2 = ((const float*)(ws + WS_TAB))[TAB_SC + l * 8 + 2];
    const unsigned lds0 = (unsigned)(uintptr_t)shm; const lds_cptr shm3 = (lds_cptr)shm;
    const unsigned ring = lds0 + g * ML_RING;
    int koffs[3];
#pragma unroll
    for (int i = 0; i < 3; ++i) { const int idx = 64 * (w4 + 4 * i) + lane, row = idx / 12, slot = idx - 12 * row; koffs[i] = row * 96 + ((slot & ~3) | ((slot & 3) ^ ((row >> 2) & 3))) * 8; }
    const bf16* vsrc = Vb + (size_t)(16 * w4 + (lane >> 2)) * 64 + (lane & 3) * 8;
#define MLA_DMA_K(t, buf) do { const unsigned d_ = (unsigned)__builtin_amdgcn_readfirstlane(ring + (buf) * DN_BUF + w4 * 1024); \
        const bf16* kt_ = Kb + (size_t)(t) * 64 * 96; glds16(kt_ + koffs[0], d_); glds16(kt_ + koffs[1], d_ + 4096); glds16(kt_ + koffs[2], d_ + 8192); } while (0)
#define MLA_DMA_V(t, buf) do { const unsigned d_ = (unsigned)__builtin_amdgcn_readfirstlane(ring + (buf) * DN_BUF + w4 * 1024); \
        glds16(vsrc + (size_t)(t) * 64 * 64, d_ + 12288); glds16(vsrc + (size_t)(t) * 64 * 64 + 32, d_ + 12288 + 4096); } while (0)
    MLA_DMA_K(0, 0); MLA_DMA_K(1, 1); MLA_DMA_V(0, 0);
    bf16x8 qr[6];
#pragma unroll
    for (int d0 = 0; d0 < 6; ++d0) qr[d0] = *(const GAS bf16x8*)(Qb + (size_t)r32 * 96 + d0 * 16 + hi * 8);
    asm volatile("" : "+v"(qr[0]), "+v"(qr[1]), "+v"(qr[2]), "+v"(qr[3]), "+v"(qr[4]), "+v"(qr[5]));
    f32x16 o0 = {}, o1 = {}; float lsum = 0.f;
    const int kx = (r32 >> 2) & 3;
    const lds_cptr kpe0 = shm3 + g * ML_RING + r32 * 192 + ((hi ^ kx) << 4), kpe1 = shm3 + g * ML_RING + r32 * 192 + (((2 + hi) ^ kx) << 4);
    const lds_cptr vp0 = shm3 + g * ML_RING + 12288 + ((lane >> 4) & 1) * 32 + (lane & 3) * 8 + (4 * hi + ((lane & 15) >> 2)) * 64;
#define MLA_QK(P0, P1, buf) do { \
        _Pragma("unroll") for (int r = 0; r < 16; ++r) { P0[r] = nb2; P1[r] = nb2; } \
        _Pragma("unroll") for (int d0 = 0; d0 < 6; ++d0) { const lds_cptr kp = ((d0 & 1) ? kpe1 : kpe0) + (buf) * DN_BUF + (d0 >> 1) * 64; \
            const bf16x8 a0 = *(const __attribute__((address_space(3))) bf16x8*)(kp), a1 = *(const __attribute__((address_space(3))) bf16x8*)(kp + 6144); \
            P0 = __builtin_amdgcn_mfma_f32_32x32x16_bf16(a0, qr[d0], P0, 0, 0, 0); P1 = __builtin_amdgcn_mfma_f32_32x32x16_bf16(a1, qr[d0], P1, 0, 0, 0); } } while (0)
#define MLA_SMPV(P0, P1, buf) do { lsum += exp_sum(P0, P1); bf16x8 pa[4]; pack_p(P0, P1, pa); pv64(o0, o1, vp0 + (buf) * DN_BUF, pa); } while (0)
    {
        f32x16 p0, p1;
        ATT_WAIT_BAR(5);
        MLA_DMA_K(2, 2); MLA_DMA_V(1, 1);
        MLA_QK(p0, p1, 0);
        int bk = 1, bk2 = 0, bv = 0, bv1 = 2;
        for (int t = 1; t < 16; ++t) {
#if MK_PROBE == 10 || MK_PROBE == 11
            { PROBE_T0(pta_); asm volatile("s_waitcnt vmcnt(5) lgkmcnt(0)" ::: "memory"); PROBE_ADD(10, pta_, shm3); PROBE_T0(ptb_); asm volatile("s_barrier" ::: "memory"); PROBE_ADD(11, ptb_, shm3); }
#else
            { PROBE_T0(pt6_); ATT_WAIT_BAR(5); PROBE_ADD(6, pt6_, shm3); }
#endif
            { const int kn = t + 2 < 16 ? t + 2 : 15, vn = t + 1 < 16 ? t + 1 : 15; MLA_DMA_K(kn, bk2); MLA_DMA_V(vn, bv1); }
            MLA_SMPV(p0, p1, bv);
            MLA_QK(p0, p1, bk);
            bk = bk == 2 ? 0 : bk + 1; bk2 = bk2 == 2 ? 0 : bk2 + 1; bv = bv == 2 ? 0 : bv + 1; bv1 = bv1 == 2 ? 0 : bv1 + 1;
        }
        ATT_WAIT_BAR(0);
        MLA_SMPV(p0, p1, bv);
    }
    ATT_WAIT_BAR(0);
    PROBE_T0(pt7_);
#undef MLA_QK
#undef MLA_SMPV
#undef MLA_DMA_K
#undef MLA_DMA_V
#define MLA_DMA(t, buf) do {} while (0)
#undef MLA_DMA
    int lane_t = lane; asm volatile("" : "+v"(lane_t));
    const int r32t = lane_t & 31, hit = lane_t >> 5;
    __attribute__((address_space(3))) float* Cs = (__attribute__((address_space(3))) float*)shm3;
    if (g == 1) {
#pragma unroll
        for (int r = 0; r < 16; ++r) { Cs[(w4 * 33 + r) * 64 + lane_t] = o0[r]; Cs[(w4 * 33 + 16 + r) * 64 + lane_t] = o1[r]; }
        Cs[(w4 * 33 + 32) * 64 + lane_t] = lsum;
    }
    ATT_BAR();
    if (g == 0) {
#pragma unroll
        for (int r = 0; r < 16; ++r) { o0[r] += Cs[(w4 * 33 + r) * 64 + lane_t]; o1[r] += Cs[(w4 * 33 + 16 + r) * 64 + lane_t]; }
        lsum += Cs[(w4 * 33 + 32) * 64 + lane_t];
        lsum = half_swap_sum(lsum);
        __attribute__((address_space(3))) float* wsf = (__attribute__((address_space(3))) float*)(shm3 + ML_WSF) + wid * 64;
        if (hit == 0) wsf[r32t] = __builtin_amdgcn_rcpf(lsum);
        asm volatile("s_waitcnt lgkmcnt(0)" ::: "memory");
        float sc[16];
#pragma unroll
        for (int r = 0; r < 16; ++r) sc[r] = wsf[crow(r, hit)];
        const int b = bh / 6, h = bh - b * 6;
        store_o64(o0, o1, sc, (lds_ptr)(shm3 + ML_OST + w4 * 4096), (bf16*)(ws + WS_MIX) + ((size_t)(b * SEQ + q0)) * DM + 640 + h * 64, DM, lane_t);
    }
    ATT_BAR();
    PROBE_ADD(7, pt7_, shm3); PROBE_ADD(5, pt5_, shm3);
}

__device__ __forceinline__ void mla_unit256(const unsigned char* ws, const int tid, int l, int bh, int qb, char* shm) {
    const int lane = tid & 63, r32 = lane & 31, hi = lane >> 5, wid = __builtin_amdgcn_readfirstlane(tid >> 6), w4 = wid & 3, g = wid >> 2;
    const int q0 = qb + wid * 32;
    const bf16* Qb = (const bf16*)(ws + WS_QC) + ((size_t)bh * SEQ + q0) * 96;
    const bf16* Kb = (const bf16*)(ws + WS_KC) + ((size_t)bh * SEQ + g * 1024) * 96;
    const bf16* Vb = (const bf16*)(ws + WS_VC) + ((size_t)bh * SEQ + g * 1024) * 64;
    const float nb2 = ((const float*)(ws + WS_TAB))[TAB_SC + l * 8 + 2];
    const unsigned lds0 = (unsigned)(uintptr_t)shm; const lds_cptr shm3 = (lds_cptr)shm;
    const unsigned ring = lds0 + g * ML_RING;
    int koffs[3];
#pragma unroll
    for (int i = 0; i < 3; ++i) { const int idx = 64 * (w4 + 4 * i) + lane, row = idx / 12, slot = idx - 12 * row; koffs[i] = row * 96 + ((slot & ~3) | ((slot & 3) ^ ((row >> 2) & 3))) * 8; }
    const bf16* vsrc = Vb + (size_t)(16 * w4 + (lane >> 2)) * 64 + (lane & 3) * 8;
#define MLA_DMA_K(t, buf) do { const unsigned d_ = (unsigned)__builtin_amdgcn_readfirstlane(ring + (buf) * DN_BUF + w4 * 1024); \
        const bf16* kt_ = Kb + (size_t)(t) * 64 * 96; glds16(kt_ + koffs[0], d_); glds16(kt_ + koffs[1], d_ + 4096); glds16(kt_ + koffs[2], d_ + 8192); } while (0)
#define MLA_DMA_V(t, buf) do { const unsigned d_ = (unsigned)__builtin_amdgcn_readfirstlane(ring + (buf) * DN_BUF + w4 * 1024); \
        glds16(vsrc + (size_t)(t) * 64 * 64, d_ + 12288); glds16(vsrc + (size_t)(t) * 64 * 64 + 32, d_ + 12288 + 4096); } while (0)
    MLA_DMA_K(0, 0); MLA_DMA_K(1, 1); MLA_DMA_V(0, 0);
    bf16x8 qr[6];
#pragma unroll
    for (int d0 = 0; d0 < 6; ++d0) qr[d0] = *(const GAS bf16x8*)(Qb + (size_t)r32 * 96 + d0 * 16 + hi * 8);
    asm volatile("" : "+v"(qr[0]), "+v"(qr[1]), "+v"(qr[2]), "+v"(qr[3]), "+v"(qr[4]), "+v"(qr[5]));
    f32x16 o0 = {}, o1 = {}; float lsum = 0.f;
    const int kx = (r32 >> 2) & 3;
    const lds_cptr kpe0 = shm3 + r32 * 192 + ((hi ^ kx) << 4), kpe1 = shm3 + r32 * 192 + (((2 + hi) ^ kx) << 4);
    const lds_cptr vp0 = shm3 + 12288 + ((lane >> 4) & 1) * 32 + (lane & 3) * 8 + (4 * hi + ((lane & 15) >> 2)) * 64;
#define MLA_QK(P0, P1, buf, gg) do { \
        _Pragma("unroll") for (int r = 0; r < 16; ++r) { P0[r] = nb2; P1[r] = nb2; } \
        _Pragma("unroll") for (int d0 = 0; d0 < 6; ++d0) { const lds_cptr kp = ((d0 & 1) ? kpe1 : kpe0) + (gg) * ML_RING + (buf) * DN_BUF + (d0 >> 1) * 64; \
            const bf16x8 a0 = *(const __attribute__((address_space(3))) bf16x8*)(kp), a1 = *(const __attribute__((address_space(3))) bf16x8*)(kp + 6144); \
            P0 = __builtin_amdgcn_mfma_f32_32x32x16_bf16(a0, qr[d0], P0, 0, 0, 0); P1 = __builtin_amdgcn_mfma_f32_32x32x16_bf16(a1, qr[d0], P1, 0, 0, 0); } } while (0)
#define MLA_SMPV(P0, P1, buf, gg) do { lsum += exp_sum(P0, P1); bf16x8 pa[4]; pack_p(P0, P1, pa); pv64(o0, o1, vp0 + (gg) * ML_RING + (buf) * DN_BUF, pa); } while (0)
    {
        f32x16 p0, p1, r0, r1;
        ATT_WAIT_BAR(5);
        MLA_DMA_K(2, 2); MLA_DMA_V(1, 1);
        MLA_QK(p0, p1, 0, 0); MLA_QK(r0, r1, 0, 1);
        int bk = 1, bk2 = 0, bv = 0, bv1 = 2;
        for (int t = 1; t < 16; ++t) {
            ATT_WAIT_BAR(5);
            { const int kn = t + 2 < 16 ? t + 2 : 15, vn = t + 1 < 16 ? t + 1 : 15; MLA_DMA_K(kn, bk2); MLA_DMA_V(vn, bv1); }
            MLA_SMPV(p0, p1, bv, 0); MLA_QK(p0, p1, bk, 0);
            MLA_SMPV(r0, r1, bv, 1); MLA_QK(r0, r1, bk, 1);
            bk = bk == 2 ? 0 : bk + 1; bk2 = bk2 == 2 ? 0 : bk2 + 1; bv = bv == 2 ? 0 : bv + 1; bv1 = bv1 == 2 ? 0 : bv1 + 1;
        }
        ATT_WAIT_BAR(0);
        MLA_SMPV(p0, p1, bv, 0); MLA_SMPV(r0, r1, bv, 1);
    }
    ATT_WAIT_BAR(0);
#undef MLA_QK
#undef MLA_SMPV
#undef MLA_DMA_K
#undef MLA_DMA_V
#define MLA_DMA(t, buf) do {} while (0)
#undef MLA_DMA
    int lane_t = lane; asm volatile("" : "+v"(lane_t));
    const int r32t = lane_t & 31, hit = lane_t >> 5;
    {
        lsum = half_swap_sum(lsum);
        __attribute__((address_space(3))) float* wsf = (__attribute__((address_space(3))) float*)(shm3 + ML_WSF) + wid * 64;
        if (hit == 0) wsf[r32t] = __builtin_amdgcn_rcpf(lsum);
        asm volatile("s_waitcnt lgkmcnt(0)" ::: "memory");
        float sc[16];
#pragma unroll
        for (int r = 0; r < 16; ++r) sc[r] = wsf[crow(r, hit)];
        const int b = bh / 6, h = bh - b * 6;
        store_o64(o0, o1, sc, (lds_ptr)(shm3 + wid * 4096), (bf16*)(ws + WS_MIX) + ((size_t)(b * SEQ + q0)) * DM + 640 + h * 64, DM, lane_t);
    }
    ATT_BAR();
}

__device__ __forceinline__ void diff_unit(const unsigned char* ws, const float* sub, const int tid, int l, int u, char* shm) {
    const int lane = tid & 63, r32 = lane & 31, hi = lane >> 5, wid = __builtin_amdgcn_readfirstlane(tid >> 6), w4 = wid & 3, g = wid >> 2;
    PROBE_T0(pt8_);
    const int bh = u >> 4, q0 = (u & 15) * 128 + w4 * 32, b = bh >> 2, h = bh & 3;
    const bf16* Q0 = (const bf16*)(ws + WS_QD) + ((size_t)(bh * 2) * SEQ + q0) * 32;
    const bf16* K0 = (const bf16*)(ws + WS_KD) + ((size_t)(bh * 2) * SEQ + g * 1024) * 32;
    const bf16* Vb = (const bf16*)(ws + WS_VD) + ((size_t)bh * SEQ + g * 1024) * 64;
    const float* tabg = (const float*)(ws + WS_TAB) + TAB_BD + (l * 4 + h) * 4096;
    const unsigned lds0 = (unsigned)(uintptr_t)shm; const lds_cptr shm3 = (lds_cptr)shm;
    const unsigned ring = lds0 + g * DN_RING;
    const bf16* ksrc = K0 + (size_t)(16 * w4 + (lane >> 2)) * 32 + (((lane & 3) ^ ((lane >> 4) & 3)) * 8);
    const bf16* vsrc = Vb + (size_t)(16 * w4 + (lane >> 2)) * 64 + (lane & 3) * 8;
#define DIFF_KOFF(t) (((t) & 1) * 8192)
#define DIFF_VOFF(t) (16384 + ((t) % 3) * 8192)
#define DIFF_DMA_K(t) do { const unsigned d_ = (unsigned)__builtin_amdgcn_readfirstlane(ring + DIFF_KOFF(t) + w4 * 1024); \
        glds16(ksrc + (size_t)(t) * 64 * 32, d_); glds16(ksrc + (size_t)SEQ * 32 + (size_t)(t) * 64 * 32, d_ + 4096); } while (0)
#define DIFF_DMA_V(t) do { const unsigned d_ = (unsigned)__builtin_amdgcn_readfirstlane(ring + DIFF_VOFF(t) + w4 * 1024); \
        glds16(vsrc + (size_t)(t) * 64 * 64, d_); glds16(vsrc + (size_t)(t) * 64 * 64 + 32, d_ + 4096); } while (0)
    DIFF_DMA_K(0); DIFF_DMA_V(0);
    { __attribute__((address_space(3))) float* tl = (__attribute__((address_space(3))) float*)(shm3 + DN_TAB);
#pragma unroll
      for (int i = 0; i < 2; ++i) { const f32x4 v = *(const GAS f32x4*)(tabg + (i * 512 + tid) * 4); *(__attribute__((address_space(3))) f32x4*)(tl + (i * 512 + tid) * 4) = v; } }
    bf16x8 qr[2][2];
#pragma unroll
    for (int c = 0; c < 2; ++c)
#pragma unroll
        for (int d0 = 0; d0 < 2; ++d0) qr[c][d0] = *(const GAS bf16x8*)(Q0 + (size_t)c * SEQ * 32 + (size_t)r32 * 32 + d0 * 16 + hi * 8);
    asm volatile("" : "+v"(qr[0][0]), "+v"(qr[0][1]), "+v"(qr[1][0]), "+v"(qr[1][1]));
    f32x16 oa0 = {}, oa1 = {}, ob0 = {}, ob1 = {}; float lsa = 0.f, lsb = 0.f;
    const int kx = (r32 >> 2) & 3;
    const lds_cptr kpe0 = shm3 + g * DN_RING + r32 * 64 + ((hi ^ kx) << 4), kpe1 = shm3 + g * DN_RING + r32 * 64 + (((2 + hi) ^ kx) << 4);
    const lds_cptr vp0 = shm3 + g * DN_RING + ((lane >> 4) & 1) * 32 + (lane & 3) * 8 + (4 * hi + ((lane & 15) >> 2)) * 64;
    const __attribute__((address_space(3))) float* tb0 = (const __attribute__((address_space(3))) float*)(shm3 + DN_TAB) + (2048 + g * 1024 - q0 + 4 * hi - r32);
#define DIFF_QK(S0, S1, t, blk) do { const __attribute__((address_space(3))) float* tb = tb0 + (t) * 64 + (blk) * 32; int koff_ = __builtin_amdgcn_readfirstlane(DIFF_KOFF(t) + (blk) * 2048); asm volatile("" : "+s"(koff_)); \
        _Pragma("unroll") for (int r = 0; r < 16; ++r) { S0[r] = tb[(r & 3) + 8 * (r >> 2)]; S1[r] = S0[r]; } \
        _Pragma("unroll") for (int d0 = 0; d0 < 2; ++d0) { \
            const lds_cptr kp = (d0 ? kpe1 : kpe0) + koff_; const bf16x8 a0 = *(const __attribute__((address_space(3))) bf16x8*)(kp), a1 = *(const __attribute__((address_space(3))) bf16x8*)(kp + 4096); \
            S0 = __builtin_amdgcn_mfma_f32_32x32x16_bf16(a0, qr[0][d0], S0, 0, 0, 0); S1 = __builtin_amdgcn_mfma_f32_32x32x16_bf16(a1, qr[1][d0], S1, 0, 0, 0); } __builtin_amdgcn_sched_barrier(0); } while (0)
#define DIFF_SMPV(S0, S1, t, blk) do { int voff_ = __builtin_amdgcn_readfirstlane(DIFF_VOFF(t) + (blk) * 2048); asm volatile("" : "+s"(voff_)); const lds_cptr vpb = vp0 + voff_; bf16x8 pa0, pa1; \
        lsa += exp_sum1(S0); pack_p1(S0, pa0, pa1); pv32(oa0, oa1, vpb, pa0, pa1); \
        __builtin_amdgcn_sched_barrier(0); lsb += exp_sum1(S1); pack_p1(S1, pa0, pa1); pv32(ob0, ob1, vpb, pa0, pa1); __builtin_amdgcn_sched_barrier(0); } while (0)
    {
        f32x16 s0, s1, u0, u1;
        ATT_WAIT_BAR(0);
        DIFF_DMA_K(1); DIFF_DMA_V(1);
        DIFF_QK(s0, s1, 0, 0); DIFF_SMPV(s0, s1, 0, 0); DIFF_QK(u0, u1, 0, 1);
        for (int t = 1; t < 16; ++t) {
            { PROBE_T0(pt9_); ATT_WAIT_BAR(0); PROBE_ADD(9, pt9_, shm3); }
            if (t + 1 < 16) { DIFF_DMA_K(t + 1); DIFF_DMA_V(t + 1); }
            DIFF_SMPV(u0, u1, t - 1, 1); DIFF_QK(s0, s1, t, 0);
            DIFF_SMPV(s0, s1, t, 0); DIFF_QK(u0, u1, t, 1);
        }
        ATT_WAIT_BAR(0);
        DIFF_SMPV(u0, u1, 15, 1);
    }
    ATT_WAIT_BAR(0);
#undef DIFF_QK
#undef DIFF_SMPV
#undef DIFF_DMA_K
#undef DIFF_DMA_V
#undef DIFF_KOFF
#undef DIFF_VOFF
#define DIFF_DMA(t, buf) do {} while (0)
#undef DIFF_DMA
    int lane_t = lane; asm volatile("" : "+v"(lane_t));
    const int r32t = lane_t & 31, hit = lane_t >> 5;
    __attribute__((address_space(3))) float* Cs = (__attribute__((address_space(3))) float*)shm3 + w4 * 66 * 64;
    if (g == 1) {
#pragma unroll
        for (int r = 0; r < 16; ++r) { Cs[r * 64 + lane_t] = oa0[r]; Cs[(16 + r) * 64 + lane_t] = oa1[r]; Cs[(32 + r) * 64 + lane_t] = ob0[r]; Cs[(48 + r) * 64 + lane_t] = ob1[r]; }
        Cs[64 * 64 + lane_t] = lsa; Cs[65 * 64 + lane_t] = lsb;
    }
    ATT_BAR();
    if (g == 0) {
#pragma unroll
        for (int r = 0; r < 16; ++r) { oa0[r] += Cs[r * 64 + lane_t]; oa1[r] += Cs[(16 + r) * 64 + lane_t]; ob0[r] += Cs[(32 + r) * 64 + lane_t]; ob1[r] += Cs[(48 + r) * 64 + lane_t]; }
        lsa += Cs[64 * 64 + lane_t]; lsb += Cs[65 * 64 + lane_t];
        lsa = half_swap_sum(lsa); lsb = half_swap_sum(lsb);
        const float* sc = (const float*)(ws + WS_TAB) + TAB_SC + l * 8; const float lam = sc[0], post = sc[1];
        __attribute__((address_space(3))) float* wsf = (__attribute__((address_space(3))) float*)(shm3 + DN_WSF) + wid * 64;
        if (hit == 0) { wsf[r32t] = __builtin_amdgcn_rcpf(lsa); wsf[32 + r32t] = lam * __builtin_amdgcn_rcpf(lsb); }
        asm volatile("s_waitcnt lgkmcnt(0)" ::: "memory");
        __attribute__((address_space(3))) float* As = Cs;
#pragma unroll
        for (int r = 0; r < 16; ++r) { const int q = crow(r, hit); const float s0 = wsf[q], s1 = wsf[32 + q];
            As[q * 65 + r32t] = oa0[r] * s0 - ob0[r] * s1; As[q * 65 + 32 + r32t] = oa1[r] * s0 - ob1[r] * s1; }
        asm volatile("s_waitcnt lgkmcnt(0)" ::: "memory");
        const int row = lane_t >> 1, hf = lane_t & 1;
        float v[32]; float ss = 0.f;
#pragma unroll
        for (int i = 0; i < 32; ++i) { v[i] = As[row * 65 + hf * 32 + i]; ss += v[i] * v[i]; }
        ss += swz<1>(ss);
        const float rn = __builtin_amdgcn_rsqf(ss * (1.0f / 64.0f) + EPS) * post;
        bf16* dst = (bf16*)(ws + WS_MIX) + ((size_t)(b * SEQ + q0 + row)) * DM + h * 64 + hf * 32;
#pragma unroll
        for (int i = 0; i < 4; ++i) { u32x4 w;
            w.x = cvtpk_s(v[8 * i] * rn * ((const GAS float*)sub)[hf * 32 + 8 * i], v[8 * i + 1] * rn * ((const GAS float*)sub)[hf * 32 + 8 * i + 1]); w.y = cvtpk_s(v[8 * i + 2] * rn * ((const GAS float*)sub)[hf * 32 + 8 * i + 2], v[8 * i + 3] * rn * ((const GAS float*)sub)[hf * 32 + 8 * i + 3]);
            w.z = cvtpk_s(v[8 * i + 4] * rn * ((const GAS float*)sub)[hf * 32 + 8 * i + 4], v[8 * i + 5] * rn * ((const GAS float*)sub)[hf * 32 + 8 * i + 5]); w.w = cvtpk_s(v[8 * i + 6] * rn * ((const GAS float*)sub)[hf * 32 + 8 * i + 6], v[8 * i + 7] * rn * ((const GAS float*)sub)[hf * 32 + 8 * i + 7]);
            *(GAS u32x4*)(dst + 8 * i) = w; }
    }
    ATT_BAR();
    PROBE_ADD(8, pt8_, shm3);
}

__device__ __forceinline__ void diff_unit256(const unsigned char* ws, const float* sub, const int tid, int l, int u, char* shm) {
    const int lane = tid & 63, r32 = lane & 31, hi = lane >> 5, wid = __builtin_amdgcn_readfirstlane(tid >> 6), w4 = wid & 3, g = wid >> 2;
    const int bh = u >> 3, q0 = (u & 7) * 256 + wid * 32, b = bh >> 2, h = bh & 3;
    const bf16* Q0 = (const bf16*)(ws + WS_QD) + ((size_t)(bh * 2) * SEQ + q0) * 32;
    const bf16* K0 = (const bf16*)(ws + WS_KD) + ((size_t)(bh * 2) * SEQ + g * 1024) * 32;
    const bf16* Vb = (const bf16*)(ws + WS_VD) + ((size_t)bh * SEQ + g * 1024) * 64;
    const float* tabg = (const float*)(ws + WS_TAB) + TAB_BD + (l * 4 + h) * 4096;
    const unsigned lds0 = (unsigned)(uintptr_t)shm; const lds_cptr shm3 = (lds_cptr)shm;
    const unsigned ring = lds0 + g * DN_RING;
    const bf16* ksrc = K0 + (size_t)(16 * w4 + (lane >> 2)) * 32 + (((lane & 3) ^ ((lane >> 4) & 3)) * 8);
    const bf16* vsrc = Vb + (size_t)(16 * w4 + (lane >> 2)) * 64 + (lane & 3) * 8;
#define DIFF_KOFF(t) (((t) & 1) * 8192)
#define DIFF_VOFF(t) (16384 + ((t) % 3) * 8192)
#define DIFF_DMA_K(t) do { const unsigned d_ = (unsigned)__builtin_amdgcn_readfirstlane(ring + DIFF_KOFF(t) + w4 * 1024); \
        glds16(ksrc + (size_t)(t) * 64 * 32, d_); glds16(ksrc + (size_t)SEQ * 32 + (size_t)(t) * 64 * 32, d_ + 4096); } while (0)
#define DIFF_DMA_V(t) do { const unsigned d_ = (unsigned)__builtin_amdgcn_readfirstlane(ring + DIFF_VOFF(t) + w4 * 1024); \
        glds16(vsrc + (size_t)(t) * 64 * 64, d_); glds16(vsrc + (size_t)(t) * 64 * 64 + 32, d_ + 4096); } while (0)
    DIFF_DMA_K(0); DIFF_DMA_V(0);
    { __attribute__((address_space(3))) float* tl = (__attribute__((address_space(3))) float*)(shm3 + DN_TAB);
#pragma unroll
      for (int i = 0; i < 2; ++i) { const f32x4 v = *(const GAS f32x4*)(tabg + (i * 512 + tid) * 4); *(__attribute__((address_space(3))) f32x4*)(tl + (i * 512 + tid) * 4) = v; } }
    bf16x8 qr[2][2];
#pragma unroll
    for (int c = 0; c < 2; ++c)
#pragma unroll
        for (int d0 = 0; d0 < 2; ++d0) qr[c][d0] = *(const GAS bf16x8*)(Q0 + (size_t)c * SEQ * 32 + (size_t)r32 * 32 + d0 * 16 + hi * 8);
    asm volatile("" : "+v"(qr[0][0]), "+v"(qr[0][1]), "+v"(qr[1][0]), "+v"(qr[1][1]));
    f32x16 oa0 = {}, oa1 = {}, ob0 = {}, ob1 = {}; float lsa = 0.f, lsb = 0.f;
    const int kx = (r32 >> 2) & 3;
    const lds_cptr kpe0 = shm3 + r32 * 64 + ((hi ^ kx) << 4), kpe1 = shm3 + r32 * 64 + (((2 + hi) ^ kx) << 4);
    const lds_cptr vp0 = shm3 + ((lane >> 4) & 1) * 32 + (lane & 3) * 8 + (4 * hi + ((lane & 15) >> 2)) * 64;
    const __attribute__((address_space(3))) float* tb0 = (const __attribute__((address_space(3))) float*)(shm3 + DN_TAB) + (2048 - q0 + 4 * hi - r32);
#define DIFF_QK(S0, S1, t, blk, gg) do { const __attribute__((address_space(3))) float* tb = tb0 + (gg) * 1024 + (t) * 64 + (blk) * 32; int koff_ = __builtin_amdgcn_readfirstlane((gg) * DN_RING + DIFF_KOFF(t) + (blk) * 2048); asm volatile("" : "+s"(koff_)); \
        _Pragma("unroll") for (int r = 0; r < 16; ++r) { S0[r] = tb[(r & 3) + 8 * (r >> 2)]; S1[r] = S0[r]; } \
        _Pragma("unroll") for (int d0 = 0; d0 < 2; ++d0) { \
            const lds_cptr kp = (d0 ? kpe1 : kpe0) + koff_; const bf16x8 a0 = *(const __attribute__((address_space(3))) bf16x8*)(kp), a1 = *(const __attribute__((address_space(3))) bf16x8*)(kp + 4096); \
            S0 = __builtin_amdgcn_mfma_f32_32x32x16_bf16(a0, qr[0][d0], S0, 0, 0, 0); S1 = __builtin_amdgcn_mfma_f32_32x32x16_bf16(a1, qr[1][d0], S1, 0, 0, 0); } __builtin_amdgcn_sched_barrier(0); } while (0)
#define DIFF_SMPV(S0, S1, t, blk, gg) do { int voff_ = __builtin_amdgcn_readfirstlane((gg) * DN_RING + DIFF_VOFF(t) + (blk) * 2048); asm volatile("" : "+s"(voff_)); const lds_cptr vpb = vp0 + voff_; bf16x8 pa0, pa1; \
        lsa += exp_sum1(S0); pack_p1(S0, pa0, pa1); pv32(oa0, oa1, vpb, pa0, pa1); \
        __builtin_amdgcn_sched_barrier(0); lsb += exp_sum1(S1); pack_p1(S1, pa0, pa1); pv32(ob0, ob1, vpb, pa0, pa1); __builtin_amdgcn_sched_barrier(0); } while (0)
    {
        f32x16 s0, s1, u0, u1;
        for (int t = 0; t < 16; ++t) {
            ATT_WAIT_BAR(0);
            if (t + 1 < 16) { DIFF_DMA_K(t + 1); DIFF_DMA_V(t + 1); }
#pragma unroll 1
            for (int gg = 0; gg < 2; ++gg) {
                if (t | gg) DIFF_SMPV(u0, u1, gg ? t : t - 1, 1, gg ^ 1);
                DIFF_QK(s0, s1, t, 0, gg);
                DIFF_SMPV(s0, s1, t, 0, gg); DIFF_QK(u0, u1, t, 1, gg);
            }
        }
        ATT_WAIT_BAR(0);
        DIFF_SMPV(u0, u1, 15, 1, 1);
    }
    ATT_WAIT_BAR(0);
#undef DIFF_QK
#undef DIFF_SMPV
#undef DIFF_DMA_K
#undef DIFF_DMA_V
#undef DIFF_KOFF
#undef DIFF_VOFF
#define DIFF_DMA(t, buf) do {} while (0)
#undef DIFF_DMA
    int lane_t = lane; asm volatile("" : "+v"(lane_t));
    const int r32t = lane_t & 31, hit = lane_t >> 5;
    __attribute__((address_space(3))) float* Cs = (__attribute__((address_space(3))) float*)shm3 + wid * 32 * 65;
    {
        lsa = half_swap_sum(lsa); lsb = half_swap_sum(lsb);
        const float* sc = (const float*)(ws + WS_TAB) + TAB_SC + l * 8; const float lam = sc[0], post = sc[1];
        __attribute__((address_space(3))) float* wsf = (__attribute__((address_space(3))) float*)(shm3 + DN_WSF) + wid * 64;
        if (hit == 0) { wsf[r32t] = __builtin_amdgcn_rcpf(lsa); wsf[32 + r32t] = lam * __builtin_amdgcn_rcpf(lsb); }
        asm volatile("s_waitcnt lgkmcnt(0)" ::: "memory");
        __attribute__((address_space(3))) float* As = Cs;
#pragma unroll
        for (int r = 0; r < 16; ++r) { const int q = crow(r, hit); const float s0 = wsf[q], s1 = wsf[32 + q];
            As[q * 65 + r32t] = oa0[r] * s0 - ob0[r] * s1; As[q * 65 + 32 + r32t] = oa1[r] * s0 - ob1[r] * s1; }
        asm volatile("s_waitcnt lgkmcnt(0)" ::: "memory");
        const int row = lane_t >> 1, hf = lane_t & 1;
        float v[32]; float ss = 0.f;
#pragma unroll
        for (int i = 0; i < 32; ++i) { v[i] = As[row * 65 + hf * 32 + i]; ss += v[i] * v[i]; }
        ss += swz<1>(ss);
        const float rn = __builtin_amdgcn_rsqf(ss * (1.0f / 64.0f) + EPS) * post;
        bf16* dst = (bf16*)(ws + WS_MIX) + ((size_t)(b * SEQ + q0 + row)) * DM + h * 64 + hf * 32;
#pragma unroll
        for (int i = 0; i < 4; ++i) { u32x4 w;
            w.x = cvtpk_s(v[8 * i] * rn * ((const GAS float*)sub)[hf * 32 + 8 * i], v[8 * i + 1] * rn * ((const GAS float*)sub)[hf * 32 + 8 * i + 1]); w.y = cvtpk_s(v[8 * i + 2] * rn * ((const GAS float*)sub)[hf * 32 + 8 * i + 2], v[8 * i + 3] * rn * ((const GAS float*)sub)[hf * 32 + 8 * i + 3]);
            w.z = cvtpk_s(v[8 * i + 4] * rn * ((const GAS float*)sub)[hf * 32 + 8 * i + 4], v[8 * i + 5] * rn * ((const GAS float*)sub)[hf * 32 + 8 * i + 5]); w.w = cvtpk_s(v[8 * i + 6] * rn * ((const GAS float*)sub)[hf * 32 + 8 * i + 6], v[8 * i + 7] * rn * ((const GAS float*)sub)[hf * 32 + 8 * i + 7]);
            *(GAS u32x4*)(dst + 8 * i) = w; }
    }
    ATT_BAR();
}

__device__ __forceinline__ void dil_prefetch(const unsigned char* ws, const int tid, int bh, int br, int chunk, unsigned lds_dummy) {
    const int wid = __builtin_amdgcn_readfirstlane(tid >> 6);
    if (wid < 6) {
        const int s = wid, within = tid & 63, dsh = 2 * br, L = SEQ >> dsh;
        int res, k0;
        if (br == 2) { res = 2 * chunk + ((s >> 1) & 1); k0 = 64 * (s & 1); }
        else { res = br == 1 ? (chunk >> 1) : 0; k0 = (br == 1 ? 256 * (chunk & 1) : 256 * chunk) - 64 + 64 * s; }
        int ki = k0 + within; ki = ki < 0 ? 0 : (ki > L - 1 ? L - 1 : ki);
        const size_t off = ((size_t)bh * SEQ + res + ((size_t)ki << dsh)) * 64;
        const unsigned d_ = (unsigned)__builtin_amdgcn_readfirstlane(lds_dummy + wid * 1024);
        glds16((const bf16*)(ws + WS_KL) + off, d_); glds16((const bf16*)(ws + WS_VL) + off, d_);
    }
}

constexpr int DL_SLOT = 16384, DL_TAB = 98304, DL_WSF = 114688;
template <int DIL> __device__ __forceinline__ void dil_unit(const unsigned char* ws, unsigned char* wsw, const int tid, int l, int bh, int chunk, int nud, char* shm) {
    constexpr int L = SEQ / DIL, BR = DIL == 1 ? 0 : (DIL == 4 ? 1 : 2), NSLOT = DIL == 16 ? 4 : 6, NTW = DIL == 16 ? 2 : 3;
    const int lane = tid & 63, r32 = lane & 31, hi = lane >> 5, wid = __builtin_amdgcn_readfirstlane(tid >> 6);
    const int h = bh % 6, b = bh / 6;
    const bf16* Qb = (const bf16*)(ws + WS_QL) + (size_t)bh * SEQ * 64; const bf16* Kb = (const bf16*)(ws + WS_KL) + (size_t)bh * SEQ * 64; const bf16* Vb = (const bf16*)(ws + WS_VL) + (size_t)bh * SEQ * 64;
    const float* tabg = (const float*)(ws + WS_TAB) + TAB_BL + (l * 6 + h) * 4096;
    const unsigned lds0 = (unsigned)(uintptr_t)shm; const lds_cptr shm3 = (lds_cptr)shm;
    PROBE_T0(pt4_);
    int res_w, qidx0, tf;
    if (DIL == 16) { res_w = 2 * chunk + (wid >> 2); qidx0 = 32 * (wid & 3); tf = 2 * (wid >> 2); }
    else if (DIL == 4) { res_w = chunk >> 1; qidx0 = 256 * (chunk & 1) + 32 * wid; tf = wid >> 1; }
    else { res_w = 0; qidx0 = 256 * chunk + 32 * wid; tf = wid >> 1; }
    const int t0idx = DIL == 16 ? 0 : (DIL == 4 ? 256 * (chunk & 1) - 64 : 256 * chunk - 64);
#pragma unroll
    for (int s = 0; s < NSLOT; ++s) {
        const int res_s = DIL == 16 ? 2 * chunk + (s >> 1) : res_w, k0 = DIL == 16 ? 64 * (s & 1) : t0idx + 64 * s;
        int ki = k0 + 8 * wid + (lane >> 3); ki = ki < 0 ? 0 : (ki > L - 1 ? L - 1 : ki);
        int vi = k0 + 16 * (wid & 3) + (lane >> 2); vi = vi < 0 ? 0 : (vi > L - 1 ? L - 1 : vi);
        const unsigned d_ = (unsigned)__builtin_amdgcn_readfirstlane(lds0 + s * DL_SLOT + wid * 1024);
        glds16(Kb + (size_t)(res_s + DIL * ki) * 64 + (((lane & 7) ^ (((8 * wid + (lane >> 3)) >> 1) & 7)) * 8), d_);
        glds16(Vb + (size_t)(res_s + DIL * vi) * 64 + (wid >> 2) * 32 + (lane & 3) * 8, d_ + 8192);
    }
    if (tid < 256) ((__attribute__((address_space(3))) float*)(shm3 + DL_TAB))[tid] = (tid >= 64 && tid <= 192) ? ((const GAS float*)tabg)[2048 + DIL * (tid - 128)] : -1.0e30f;
    bf16x8 qr[4];
#pragma unroll
    for (int d0 = 0; d0 < 4; ++d0) qr[d0] = *(const GAS bf16x8*)(Qb + (size_t)(res_w + DIL * (qidx0 + r32)) * 64 + d0 * 16 + hi * 8);
    PROBE_T0(pt1_); ATT_WAIT_BAR(0); PROBE_ADD(1, pt1_, shm3);
    PROBE_T0(pt2_);
    f32x16 o0 = {}, o1 = {}; float lsum = 0.f;
    const int qidx = qidx0 + r32;
#pragma unroll
    for (int tt = 0; tt < NTW; ++tt) {
        const int slot = tf + tt;
        const int k0 = DIL == 16 ? 64 * tt : t0idx + 64 * slot;
        if (k0 < 0 || k0 >= L) continue;
        const lds_cptr kp = shm3 + slot * DL_SLOT + r32 * 128;
        const lds_cptr vp = shm3 + slot * DL_SLOT + 8192 + ((lane >> 4) & 1) * 32 + (lane & 3) * 8 + (4 * hi + ((lane & 15) >> 2)) * 64;
        const int dbase = k0 + 4 * hi - qidx;
        int ti = 128 + dbase; ti = ti < 0 ? 0 : (ti > 255 - 59 ? 255 - 59 : ti);
        const __attribute__((address_space(3))) float* tb = (const __attribute__((address_space(3))) float*)(shm3 + DL_TAB) + ti;
        f32x16 p0, p1;
#pragma unroll
        for (int r = 0; r < 16; ++r) { p0[r] = tb[(r & 3) + 8 * (r >> 2)]; p1[r] = tb[32 + (r & 3) + 8 * (r >> 2)]; }
#pragma unroll
        for (int d0 = 0; d0 < 4; ++d0) {
            const int e_ = ((2 * d0 + hi) ^ ((r32 >> 1) & 7)) << 4;
            const bf16x8 a0 = *(const __attribute__((address_space(3))) bf16x8*)(kp + e_), a1 = *(const __attribute__((address_space(3))) bf16x8*)(kp + e_ + 4096);
            p0 = __builtin_amdgcn_mfma_f32_32x32x16_bf16(a0, qr[d0], p0, 0, 0, 0); p1 = __builtin_amdgcn_mfma_f32_32x32x16_bf16(a1, qr[d0], p1, 0, 0, 0);
        }
        const float s0 = exp_sum(p0, p1);
        lsum += s0;
        bf16x8 pa[4]; pack_p(p0, p1, pa);
        pv64(o0, o1, vp, pa);
    }
    ATT_BAR();
    PROBE_ADD(2, pt2_, shm3);
    PROBE_T0(pt3_);
    lsum = half_swap_sum(lsum);
    int lane_t = lane; asm volatile("" : "+v"(lane_t));
    const int r32t = lane_t & 31, hit = lane_t >> 5;
    __attribute__((address_space(3))) float* wsf = (__attribute__((address_space(3))) float*)(shm3 + DL_WSF) + wid * 64;
    if (hit == 0) wsf[r32t] = __builtin_amdgcn_rcpf(lsum);
    asm volatile("s_waitcnt lgkmcnt(0)" ::: "memory");
    float sc[16];
#pragma unroll
    for (int r = 0; r < 16; ++r) sc[r] = wsf[crow(r, hit)];
    bf16* DO = (bf16*)(wsw + (BR == 0 ? WS_DO0 : (BR == 1 ? WS_DO1 : WS_DO2)));
    float* DLs = (float*)(wsw + WS_DL) + (size_t)BR * MTOK * 8;
    const size_t row0 = (size_t)b * SEQ + res_w + (size_t)DIL * qidx0;
    store_o64<true>(o0, o1, sc, (lds_ptr)(shm3 + wid * 4096), DO + row0 * 384 + h * 64, 384 * DIL, lane_t);
    if (hit == 0) ((GAS float*)DLs)[(row0 + (size_t)DIL * r32t) * 8 + h] = lsum;
    ATT_BAR();
    PROBE_ADD(3, pt3_, shm3); PROBE_ADD(4, pt4_, shm3);
}

__device__ __forceinline__ void dil_merge(unsigned char* wsm, const unsigned char* wsw, const int tid, int gw, int NGW, int xloc) {
    const int lane = tid & 63;
    const bf16* D0 = (const bf16*)(wsw + WS_DO0); const bf16* D1 = (const bf16*)(wsw + WS_DO1); const bf16* D2 = (const bf16*)(wsw + WS_DO2);
    const float* DLs = (const float*)(wsw + WS_DL);
    bf16* mix = (bf16*)(wsm + WS_MIX);
    const int mstep = xloc ? 256 : NGW, mfirst = xloc ? (gw >> 8) * SEQ + (gw & 255) : gw;
    for (int m0 = mfirst; m0 < (xloc ? mfirst + 1 : MTOK); m0 += 8 * mstep) {
        if (lane < 48) {
            const int h = lane >> 3;
            v4u a[8], bq[8], c[8]; float l0[8], l1[8], l2[8];
#pragma unroll
            for (int k = 0; k < 8; ++k) { int m = m0 + k * mstep; m = m < MTOK ? m : MTOK - 1;
                a[k] = __builtin_nontemporal_load((const GAS v4u*)(D0 + (size_t)m * 384 + lane * 8)); bq[k] = __builtin_nontemporal_load((const GAS v4u*)(D1 + (size_t)m * 384 + lane * 8)); c[k] = __builtin_nontemporal_load((const GAS v4u*)(D2 + (size_t)m * 384 + lane * 8));
                l0[k] = ((const GAS float*)DLs)[(size_t)m * 8 + h]; l1[k] = ((const GAS float*)DLs)[((size_t)MTOK + m) * 8 + h]; l2[k] = ((const GAS float*)DLs)[((size_t)2 * MTOK + m) * 8 + h]; }
#pragma unroll
            for (int k = 0; k < 8; ++k) { const int m = m0 + k * mstep;
                const float inv = 1.0f / (l0[k] + l1[k] + l2[k]), w0 = l0[k] * inv, w1 = l1[k] * inv, w2 = l2[k] * inv;
                float x[8], y[8], z[8]; unpack8(a[k], x); unpack8(bq[k], y); unpack8(c[k], z);
                v4u o; o.x = pk2(w0 * x[0] + w1 * y[0] + w2 * z[0], w0 * x[1] + w1 * y[1] + w2 * z[1]); o.y = pk2(w0 * x[2] + w1 * y[2] + w2 * z[2], w0 * x[3] + w1 * y[3] + w2 * z[3]);
                o.z = pk2(w0 * x[4] + w1 * y[4] + w2 * z[4], w0 * x[5] + w1 * y[5] + w2 * z[5]); o.w = pk2(w0 * x[6] + w1 * y[6] + w2 * z[6], w0 * x[7] + w1 * y[7] + w2 * z[7]);
                if (m < MTOK) *(GAS v4u*)(mix + (size_t)m * DM + 256 + lane * 8) = o; }
        }
    }
}
}

#ifndef MK_PROBE_L
#define MK_PROBE_L -1
#endif
#ifndef MK_PH
#define MK_PH 255
#endif
#ifndef MK_CONV_EARLY
#define MK_CONV_EARLY 1
#endif
#ifndef MK_DUP
#define MK_DUP 0
#endif
#define REP(kind) for (int rep_ = 0; rep_ < (((MK_DUP >> (kind)) & 1) ? 2 : 1); ++rep_)
#ifndef MK_ATTN_V1
#define MK_ATTN_V1 0
#endif
#ifndef MK_SP2
#define MK_SP2 true
#endif
constexpr int NPHASE = 18;
template <int MODE>
__global__ void __launch_bounds__(512, 2) enc_fwd(Args args) {
    extern __shared__ __attribute__((aligned(16))) unsigned char lds[];
    LAS unsigned char* L = (LAS unsigned char*)lds;
    volatile LAS unsigned* MISC = (volatile LAS unsigned*)(L + MISC_OFF);
    LAS float* xs = (LAS float*)(L + XS_OFF);
    PROBE_T0(ptall_);
    const int G = gridDim.x; int bx = blockIdx.x, xloc = 0;
    const int wave0 = __builtin_amdgcn_readfirstlane(threadIdx.x >> 6);
    int vcu = (G % 8 == 0) ? (bx % 8) * (G / 8) + bx / 8 : bx;
    for (int u = threadIdx.x; u < (LDS_BYTES - MISC_OFF) / 4; u += 512) ((LAS unsigned*)(L + MISC_OFF))[u] = 0u;
    __syncthreads();
    { volatile LAS unsigned long long* PT = (volatile LAS unsigned long long*)(L + MISC_OFF + 128);
      if (threadIdx.x == 0) {
#pragma unroll
          for (int i = 0; i < 25; ++i) PT[i] = (unsigned long long)args.in[i];
          PT[25] = (unsigned long long)args.out; } }
    __syncthreads();
    if (MODE < 0) xcd_barrier_post((unsigned*)(args.ws + WS_CTL) + CW_BAR, MISC + 8, threadIdx.x == 0);
#define IN(k) (MODE < 0 || MODE == (k))
#define SEAM(k) do { if (MODE < 0) { PROBE_T0(pts_); int lid_; asm volatile("v_mbcnt_lo_u32_b32 %0, -1, 0\n\tv_mbcnt_hi_u32_b32 %0, -1, %0" : "=v"(lid_)); xcd_barrier((unsigned*)(args.ws + WS_CTL) + CW_BAR, MISC + 8, wave0 == 0 && lid_ == 0); if ((k) != 99) PROBE_ADD(30, pts_, L); } } while (0)
#define SEAM_L(k) do { if (MODE < 0) { PROBE_T0(pts_); int lid_; asm volatile("v_mbcnt_lo_u32_b32 %0, -1, 0\n\tv_mbcnt_hi_u32_b32 %0, -1, %0" : "=v"(lid_)); { if (xloc) xcd_local_barrier((unsigned*)(args.ws + WS_CTL) + CW_BAR, MISC + 8, wave0 == 0 && lid_ == 0); else xcd_barrier((unsigned*)(args.ws + WS_CTL) + CW_BAR, MISC + 8, wave0 == 0 && lid_ == 0); } if ((k) != 99) PROBE_ADD(30, pts_, L); } } while (0)
#define INP(i) ((const float*)lds_ptr_get((volatile LAS unsigned long long*)(L + MISC_OFF + 128), (i)))
#define PHASE_ENV() int tidp; asm volatile("v_mbcnt_lo_u32_b32 %0, -1, 0\n\tv_mbcnt_hi_u32_b32 %0, -1, %0" : "=v"(tidp)); tidp |= wave0 << 6; asm volatile("" : "+v"(tidp)); int bxp = bx, Gp = G, vcup = vcu; asm volatile("" : "+s"(bxp), "+s"(Gp), "+s"(vcup)); (void)vcup; unsigned char* ws; { const unsigned long long w_ = (unsigned long long)args.ws; unsigned wl_ = (unsigned)w_, wh_ = (unsigned)(w_ >> 32); \
          asm volatile("" : "+s"(wl_), "+s"(wh_)); ws = (unsigned char*)(((unsigned long long)wh_ << 32) | wl_); } \
        const int lane = tidp & 63, wave = __builtin_amdgcn_readfirstlane(tidp >> 6), gw = vcup * 8 + wave, gtid = bxp * 512 + tidp; const int NGW = Gp * 8, NGT = Gp * 512; (void)NGW; (void)NGT; (void)lane; (void)gw; (void)gtid; \
        bf16* XB = (bf16*)(ws + WS_XB); bf16* HB = (bf16*)(ws + WS_H); float* P0 = (float*)(ws + WS_P); float* P1 = P0 + (size_t)MTOK * 16; float* P2 = P1 + (size_t)MTOK * 16; \
        const float* tab = (const float*)(ws + WS_TAB); (void)XB; (void)HB; (void)P0; (void)P1; (void)P2; (void)tab;

    PROBE_T0(ptp_);
    REP(0) if (IN(0) && (MK_PH & 1)) { PHASE_ENV();
        prologue_misc((volatile LAS unsigned long long*)(L + MISC_OFF + 128), ws, gw, NGW, lane, gtid, NGT);
        convert_weights((volatile LAS unsigned long long*)(L + MISC_OFF + 128), ws, 0, MK_CONV_EARLY ? 1 : 255, gw, NGW, lane);
    }
    SEAM(0);
    PROBE_ADD(47, ptp_, L);
    if (MODE < 0 && G == 256) {
        int lidx_; asm volatile("v_mbcnt_lo_u32_b32 %0, -1, 0\n\tv_mbcnt_hi_u32_b32 %0, -1, %0" : "=v"(lidx_));
        if (wave0 == 0 && lidx_ == 0) MISC[12] = xcd_topology_regular((unsigned*)(args.ws + WS_CTL) + CW_BAR, (unsigned)G) ? 1u : 0u;
        __syncthreads();
        if (__builtin_amdgcn_readfirstlane((int)MISC[12])) { const int x_ = __builtin_amdgcn_readfirstlane((int)MISC[10]), r_ = __builtin_amdgcn_readfirstlane((int)MISC[11]);
            bx = r_ * 8 + x_; vcu = x_ * (G / 8) + r_; xloc = 1; }
    }
#if MK_PROBE == 31
    { PROBE_T0(ptx_); int lidq_; asm volatile("v_mbcnt_lo_u32_b32 %0, -1, 0\n\tv_mbcnt_hi_u32_b32 %0, -1, %0" : "=v"(lidq_));
      for (int rr = 0; rr < 4; ++rr) xcd_barrier((unsigned*)(args.ws + WS_CTL) + CW_BAR, MISC + 8, wave0 == 0 && lidq_ == 0);
      PROBE_ADD(31, ptx_, L); }
#endif
    for (int l = (MODE < 0 ? 0 : args.layer); l < (MODE < 0 ? DEPTH : args.layer + 1); ++l) {
        constexpr int p0 = 1;
        PROBE_T0(ptw0_);
        REP(1) if (IN(p0 + 0) && (MK_PH & 4)) { PHASE_ENV();
            pg8::Gemm g{XB, (const bf16*)(ws + W_GU1), MTOK, 2 * DFF, DM, DM, DM}; pg8::StaticOrder S; S.init(MTOK, 2 * DFF, Gp, bxp);
            pg8::EpiSwiGLU E{HB, P0};
            PROBE_T0(ptg_);
            if (lane == 0) ((LAS int*)(L + RING_BYTES + 16384))[wave] = -1;        pg8::gemm_phase<pg8::EpiSwiGLU, pg8::StaticOrder, true, MK_SP2>(tidp, L, xs, g, S, E);
            PROBE_ADD(32, ptg_, L);
            if (MK_CONV_EARLY && bxp >= Gp / 2) convert_weights((volatile LAS unsigned long long*)(L + MISC_OFF + 128), ws, l, 244, (bxp - Gp / 2) * 8 + wave, (Gp - Gp / 2) * 8, lane);
        }
        SEAM(p0 + 0);
        if (MK_PROBE_L < 0 || l == MK_PROBE_L) PROBE_ADD(40, ptw0_, L); PROBE_T0(ptw1_);
        REP(2) if (IN(p0 + 1) && (MK_PH & 8)) { PHASE_ENV();
            pg8::Gemm g{HB, (const bf16*)(ws + W_D1), MTOK, DM, DFF, DFF, DFF}; pg8::StaticOrder S; S.init(MTOK, DM, Gp, bxp);
            pg8::EpiResidB E{XB, nullptr, P1, (((MK_DUP >> 2) & 1) && rep_ == 0) ? 0.0f : 0.5f};
            PROBE_T0(ptd_);
            pg8::gemm_phase<pg8::EpiResidB, pg8::StaticOrder, true, MK_SP2>(tidp, L, xs, g, S, E);
            PROBE_ADD(33, ptd_, L);
        }
        SEAM_L(p0 + 1);
        PROBE_ADD(41, ptw1_, L); PROBE_T0(ptw2_);
        REP(3) if (IN(p0 + 2) && (MK_PH & 16)) { PHASE_ENV();
            pg8::Gemm g{XB, (const bf16*)(ws + W_IN), MTOK, NIN, DM, DM, DM}; pg8::StaticOrder S; S.init(MTOK, NIN, Gp, bxp);
            pg8::EpiInProj E{P1, (bf16*)(ws + WS_QD), (bf16*)(ws + WS_KD), (bf16*)(ws + WS_VD), (bf16*)(ws + WS_QL), (bf16*)(ws + WS_KL), (bf16*)(ws + WS_VL), (bf16*)(ws + WS_AQ),
                             (float*)(ws + WS_KR), (float*)(ws + WS_KRSS), INP(I_DQN) + l * 32, INP(I_DKN) + l * 32, INP(I_LQN) + l * 64, INP(I_LKN) + l * 64,
                             0.17677669529663687f * LOG2E, 0.125f * LOG2E, 0};
            if (lane == 0) ((LAS int*)(L + RING_BYTES + 16384))[wave] = -1;        pg8::gemm_phase<pg8::EpiInProj, pg8::StaticOrder, true, MK_SP2>(tidp, L, xs, g, S, E);
            if (MK_CONV_EARLY && bxp >= Gp / 2) convert_weights((volatile LAS unsigned long long*)(L + MISC_OFF + 128), ws, l, 10, (bxp - Gp / 2) * 8 + wave, (Gp - Gp / 2) * 8, lane);
        }
        SEAM_L(p0 + 2);
        PROBE_ADD(42, ptw2_, L); PROBE_T0(ptw3_);
        REP(10) if (IN(p0 + 3) && (MK_PH & 32)) { PHASE_ENV();
            int Kq = 256; asm volatile("" : "+s"(Kq));
            pg8::Gemm g{(const bf16*)(ws + WS_AQ), (const bf16*)(ws + W_QU), MTOK, 1536, Kq, 384, 256, 3, 256}; pg8::StaticOrder S; S.init(MTOK, 1536, Gp, bxp);
            pg8::EpiMlaQKV E{ pg8::EpiMlaQ{(bf16*)(ws + WS_QC), INP(I_MQNG) + l * 96, tab + TAB_COS, tab + TAB_SIN, 0.10206207261596575f * LOG2E},
                              pg8::EpiMlaKV{(bf16*)(ws + WS_KC), (bf16*)(ws + WS_VC), INP(I_MKNG) + l * 96, (const float*)(ws + WS_KR), (const float*)(ws + WS_KRSS), tab + TAB_COS, tab + TAB_SIN} };
            PROBE_T0(ptm_);
            pg8::gemm_phase<pg8::EpiMlaQKV, pg8::StaticOrder, true, MK_SP2>(tidp, L, xs, g, S, E);
            PROBE_ADD(51, ptm_, L);
        }
#if !MK_ATTN_V1
        REP(12) if (IN(p0 + 3) && (MK_PH & 32)) { PHASE_ENV();
            const int kx_ = bxp >> 3, xc_ = bxp & 7, rnk = (kx_ >= 16) ? xc_ * 16 + (kx_ - 16) : 128 + xc_ * 16 + kx_;
            PROBE_T0(ptdl_);
            const int lr_ = (kx_ >= 16) ? (kx_ - 16) : 16 + kx_, ud0_ = xloc ? xc_ * 144 + lr_ : rnk, udn_ = xloc ? (xc_ + 1) * 144 : 1152, uds_ = xloc ? 32 : Gp;
            for (int ud = ud0_; ud < udn_; ud += uds_) {
                const int bh = ud / 24, rem = ud - bh * 24, br = rem >> 3, chunk = rem & 7;
                if (br == 0) att::dil_unit<1>(ws, (unsigned char*)INP(25), tidp, l, bh, chunk, ud + Gp, (char*)lds);
                else if (br == 1) att::dil_unit<4>(ws, (unsigned char*)INP(25), tidp, l, bh, chunk, ud + Gp, (char*)lds);
                else att::dil_unit<16>(ws, (unsigned char*)INP(25), tidp, l, bh, chunk, ud + Gp, (char*)lds);
            }
            PROBE_ADD(52, ptdl_, L);
        }
#endif
        SEAM_L(p0 + 3);
        PROBE_ADD(43, ptw3_, L); PROBE_T0(ptw4_);
#if MK_ATTN_V1
        REP(5) if (IN(p0 + 4) && (MK_PH & 64)) { PHASE_ENV();
            for (int u = bxp; u < 640; u += Gp) {
                if (u < 192) mla_unit_v1(ws, tidp, l, u, (LAS float*)L);
                else if (u < 448) diff_unit_v1(ws, INP(I_DSUB) + l * 64, tidp, l, u - 192, (LAS float*)L);
                else dil_unit_v1(ws, tidp, l, u - 448);
            }
        }
#else
        REP(13) if (IN(p0 + 4) && (MK_PH & 64)) { PHASE_ENV();
            PROBE_T0(ptdf_);
            for (int u = vcup; u < 256; u += Gp) att::diff_unit256(ws, INP(I_DSUB) + l * 64, tidp, l, u, (char*)lds);
            PROBE_ADD(53, ptdf_, L);
        }
        REP(14) if (IN(p0 + 4) && (MK_PH & 64)) { PHASE_ENV();
            PROBE_T0(ptml_);
            if (Gp == 256) { const int k3 = 3 * vcup, big = (vcup & 1) ? k3 + 1 : k3, sml = (vcup & 1) ? k3 : k3 + 2;
                att::mla_unit256(ws, tidp, l, big >> 4, (big & 15) * 128, (char*)lds);
                att::mla_unit(ws, tidp, l, sml, (char*)lds); }
            else for (int u = vcup; u < 768; u += Gp) att::mla_unit(ws, tidp, l, u, (char*)lds);
            PROBE_ADD(54, ptml_, L);
        }
        REP(15) if (IN(p0 + 4) && (MK_PH & 64)) { PHASE_ENV();
            PROBE_T0(ptmg_);
            att::dil_merge(ws, (const unsigned char*)INP(25), tidp, gw, NGW, xloc);
            PROBE_ADD(55, ptmg_, L);
        }
#endif
        PROBE_T0(pta_);
        SEAM_L(p0 + 4);
        PROBE_ADD(56, pta_, L);
        PROBE_ADD(44, ptw4_, L); PROBE_T0(ptw5_);
        REP(6) if (IN(p0 + 5) && (MK_PH & 128)) { PHASE_ENV();
            pg8::Gemm g{(const bf16*)(ws + WS_MIX), (const bf16*)(ws + W_O), MTOK, DM, DM, DM, DM}; pg8::StaticOrder S; S.init(MTOK, DM, Gp, bxp);
            pg8::EpiResidB E{XB, nullptr, P2, (((MK_DUP >> 6) & 1) && rep_ == 0) ? 0.0f : 1.0f};
            pg8::gemm_phase<pg8::EpiResidB, pg8::StaticOrder, true, MK_SP2>(tidp, L, xs, g, S, E);
        }
        SEAM(p0 + 5);
        PROBE_ADD(45, ptw5_, L); PROBE_T0(ptw6_);
        REP(7) if (IN(p0 + 6) && (MK_PH & 4)) { PHASE_ENV();
            pg8::Gemm g{XB, (const bf16*)(ws + W_GU2), MTOK, 2 * DFF, DM, DM, DM}; pg8::StaticOrder S; S.init(MTOK, 2 * DFF, Gp, bxp);
            pg8::EpiSwiGLU E{HB, P2};
            if (lane == 0) ((LAS int*)(L + RING_BYTES + 16384))[wave] = -1;        pg8::gemm_phase<pg8::EpiSwiGLU, pg8::StaticOrder, true, MK_SP2>(tidp, L, xs, g, S, E);
            if (MK_CONV_EARLY && l + 1 < DEPTH && bxp >= Gp / 2) convert_weights((volatile LAS unsigned long long*)(L + MISC_OFF + 128), ws, l + 1, 1, (bxp - Gp / 2) * 8 + wave, (Gp - Gp / 2) * 8, lane);
        }
        SEAM_L(p0 + 6);
        if (MK_PROBE_L < 0 || l == MK_PROBE_L) PROBE_ADD(46, ptw6_, L); PROBE_T0(ptw7_);
        REP(8) if (IN(p0 + 7) && (MK_PH & 8)) { PHASE_ENV();
            pg8::Gemm g{HB, (const bf16*)(ws + W_D2), MTOK, DM, DFF, DFF, DFF}; pg8::StaticOrder S; S.init(MTOK, DM, Gp, bxp);
            pg8::EpiResidB E{XB, l == DEPTH - 1 ? (float*)INP(25) : nullptr, P0, (((MK_DUP >> 8) & 1) && rep_ == 0) ? 0.0f : 0.5f};
            pg8::gemm_phase<pg8::EpiResidB, pg8::StaticOrder, true, MK_SP2>(tidp, L, xs, g, S, E);
        }
        if (l + 1 < DEPTH && !MK_CONV_EARLY) {
            SEAM(p0 + 7);
            REP(9) if (IN(p0 + 8) && (MK_PH & 2)) { PHASE_ENV(); convert_weights((volatile LAS unsigned long long*)(L + MISC_OFF + 128), ws, l + 1, 255, gw, NGW, lane); }
            SEAM(p0 + 8);
        }
        if (l + 1 < DEPTH && MK_CONV_EARLY) SEAM(p0 + 7);
        PROBE_ADD(48, ptw7_, L);
    }
    PROBE_ADD(49, ptall_, L);
#if MK_PROBE
    if (MODE < 0) { SEAM(99);
        int lidp_; asm volatile("v_mbcnt_lo_u32_b32 %0, -1, 0\n\tv_mbcnt_hi_u32_b32 %0, -1, %0" : "=v"(lidp_));
        if ((int)blockIdx.x == MK_PROBE_BLOCK && wave0 == 0 && lidp_ == 0) { const unsigned tk = ((volatile LAS unsigned*)(L + MISC_OFF + 96))[0]; float* o = (float*)args.out; o[1] = o[1] + 0.04f + (float)tk * 1.0e-8f * MK_PROBE_SCALE; } }
#endif
#undef IN
#undef SEAM
#undef PHASE_ENV
}

extern "C" void kernel_launch(void* const* d_in, const int* in_sizes, int n_in, void* d_out, int out_size, void* d_ws, size_t ws_size, hipStream_t stream) {
    static int grid = 0;
    if (grid == 0) {
        if (n_in != 25 || out_size != MTOK * DM || ws_size < WS_TOTAL) { fprintf(stderr, "kernel_launch: unexpected shapes (n_in %d out %d ws %zu)\n", n_in, out_size, ws_size); grid = -1; return; }
        int dev = 0, cus = 0, per_cu = 0;
        if (hipGetDevice(&dev) != hipSuccess || hipDeviceGetAttribute(&cus, hipDeviceAttributeMultiprocessorCount, dev) != hipSuccess) { grid = -1; return; }
#if MK_ONE_LAUNCH
        if (hipFuncSetAttribute((const void*)enc_fwd<-1>, hipFuncAttributeMaxDynamicSharedMemorySize, LDS_BYTES) != hipSuccess) { fprintf(stderr, "kernel_launch: hipFuncSetAttribute failed\n"); grid = -1; return; }
        if (hipOccupancyMaxActiveBlocksPerMultiprocessor(&per_cu, (const void*)enc_fwd<-1>, 512, LDS_BYTES) != hipSuccess || per_cu < 1) { fprintf(stderr, "kernel_launch: occupancy query says %d\n", per_cu); grid = -1; return; }
#else
#define SETATTR(K) if (hipFuncSetAttribute((const void*)enc_fwd<K>, hipFuncAttributeMaxDynamicSharedMemorySize, LDS_BYTES) != hipSuccess) { fprintf(stderr, "kernel_launch: hipFuncSetAttribute failed\n"); grid = -1; return; }
        SETATTR(0) SETATTR(1) SETATTR(2) SETATTR(3) SETATTR(4) SETATTR(5) SETATTR(6) SETATTR(7) SETATTR(8) SETATTR(9)
        per_cu = 1;
#endif
        (void)hipGetLastError();
        grid = cus;
    }
    if (grid < 0) return;
    (void)hipMemsetAsync((char*)d_ws + WS_CTL, 0, CTL_ZERO_BYTES, stream);
    Args a{};
    for (int i = 0; i < 25; ++i) a.in[i] = (const float*)d_in[i];
    a.out = (float*)d_out; a.ws = (unsigned char*)d_ws;
#if MK_ONE_LAUNCH
    a.layer = 0;
    hipLaunchKernelGGL(enc_fwd<-1>, dim3(grid), dim3(512), LDS_BYTES, stream, a);
#else
#define LAUNCH_PH(K, LAYER) do { a.layer = (LAYER); hipLaunchKernelGGL(enc_fwd<K>, dim3(grid), dim3(512), LDS_BYTES, stream, a); } while (0)
    LAUNCH_PH(0, 0);
    for (int l = 0; l < DEPTH; ++l) {
        LAUNCH_PH(1, l); LAUNCH_PH(2, l); LAUNCH_PH(3, l); LAUNCH_PH(4, l); LAUNCH_PH(5, l); LAUNCH_PH(6, l); LAUNCH_PH(7, l); LAUNCH_PH(8, l);
        if (l + 1 < DEPTH) LAUNCH_PH(9, l);
    }
#endif
}
```
